# Optimizing an MI355X kernel written in HIP

```python
import jax, jax.numpy as jnp
from jax import lax
import numpy as np

D_MODEL = 2048
BATCH = 2
SEQ = 16384
DEPTH = 1

GRID_W = 64
CTX_LEN = 256
LRU_WIDTH = D_MODEL // 2
LRU_HEADS = 8
LRU_HEAD_DIM = LRU_WIDTH // LRU_HEADS
LRU_C = 8.0
CONV_W = 4
CONV_LEFT = 2
SGU_WIDTH = D_MODEL // 2
SGU_GROUPS = 8
SGU_GROUP_DIM = SGU_WIDTH // SGU_GROUPS
CHUNK = 128
ROWS_PER_CHUNK = CHUNK // GRID_W
MIX_WIDTH = LRU_WIDTH + SGU_WIDTH
IN_WIDTH = 2 * LRU_WIDTH + 2 * SGU_WIDTH
PEER_HEADS = 8
PEER_NKEYS = 128
PEER_EXPERTS = PEER_NKEYS * PEER_NKEYS
PEER_QDIM = 256
PEER_HALF = PEER_QDIM // 2
PEER_TOPK = 16
PEER_BLOCK = 128
N_MOD = 6
EPS = 1e-6

kernel_name = "hybrid_rglru_sgu_peer_prefix_dit"


def rms_norm(x, g):
    xf = x.astype(jnp.float32)
    y = xf * lax.rsqrt(jnp.mean(xf * xf, axis=-1, keepdims=True) + EPS)
    return (y * g.astype(jnp.float32)).astype(x.dtype)


def layer_norm_noaffine(x):
    xf = x.astype(jnp.float32)
    mu = jnp.mean(xf, axis=-1, keepdims=True)
    var = jnp.mean(jnp.square(xf - mu), axis=-1, keepdims=True)
    return ((xf - mu) * lax.rsqrt(var + EPS)).astype(x.dtype)


def adaln(s, w_mod, b_mod, k):
    lo, hi = k * D_MODEL, (k + 1) * D_MODEL
    return (s @ w_mod[:, lo:hi] + b_mod[lo:hi])[..., None, :]


def modulate(h, shift, scale):
    return h * (1.0 + scale) + shift


def centred_conv(x, w, b):
    L = x.shape[1]
    xp = jnp.pad(x, ((0, 0), (CONV_LEFT, CONV_W - 1 - CONV_LEFT), (0, 0)))
    y = b
    for k in range(CONV_W):
        y = y + xp[:, k:k + L, :] * w[k]
    return y


def block_diag(x, w, b):
    B, L, _ = x.shape
    xh = x.reshape(B, L, LRU_HEADS, LRU_HEAD_DIM)
    return jnp.einsum('blhi,hij->blhj', xh, w).reshape(B, L, LRU_WIDTH) + b


def lru_coeffs(xc, wa, ba, wx, bx, lam):
    xf = xc.astype(jnp.float32)
    r = jax.nn.sigmoid(block_diag(xc, wa, ba).astype(jnp.float32))
    i = jax.nn.sigmoid(block_diag(xc, wx, bx).astype(jnp.float32))
    log_a = -LRU_C * r * jax.nn.softplus(-lam.astype(jnp.float32))
    a = jnp.exp(log_a)
    b = jnp.sqrt(-jnp.expm1(2.0 * log_a)) * (i * xf)
    return a, b


def linear_scan(a, b, h0, reverse):
    def step(h, ab):
        h = ab[0] * h + ab[1]
        return h, h
    h_fin, hs = lax.scan(step, h0, (jnp.swapaxes(a, 0, 1), jnp.swapaxes(b, 0, 1)), reverse=reverse)
    return h_fin, jnp.swapaxes(hs, 0, 1)


def scan_final_state(a, b, h0, reverse):
    def step(h, ab):
        return ab[0] * h + ab[1], None
    h_fin, _ = lax.scan(step, h0, (jnp.swapaxes(a, 0, 1), jnp.swapaxes(b, 0, 1)), reverse=reverse)
    return h_fin


def spatial_gating(u, v, w_s, b_s, n_chunks):
    B, L, _ = u.shape
    shp = (B, n_chunks, CHUNK, SGU_GROUPS, SGU_GROUP_DIM)
    ug = jax.nn.gelu(u).reshape(shp)
    vg = layer_norm_noaffine(jax.nn.gelu(v).reshape(shp))
    mixed = jnp.einsum('gpq,bnqgc->bnpgc', w_s, vg) + b_s.T[:, :, None]
    return (ug * mixed).reshape(B, L, SGU_WIDTH)


def mixer_output(proj, y_scan, sgu_w, sgu_b, w_out, n_chunks):
    gate = proj[..., LRU_WIDTH:2 * LRU_WIDTH]
    u = proj[..., 2 * LRU_WIDTH:2 * LRU_WIDTH + SGU_WIDTH]
    v = proj[..., 2 * LRU_WIDTH + SGU_WIDTH:]
    y_lru = jax.nn.gelu(gate) * y_scan.astype(proj.dtype)
    y_sgu = spatial_gating(u, v, sgu_w, sgu_b, n_chunks)
    return jnp.concatenate([y_lru, y_sgu], axis=-1) @ w_out


def peer_ffn(h, w_q, k1, k2, u_tab, v_tab):
    B, L, D = h.shape
    blocks = h.reshape((B * L) // PEER_BLOCK, PEER_BLOCK, D)

    def block_fn(hb):
        q = (hb @ w_q).reshape(PEER_BLOCK, PEER_HEADS, 2, PEER_HALF)
        s1 = jnp.einsum('thd,hkd->thk', q[:, :, 0], k1).astype(jnp.float32)
        s2 = jnp.einsum('thd,hkd->thk', q[:, :, 1], k2).astype(jnp.float32)
        v1, i1 = lax.top_k(s1, PEER_TOPK)
        v2, i2 = lax.top_k(s2, PEER_TOPK)
        cand = (v1[..., :, None] + v2[..., None, :]).reshape(PEER_BLOCK, PEER_HEADS, PEER_TOPK * PEER_TOPK)
        sc, flat = lax.top_k(cand, PEER_TOPK)
        e1 = jnp.take_along_axis(i1, flat // PEER_TOPK, axis=-1)
        e2 = jnp.take_along_axis(i2, flat % PEER_TOPK, axis=-1)
        idx = e1 * PEER_NKEYS + e2
        g = jax.nn.softmax(sc, axis=-1)
        u_sel = jnp.take(u_tab, idx, axis=0)
        act = jax.nn.gelu(jnp.einsum('td,thkd->thk', hb, u_sel))
        v_sel = jnp.take(v_tab, idx, axis=0)
        return jnp.einsum('thk,thkd->td', (g * act.astype(jnp.float32)).astype(hb.dtype), v_sel)

    return lax.map(block_fn, blocks).reshape(B, L, D)


def setup_inputs(seed: int = 0) -> dict:
    key = jax.random.key(seed)
    ks = jax.random.split(key, 32)
    f32 = jnp.float32
    D = D_MODEL

    def nrm(k, shape, scale):
        return jax.random.normal(k, shape, f32) * scale

    u_a = jax.random.uniform(ks[14], (DEPTH, 2, LRU_WIDTH), f32, 0.9, 0.999)
    s_a = u_a ** (1.0 / LRU_C)
    lru_lambda = jnp.log(s_a) - jnp.log1p(-s_a)
    return {
        "x": nrm(ks[0], (BATCH, SEQ, D), 1.0),
        "c": nrm(ks[1], (BATCH, D), 1.0),
        "ctx": nrm(ks[2], (BATCH, CTX_LEN, D), 1.0),
        "c_ctx": nrm(ks[3], (D,), 1.0),
        "w_mod": nrm(ks[4], (DEPTH, D, N_MOD * D), D ** -0.5),
        "b_mod": nrm(ks[5], (DEPTH, N_MOD * D), 0.02),
        "norm1_g": 1.0 + nrm(ks[6], (DEPTH, D), 0.02),
        "norm2_g": 1.0 + nrm(ks[7], (DEPTH, D), 0.02),
        "w_in": nrm(ks[8], (DEPTH, D, IN_WIDTH), D ** -0.5),
        "conv_w": nrm(ks[9], (DEPTH, CONV_W, LRU_WIDTH), CONV_W ** -0.5),
        "conv_b": nrm(ks[10], (DEPTH, LRU_WIDTH), 0.02),
        "lru_wa": nrm(ks[11], (DEPTH, 2, LRU_HEADS, LRU_HEAD_DIM, LRU_HEAD_DIM), LRU_HEAD_DIM ** -0.5),
        "lru_ba": nrm(ks[12], (DEPTH, 2, LRU_WIDTH), 0.02),
        "lru_wx": nrm(ks[13], (DEPTH, 2, LRU_HEADS, LRU_HEAD_DIM, LRU_HEAD_DIM), LRU_HEAD_DIM ** -0.5),
        "lru_bx": nrm(ks[15], (DEPTH, 2, LRU_WIDTH), 0.02),
        "lru_lambda": lru_lambda,
        "sgu_w": nrm(ks[16], (DEPTH, SGU_GROUPS, CHUNK, CHUNK), CHUNK ** -0.5),
        "sgu_b": nrm(ks[17], (DEPTH, SGU_GROUPS, CHUNK), 0.02),
        "w_out": nrm(ks[18], (DEPTH, MIX_WIDTH, D), MIX_WIDTH ** -0.5),
        "peer_wq": nrm(ks[19], (DEPTH, D, PEER_HEADS * PEER_QDIM), D ** -0.5),
        "peer_k1": nrm(ks[20], (DEPTH, PEER_HEADS, PEER_NKEYS, PEER_HALF), PEER_HALF ** -0.5),
        "peer_k2": nrm(ks[21], (DEPTH, PEER_HEADS, PEER_NKEYS, PEER_HALF), PEER_HALF ** -0.5),
        "peer_u": nrm(ks[22], (DEPTH, PEER_EXPERTS, D), D ** -0.5),
        "peer_v": nrm(ks[23], (DEPTH, PEER_EXPERTS, D), PEER_HEADS ** -0.5),
        "final_g": 1.0 + nrm(ks[24], (D,), 0.02),
    }


def reference(x, c, ctx, c_ctx, w_mod, b_mod, norm1_g, norm2_g, w_in, conv_w, conv_b,
              lru_wa, lru_ba, lru_wx, lru_bx, lru_lambda, sgu_w, sgu_b, w_out,
              peer_wq, peer_k1, peer_k2, peer_u, peer_v, final_g):
    B, L, _ = x.shape
    rows = L // GRID_W
    lat_chunks = rows // ROWS_PER_CHUNK
    ctx_chunks = ctx.shape[1] // CHUNK
    s_lat = jax.nn.silu(c)
    s_ctx = jax.nn.silu(c_ctx)
    x_lat, x_ctx = x, ctx
    for l in range(DEPTH):
        last = l == DEPTH - 1
        wm, bm = w_mod[l], b_mod[l]
        hn_lat = modulate(rms_norm(x_lat, norm1_g[l]), adaln(s_lat, wm, bm, 0), adaln(s_lat, wm, bm, 1))
        hn_ctx = modulate(rms_norm(x_ctx, norm1_g[l]), adaln(s_ctx, wm, bm, 0), adaln(s_ctx, wm, bm, 1))
        proj_lat = hn_lat @ w_in[l]
        if last:
            proj_ctx_x = hn_ctx @ w_in[l][:, :LRU_WIDTH]
        else:
            proj_ctx = hn_ctx @ w_in[l]
            proj_ctx_x = proj_ctx[..., :LRU_WIDTH]
        xc_lat = centred_conv(proj_lat[..., :LRU_WIDTH], conv_w[l], conv_b[l])
        xc_ctx = centred_conv(proj_ctx_x, conv_w[l], conv_b[l])
        y_scan_lat = jnp.zeros((B, L, LRU_WIDTH), jnp.float32)
        y_scan_ctx = jnp.zeros((B, x_ctx.shape[1], LRU_WIDTH), jnp.float32)
        for d, rev in enumerate((False, True)):
            prm = (lru_wa[l, d], lru_ba[l, d], lru_wx[l, d], lru_bx[l, d], lru_lambda[l, d])
            a_c, b_c = lru_coeffs(xc_ctx, *prm)
            h0 = jnp.zeros((B, LRU_WIDTH), jnp.float32)
            if last:
                h_ctx = scan_final_state(a_c, b_c, h0, rev)
            else:
                h_ctx, ys_c = linear_scan(a_c, b_c, h0, rev)
                y_scan_ctx = y_scan_ctx + ys_c
            a_l, b_l = lru_coeffs(xc_lat, *prm)
            _, ys_l = linear_scan(a_l, b_l, h_ctx, rev)
            y_scan_lat = y_scan_lat + ys_l
        y_lat = mixer_output(proj_lat, y_scan_lat, sgu_w[l], sgu_b[l], w_out[l], lat_chunks)
        x_lat = x_lat + adaln(s_lat, wm, bm, 2) * y_lat
        hn2_lat = modulate(rms_norm(x_lat, norm2_g[l]), adaln(s_lat, wm, bm, 3), adaln(s_lat, wm, bm, 4))
        x_lat = x_lat + adaln(s_lat, wm, bm, 5) * peer_ffn(hn2_lat, peer_wq[l], peer_k1[l], peer_k2[l], peer_u[l], peer_v[l])
        if not last:
            y_ctx = mixer_output(proj_ctx, y_scan_ctx, sgu_w[l], sgu_b[l], w_out[l], ctx_chunks)
            x_ctx = x_ctx + adaln(s_ctx, wm, bm, 2) * y_ctx
            hn2_ctx = modulate(rms_norm(x_ctx, norm2_g[l]), adaln(s_ctx, wm, bm, 3), adaln(s_ctx, wm, bm, 4))
            x_ctx = x_ctx + adaln(s_ctx, wm, bm, 5) * peer_ffn(hn2_ctx, peer_wq[l], peer_k1[l], peer_k2[l], peer_u[l], peer_v[l])
    return rms_norm(x_lat, final_g)
```

```cpp
#include <hip/hip_runtime.h>
#include <hip/hip_cooperative_groups.h>
#include <cstdio>
#include <cstdint>

#ifndef FUSED
#define FUSED 0
#endif

namespace cg = cooperative_groups;

typedef unsigned short bf16_t;
typedef short bf16x8 __attribute__((ext_vector_type(8)));
typedef float f32x4 __attribute__((ext_vector_type(4)));
typedef float f32x2 __attribute__((ext_vector_type(2)));
typedef unsigned u32x4 __attribute__((ext_vector_type(4)));
typedef unsigned u32x2 __attribute__((ext_vector_type(2)));
typedef __bf16 bf16x2_t __attribute__((ext_vector_type(2)));
#define LAS __attribute__((address_space(3)))

constexpr int D = 2048, SEQ = 16384, CTXL = 256;
constexpr int MLAT = 2 * SEQ, MCTX = 2 * CTXL, MALL = MLAT + MCTX;
constexpr int INW = 4096;
constexpr int NSEG = 130;
constexpr float EPS = 1e-6f;

constexpr size_t MiB = 1u << 20;
constexpr size_t WS_CTL = 0;
constexpr size_t WS_MOD = 1 * MiB;
constexpr size_t WS_SP = 1 * MiB + 512 * 1024;
constexpr size_t WS_WIN = 4 * MiB;
constexpr size_t WS_WOUT = 20 * MiB;
constexpr size_t WS_WQ = 28 * MiB;
constexpr size_t WS_SGUW = 36 * MiB;
constexpr size_t WS_K1 = 36 * MiB + 256 * 1024;
constexpr size_t WS_K2 = 36 * MiB + 512 * 1024;
constexpr size_t WS_LRUW = 37 * MiB;
constexpr size_t WS_SUMS = 38 * MiB;
constexpr size_t WS_UB = 44 * MiB;
constexpr size_t WS_VB = 108 * MiB;
constexpr size_t WS_HN = 172 * MiB;
constexpr size_t WS_PROJ = 302 * MiB;
constexpr size_t WS_TOPI = 562 * MiB;
constexpr size_t WS_TOPG = 578 * MiB;
constexpr size_t WS_END = 594 * MiB;

constexpr int LDS_BYTES = 159744;
constexpr int NPHASES = 10;

struct Params {
    const float *x, *c, *ctx, *c_ctx, *w_mod, *b_mod, *g1, *g2, *w_in, *conv_w, *conv_b, *lru_wa, *lru_ba, *lru_wx, *lru_bx, *lru_lam,
        *sgu_w, *sgu_b, *w_out, *wq, *k1, *k2, *pu, *pv, *fg;
    float* out;
    unsigned char* ws;
};

__device__ __forceinline__ unsigned f2bf(float f) { unsigned u = __builtin_bit_cast(unsigned, f); return (u + 0x7fffu + ((u >> 16) & 1u)) >> 16; }
__device__ __forceinline__ unsigned pk2(float lo, float hi) { return f2bf(lo) | (f2bf(hi) << 16); }
__device__ __forceinline__ float bflo(unsigned u) { return __builtin_bit_cast(float, u << 16); }
__device__ __forceinline__ float bfhi(unsigned u) { return __builtin_bit_cast(float, u & 0xffff0000u); }
__device__ __forceinline__ float bf1(bf16_t u) { return __builtin_bit_cast(float, (unsigned)u << 16); }
__device__ __forceinline__ float sigmoidf_(float x) { return __builtin_amdgcn_rcpf(1.0f + __expf(-x)); }
__device__ __forceinline__ float gelu_tanh(float x) {
    const float u = 1.5957691216057308f * (x + 0.044715f * x * x * x);
    return x * __builtin_amdgcn_rcpf(1.0f + __expf(-u));
}
__device__ __forceinline__ float wave_sum(float v) {
#pragma unroll
    for (int o = 1; o < 64; o <<= 1) v += __shfl_xor(v, o);
    return v;
}
__device__ __forceinline__ int mono(float v) { int b = __builtin_bit_cast(int, v); return b ^ ((b >> 31) & 0x7fffffff); }
__device__ __forceinline__ float unmono(int m) { int b = m ^ ((m >> 31) & 0x7fffffff); return __builtin_bit_cast(float, b); }

namespace pg8 {
constexpr int BM = 256, BK = 64, HALF = 128, HTB = HALF * BK * 2, STAGE_BYTES = 8 * HTB, NXCD = 8, WGM = 8;
__host__ __device__ __forceinline__ int lds_byte(int r, int c) { const int st = (r >> 4) * 2 + (c >> 5), rr = r & 15, cc = c & 31, ob = rr * 64 + cc * 2; return st * 1024 + (ob ^ (((ob >> 9) & 1) << 5)); }
__host__ __device__ __forceinline__ void stage_rc(int b, int& R, int& C) { const int st = b / 1024, sb = b % 1024, swz = sb ^ (((sb >> 9) & 1) << 5); R = (st >> 1) * 16 + swz / 64; C = (st & 1) * 32 + (swz % 64) / 2; }
__host__ __device__ __forceinline__ int perm32(int rho) { const int n = rho >> 4, i = rho & 15; return 8 * (i >> 2) + 4 * n + (i & 3); }
struct Unit { int pm, pn; };
struct Gemm { const bf16_t* A; const bf16_t* Bt; int M, N, K; };
struct StaticOrder {
    int nM, nN, nwg, G, c;
    __host__ __device__ void init(int M, int N, int G_, int c_) { nM = M / BM; nN = N / BM; nwg = nM * nN; G = G_; c = c_; }
    __host__ __device__ bool next(int i, Unit& u) const {
        const long L = (long)i * G + c; if (L >= nwg) return false;
        int wgid = (int)L; { const int q = nwg / NXCD, r = nwg % NXCD, xcd = wgid % NXCD, off = wgid / NXCD; wgid = (xcd < r ? xcd * (q + 1) : r * (q + 1) + (xcd - r) * q) + off; }
        const int nig = WGM * nN, gid = wgid / nig, fm = gid * WGM, gsz = (nM - fm) < WGM ? (nM - fm) : WGM;
        u.pm = fm + ((wgid % nig) % gsz); u.pn = (wgid % nig) / gsz; return true;
    }
};
__device__ __forceinline__ unsigned cvt_pk_bf16(float lo, float hi) { unsigned r; asm volatile("v_cvt_pk_bf16_f32 %0, %1, %2" : "=v"(r) : "v"(lo), "v"(hi)); return r; }

struct EpiBf16 {
    static constexpr bool PERM = true;
    bf16_t* O; int ldc;
    __device__ __forceinline__ void operator()(const f32x4 (&acc)[2][2][4][2], const Unit& u, int wr, int wc, int fr, int fq) const {
        const int row0 = u.pm * BM + wr * 64 + fr; const int col0 = u.pn * BM + wc * 32 + 8 * fq;
#pragma unroll
        for (int ai = 0; ai < 2; ++ai)
#pragma unroll
            for (int m = 0; m < 4; ++m) { bf16_t* rowp = O + (size_t)(row0 + ai * HALF + m * 16) * ldc + col0;
#pragma unroll
                for (int bj = 0; bj < 2; ++bj) { const f32x4 v0 = acc[ai][bj][m][0], v1 = acc[ai][bj][m][1];
                    u32x4 w; w.x = cvt_pk_bf16(v0[0], v0[1]); w.y = cvt_pk_bf16(v0[2], v0[3]); w.z = cvt_pk_bf16(v1[0], v1[1]); w.w = cvt_pk_bf16(v1[2], v1[3]);
                    *(u32x4*)(rowp + bj * HALF) = w; } }
    }
};
struct EpiRes {
    static constexpr bool PERM = false;
    const float* base; float* out; int ldc; const float* gate; int gate_stride; int rows_per_batch;
    __device__ __forceinline__ void operator()(const f32x4 (&acc)[2][2][4][2], const Unit& u, int wr, int wc, int fr, int fq) const {
        const int col0 = u.pn * BM + wc * 32 + 4 * fq;
        const int bsel = (u.pm * BM) / rows_per_batch;
        f32x4 gv[2][2];
#pragma unroll
        for (int bj = 0; bj < 2; ++bj)
#pragma unroll
            for (int n = 0; n < 2; ++n) gv[bj][n] = *(const f32x4*)(gate + (size_t)bsel * gate_stride + col0 + bj * HALF + n * 16);
#pragma unroll
        for (int ai = 0; ai < 2; ++ai)
#pragma unroll
            for (int m = 0; m < 4; ++m) { const size_t off = (size_t)(u.pm * BM + ai * HALF + wr * 64 + m * 16 + fr) * ldc + col0;
#pragma unroll
                for (int bj = 0; bj < 2; ++bj)
#pragma unroll
                    for (int n = 0; n < 2; ++n) { const f32x4 bs = *(const f32x4*)(base + off + bj * HALF + n * 16);
                        *(f32x4*)(out + off + bj * HALF + n * 16) = bs + gv[bj][n] * acc[ai][bj][m][n]; } }
    }
};

template <class Epi>
__device__ __forceinline__ void gemm_phase(LAS unsigned char* lds, const Gemm g, const StaticOrder& S, const Epi& E) {
    int tid = threadIdx.x; asm volatile("" : "+v"(tid));
    const int wid = __builtin_amdgcn_readfirstlane(tid >> 6), lane = tid & 63, wr = wid >> 2, wc = wid & 3, fr = lane & 15, fq = lane >> 4;
    const int K = g.K, nt = K / BK;
    unsigned voffA[2], voffB[2];
#pragma unroll
    for (int i = 0; i < 2; ++i) { int R, C; stage_rc(tid * 16 + i * 8192, R, C); const int Rb = Epi::PERM ? ((R & ~31) + perm32(R & 31)) : R;
        voffA[i] = (unsigned)(R * K + C) * 2u; voffB[i] = (unsigned)(Rb * K + C) * 2u; }
    const size_t kstep = (size_t)(BK * 2);
    const size_t hstep = (size_t)HALF * K * 2;
    const size_t tstep = 2 * hstep;
    const unsigned ldsw = (unsigned)wid * 1024u;
    const int aoff = lds_byte(wr * 64 + fr, fq * 8), boff = lds_byte(wc * 32 + fr, fq * 8);
#define PG8_SA(b, h) (((b) * 2 + (h)) * HTB)
#define PG8_SB(b, h) ((4 + (b) * 2 + (h)) * HTB)
#define PG8_STAGE(bufoff, gbase, voff) do { _Pragma("unroll") for (int _i = 0; _i < 2; ++_i) \
        __builtin_amdgcn_global_load_lds((const unsigned*)((const char*)(gbase) + (voff)[_i]), (LAS unsigned*)(lds + (bufoff) + ldsw + _i * 8192), 16, 0, 0); } while (0)
#define PG8_LDA(dst, b, h) do { _Pragma("unroll") for (int m = 0; m < 4; ++m) _Pragma("unroll") for (int k = 0; k < 2; ++k) dst[m][k] = *(const LAS bf16x8*)(lds + PG8_SA(b, h) + aoff + m * 2048 + k * 1024); } while (0)
#define PG8_LDB(dst, b, h) do { _Pragma("unroll") for (int n = 0; n < 2; ++n) _Pragma("unroll") for (int k = 0; k < 2; ++k) dst[n][k] = *(const LAS bf16x8*)(lds + PG8_SB(b, h) + boff + n * 2048 + k * 1024); } while (0)
#define PG8_MMA(ai, bj, At, Bt) do { __builtin_amdgcn_s_setprio(1); _Pragma("unroll") for (int m = 0; m < 4; ++m) _Pragma("unroll") for (int n = 0; n < 2; ++n) _Pragma("unroll") for (int k = 0; k < 2; ++k) \
        acc[ai][bj][m][n] = __builtin_amdgcn_mfma_f32_16x16x32_bf16(Bt[n][k], At[m][k], acc[ai][bj][m][n], 0, 0, 0); __builtin_amdgcn_s_setprio(0); } while (0)
#define PG8_WAIT_V(n) asm volatile("s_waitcnt vmcnt(" #n ")" ::: "memory")
#define PG8_WAIT_L(n) asm volatile("s_waitcnt lgkmcnt(" #n ")" ::: "memory")
#define PG8_BAR __builtin_amdgcn_s_barrier()
#define PG8_SCHED __builtin_amdgcn_sched_barrier(0)
    Unit cur, nxt; int ui = 0;
    if (!S.next(0, cur)) return;
    f32x4 acc[2][2][4][2];
#pragma unroll
    for (int a = 0; a < 2; ++a)
#pragma unroll
        for (int b = 0; b < 2; ++b)
#pragma unroll
            for (int m = 0; m < 4; ++m)
#pragma unroll
                for (int n = 0; n < 2; ++n) acc[a][b][m][n] = (f32x4){0.f, 0.f, 0.f, 0.f};
    bf16x8 At[4][2], B0[2][2], B1[2][2];
    const char* cA = (const char*)g.A + (size_t)cur.pm * tstep; const char* cB = (const char*)g.Bt + (size_t)cur.pn * tstep;
    PG8_STAGE(PG8_SB(0, 0), cB, voffB); PG8_STAGE(PG8_SB(0, 1), cB + hstep, voffB); PG8_STAGE(PG8_SA(0, 0), cA, voffA); PG8_STAGE(PG8_SA(0, 1), cA + hstep, voffA);
    if (wr == 1) PG8_BAR;
    PG8_WAIT_V(2); PG8_BAR;
    PG8_STAGE(PG8_SB(1, 0), cB + kstep, voffB); PG8_STAGE(PG8_SA(1, 0), cA + kstep, voffA); PG8_STAGE(PG8_SB(1, 1), cB + hstep + kstep, voffB);
    PG8_WAIT_V(6); PG8_BAR;
    for (;;) {
        const bool has_next = S.next(ui + 1, nxt);
        const char* nA = has_next ? (const char*)g.A + (size_t)nxt.pm * tstep : cA; const char* nB = has_next ? (const char*)g.Bt + (size_t)nxt.pn * tstep : cB;
        for (int t = 0; t < nt; t += 2) {
            const bool last = (t == nt - 2);
            const char* a1 = cA + (size_t)(t + 1) * kstep;
            const char* a2 = last ? nA : cA + (size_t)(t + 2) * kstep; const char* b2 = last ? nB : cB + (size_t)(t + 2) * kstep;
            const char* a3 = a2 + kstep; const char* b3 = b2 + kstep;
            PG8_LDB(B0, 0, 0); PG8_LDB(B1, 0, 1); PG8_SCHED; PG8_LDA(At, 0, 0); PG8_STAGE(PG8_SA(1, 1), a1 + hstep, voffA);
            PG8_WAIT_V(8); PG8_WAIT_L(0); PG8_BAR; PG8_MMA(0, 0, At, B0); PG8_MMA(0, 1, At, B1); PG8_BAR; PG8_SCHED;
            PG8_LDA(At, 0, 1); PG8_STAGE(PG8_SB(0, 0), b2, voffB); PG8_STAGE(PG8_SB(0, 1), b2 + hstep, voffB); PG8_STAGE(PG8_SA(0, 0), a2, voffA);
            PG8_WAIT_V(8); PG8_WAIT_L(0); PG8_BAR; PG8_MMA(1, 0, At, B0); PG8_MMA(1, 1, At, B1); PG8_BAR; PG8_SCHED;
            PG8_LDB(B0, 1, 0); PG8_LDB(B1, 1, 1); PG8_SCHED; PG8_LDA(At, 1, 0); PG8_STAGE(PG8_SA(0, 1), a2 + hstep, voffA);
            PG8_WAIT_V(8); PG8_WAIT_L(0); PG8_BAR; PG8_MMA(0, 0, At, B0); PG8_MMA(0, 1, At, B1); PG8_BAR; PG8_SCHED;
            PG8_LDA(At, 1, 1); PG8_STAGE(PG8_SB(1, 0), b3, voffB); PG8_STAGE(PG8_SB(1, 1), b3 + hstep, voffB); PG8_STAGE(PG8_SA(1, 0), a3, voffA);
            PG8_WAIT_V(8); PG8_WAIT_L(0); PG8_BAR; PG8_MMA(1, 0, At, B0); PG8_MMA(1, 1, At, B1); PG8_BAR; PG8_SCHED;
        }
        if (wr == 0) PG8_BAR;
        E(acc, cur, wr, wc, fr, fq);
        if (!has_next) break;
#pragma unroll
        for (int a = 0; a < 2; ++a)
#pragma unroll
            for (int b = 0; b < 2; ++b)
#pragma unroll
                for (int m = 0; m < 4; ++m)
#pragma unroll
                    for (int n = 0; n < 2; ++n) acc[a][b][m][n] = (f32x4){0.f, 0.f, 0.f, 0.f};
        cur = nxt; cA = nA; cB = nB; ++ui;
        if (wr == 1) PG8_BAR;
    }
    PG8_WAIT_V(0);
    PG8_BAR;
#undef PG8_SA
#undef PG8_SB
#undef PG8_STAGE
#undef PG8_LDA
#undef PG8_LDB
#undef PG8_MMA
#undef PG8_WAIT_V
#undef PG8_WAIT_L
#undef PG8_BAR
#undef PG8_SCHED
}
}

__device__ __forceinline__ void p0_transpose_item(const float* W, int K, int N, bf16_t* WT, float* scr, int item, int lane) {
    const int nblk = N / 32, kb = item / nblk, nb = item % nblk, k0 = 64 * kb, n0 = 32 * nb;
#pragma unroll 8
    for (int i = 0; i < 32; ++i) { const int kk = 2 * i + (lane >> 5); scr[kk * 33 + (lane & 31)] = W[(size_t)(k0 + kk) * N + n0 + (lane & 31)]; }
    asm volatile("s_waitcnt lgkmcnt(0)" ::: "memory");
    const int c = lane & 7;
#pragma unroll
    for (int j = 0; j < 4; ++j) { const int n = (lane >> 3) + 8 * j; const float* s = scr + (8 * c) * 33 + n;
        u32x4 o; o.x = pk2(s[0 * 33], s[1 * 33]); o.y = pk2(s[2 * 33], s[3 * 33]); o.z = pk2(s[4 * 33], s[5 * 33]); o.w = pk2(s[6 * 33], s[7 * 33]);
        *(u32x4*)(WT + (size_t)(n0 + n) * K + k0 + 8 * c) = o; }
    asm volatile("s_waitcnt lgkmcnt(0)" ::: "memory");
}
__device__ __forceinline__ void cvt_item(const float* src, bf16_t* dst, size_t item, int lane) {
    const f32x4* s = (const f32x4*)(src + item * 512) + lane * 2; const f32x4 a = s[0], b = s[1];
    u32x4 o; o.x = pk2(a[0], a[1]); o.y = pk2(a[2], a[3]); o.z = pk2(b[0], b[1]); o.w = pk2(b[2], b[3]);
    *((u32x4*)(dst + item * 512) + lane) = o;
}

__device__ __forceinline__ void phase0(const Params& p, unsigned char* lds, int bid, int nblk) {
    int tid = threadIdx.x; asm volatile("" : "+v"(tid));
    const int lane = tid & 63, wave = __builtin_amdgcn_readfirstlane(tid >> 6);
    float* s_lds = (float*)lds;
    float* red = (float*)(lds + 24576);
    float* scr = (float*)(lds + 49152 + wave * 8448);
    float* MOD = (float*)(p.ws + WS_MOD);
    for (int i = tid; i < 3 * 2048; i += 512) { const int v = i >> 11, k = i & 2047; const float cv = (v < 2) ? p.c[v * 2048 + k] : p.c_ctx[k]; s_lds[i] = cv * sigmoidf_(cv); }
    __syncthreads();
    for (int it = bid; it < 256; it += nblk) {
        const int col0 = it * 48; const int cgp = tid % 12, kl = tid / 12;
        f32x4 a0 = {0.f, 0.f, 0.f, 0.f}, a1 = a0, a2 = a0;
        if (tid < 504) {
            const float* wp = p.w_mod + col0 + 4 * cgp;
#pragma unroll 7
            for (int k = kl; k < 2048; k += 42) { const f32x4 w = *(const f32x4*)(wp + (size_t)k * 12288); a0 += w * s_lds[k]; a1 += w * s_lds[2048 + k]; a2 += w * s_lds[4096 + k]; }
            float* r = red + kl * 144 + cgp * 4;
            *(f32x4*)(r) = a0; *(f32x4*)(r + 48) = a1; *(f32x4*)(r + 96) = a2;
        }
        __syncthreads();
        if (tid < 144) { float s = 0.f; for (int k = 0; k < 42; ++k) s += red[k * 144 + tid]; const int v = tid / 48, col = col0 + tid % 48; MOD[v * 12288 + col] = s + p.b_mod[col]; }
        __syncthreads();
    }
    if (bid == 0) { float* SP = (float*)(p.ws + WS_SP); for (int i = tid; i < 2048; i += 512) SP[i] = log1pf(expf(-p.lru_lam[i])); }
    const int gw = bid * 8 + wave, NGW = nblk * 8;
    constexpr int I_IN = 32 * 128, I_OUT = 32 * 64, I_Q = 32 * 64, I_LRU = 32 * 8;
    for (int it = gw; it < I_IN + I_OUT + I_Q + I_LRU; it += NGW) {
        int r = it;
        if (r < I_LRU) { const int mat = r >> 3, d = mat >> 4, m = (mat >> 3) & 1, h = mat & 7;
            p0_transpose_item((m ? p.lru_wx : p.lru_wa) + (size_t)(d * 8 + h) * 16384, 128, 128, (bf16_t*)(p.ws + WS_LRUW) + (size_t)mat * 16384, scr, r & 7, lane); continue; } r -= I_LRU;
        if (r < I_IN) { p0_transpose_item(p.w_in, 2048, 4096, (bf16_t*)(p.ws + WS_WIN), scr, r, lane); continue; } r -= I_IN;
        if (r < I_OUT) { p0_transpose_item(p.w_out, 2048, 2048, (bf16_t*)(p.ws + WS_WOUT), scr, r, lane); continue; } r -= I_OUT;
        p0_transpose_item(p.wq, 2048, 2048, (bf16_t*)(p.ws + WS_WQ), scr, r, lane);
    }
    constexpr int C_SM = 256, C_TAB = 65536;
    for (int it = gw; it < 3 * C_SM + 2 * C_TAB; it += NGW) {
        int r = it;
        if (r < C_SM) { cvt_item(p.sgu_w, (bf16_t*)(p.ws + WS_SGUW), r, lane); continue; } r -= C_SM;
        if (r < C_SM) { cvt_item(p.k1, (bf16_t*)(p.ws + WS_K1), r, lane); continue; } r -= C_SM;
        if (r < C_SM) { cvt_item(p.k2, (bf16_t*)(p.ws + WS_K2), r, lane); continue; } r -= C_SM;
        if (r < C_TAB) { cvt_item(p.pu, (bf16_t*)(p.ws + WS_UB), r, lane); continue; } r -= C_TAB;
        cvt_item(p.pv, (bf16_t*)(p.ws + WS_VB), r, lane);
    }
}

__device__ __forceinline__ void norm_row(const float* xrow, const float* g, const float* shift, const float* scale, bf16_t* orow, int lane) {
    f32x4 v[8]; float ss = 0.f;
#pragma unroll
    for (int j = 0; j < 8; ++j) { v[j] = *((const f32x4*)xrow + lane + 64 * j); ss += (v[j][0] * v[j][0] + v[j][1] * v[j][1]) + (v[j][2] * v[j][2] + v[j][3] * v[j][3]); }
    const float rstd = rsqrtf(wave_sum(ss) * (1.0f / 2048.0f) + EPS);
#pragma unroll
    for (int j = 0; j < 8; ++j) {
        const f32x4 gg = *((const f32x4*)g + lane + 64 * j), sh = *((const f32x4*)shift + lane + 64 * j), sc = *((const f32x4*)scale + lane + 64 * j);
        const f32x4 h = (v[j] * rstd) * gg * (sc + 1.0f) + sh;
        u32x2 o; o.x = pk2(h[0], h[1]); o.y = pk2(h[2], h[3]);
        *((u32x2*)orow + lane + 64 * j) = o;
    }
}
__device__ __forceinline__ void phase_norm1(const Params& p, int bid, int nblk) {
    int tid = threadIdx.x; asm volatile("" : "+v"(tid));
    const int lane = tid & 63, wave = __builtin_amdgcn_readfirstlane(tid >> 6);
    const float* MOD = (const float*)(p.ws + WS_MOD); bf16_t* HN = (bf16_t*)(p.ws + WS_HN);
    for (int row = bid * 8 + wave; row < MALL; row += nblk * 8) {
        const bool isctx = row >= MLAT; const int v = isctx ? 2 : (row >> 14);
        const float* xr = isctx ? p.ctx + (size_t)(row - MLAT) * D : p.x + (size_t)row * D;
        norm_row(xr, p.g1, MOD + v * 12288, MOD + v * 12288 + 2048, HN + (size_t)row * D, lane);
    }
}
__device__ __forceinline__ void phase_norm2(const Params& p, int bid, int nblk) {
    int tid = threadIdx.x; asm volatile("" : "+v"(tid));
    const int lane = tid & 63, wave = __builtin_amdgcn_readfirstlane(tid >> 6);
    const float* MOD = (const float*)(p.ws + WS_MOD); bf16_t* HN = (bf16_t*)(p.ws + WS_HN);
    for (int row = bid * 8 + wave; row < MLAT; row += nblk * 8) {
        const int v = row >> 14;
        norm_row(p.out + (size_t)row * D, p.g2, MOD + v * 12288 + 3 * 2048, MOD + v * 12288 + 4 * 2048, HN + (size_t)row * D, lane);
    }
}

constexpr int XCB_LD = 136, XCF_LD = 132;
__device__ __forceinline__ void lru_gates(const bf16_t* xcb, const float* xcf, int mt, int cc, int q4, int chl, const bf16x8 (&Bwa)[4], const bf16x8 (&Bwx)[4],
                                          float ba, float bx, float sp, float (&a)[4], float (&b)[4]) {
    f32x4 ga = {0.f, 0.f, 0.f, 0.f}, gx = {0.f, 0.f, 0.f, 0.f};
#pragma unroll
    for (int ks = 0; ks < 4; ++ks) {
        const bf16x8 A = *(const bf16x8*)(xcb + (16 * mt + cc) * XCB_LD + 32 * ks + 8 * q4);
        ga = __builtin_amdgcn_mfma_f32_16x16x32_bf16(A, Bwa[ks], ga, 0, 0, 0);
        gx = __builtin_amdgcn_mfma_f32_16x16x32_bf16(A, Bwx[ks], gx, 0, 0, 0);
    }
#pragma unroll
    for (int r = 0; r < 4; ++r) {
        const float xv = xcf[(16 * mt + 4 * q4 + r) * XCF_LD + chl];
        const float rg = sigmoidf_(ga[r] + ba), ig = sigmoidf_(gx[r] + bx);
        const float la = -8.0f * rg * sp;
        a[r] = __expf(la);
        const float t = 2.0f * la;
        float em;
        if (t > -0.35f) { float q = 1.0f / 5040.0f; q = q * t + 1.0f / 720.0f; q = q * t + 1.0f / 120.0f; q = q * t + 1.0f / 24.0f; q = q * t + 1.0f / 6.0f; q = q * t + 0.5f; q = q * t + 1.0f; em = -(q * t); }
        else em = 1.0f - __expf(t);
        b[r] = sqrtf(em) * ig * xv;
    }
}

template <bool APPLY>
__device__ __forceinline__ void lru_phase(const Params& p, unsigned char* lds, int bid, int nblk) {
    int tid = threadIdx.x; asm volatile("" : "+v"(tid));
    const int lane = tid & 63, w = __builtin_amdgcn_readfirstlane(tid >> 6), cc = lane & 15, q4 = lane >> 4;
    bf16_t* xcb = (bf16_t*)lds;
    float* xcf = (float*)(lds + 34816);
    bf16_t* gl = (bf16_t*)(lds + 102400);
    float* carry = (float*)(lds + 137216);
    float* cw = (float*)(lds + 138240);
    const bf16_t* PROJ = (const bf16_t*)(p.ws + WS_PROJ);
    float* SUMS = (float*)(p.ws + WS_SUMS);
    const float* SP = (const float*)(p.ws + WS_SP);
    bf16_t* Y = (bf16_t*)(p.ws + WS_HN);
    const bf16_t* LRUW = (const bf16_t*)(p.ws + WS_LRUW);
    constexpr int NS = APPLY ? 128 : NSEG;
    const int nitems = 2 * NS * 8;
    int cur_h = -1;
    const int chl = 16 * w + cc;
#define LRU_LOADW(d_) bf16x8 Bwa[4], Bwx[4]; float ba_, bx_, sp_; { \
        const bf16_t* wa_ = LRUW + ((size_t)(((d_) * 2 + 0) * 8 + h) * 128 + chl) * 128 + 8 * q4; const bf16_t* wx_ = LRUW + ((size_t)(((d_) * 2 + 1) * 8 + h) * 128 + chl) * 128 + 8 * q4; \
        _Pragma("unroll") for (int ks = 0; ks < 4; ++ks) { Bwa[ks] = *(const bf16x8*)(wa_ + 32 * ks); Bwx[ks] = *(const bf16x8*)(wx_ + 32 * ks); } \
        ba_ = p.lru_ba[(d_) * 1024 + h * 128 + chl]; bx_ = p.lru_bx[(d_) * 1024 + h * 128 + chl]; sp_ = SP[(d_) * 1024 + h * 128 + chl]; }
    for (int it = bid; it < nitems; it += nblk) {
        const int h = it & 7, bs = it >> 3, b = bs / NS, sg = bs % NS;
        const int seg = APPLY ? sg + 2 : sg;
        const bool isctx = seg < 2;
        const int L = isctx ? CTXL : SEQ;
        const int p0 = isctx ? seg * 128 : (seg - 2) * 128;
        const size_t rowbase = isctx ? (size_t)(MLAT + b * CTXL) : (size_t)b * SEQ;
        if (h != cur_h) {
            cur_h = h;
            for (int i = tid; i < 640; i += 512) { const int k = i >> 7, ch = i & 127; cw[i] = (k < 4) ? p.conv_w[k * 1024 + h * 128 + ch] : p.conv_b[h * 128 + ch]; }
            __syncthreads();
        }
        if (APPLY) {
            if (tid < 256) {
                const int d = tid >> 7, ch = tid & 127; const int gch = h * 128 + ch;
                const float* sb = SUMS + (size_t)b * NSEG * 4096 + d * 2048 + gch;
                float hst = 0.f;
                if (d == 0) { for (int s = 0; s < seg; ++s) hst = sb[(size_t)s * 4096] * hst + sb[(size_t)s * 4096 + 1024]; }
                else { hst = sb[4096 + 1024]; hst = sb[0] * hst + sb[1024]; for (int s = NSEG - 1; s > seg; --s) hst = sb[(size_t)s * 4096] * hst + sb[(size_t)s * 4096 + 1024]; }
                carry[tid] = hst;
            }
        }
        {
            const int pos = tid >> 2, qd = tid & 3;
            u32x4 rv[4][4];
#pragma unroll
            for (int k = 0; k < 4; ++k) { const int r = p0 + pos + k - 2; const bool ok = (r >= 0) && (r < L);
                const u32x4* src = (const u32x4*)(PROJ + (rowbase + (size_t)(ok ? r : 0)) * INW + h * 128 + 32 * qd);
#pragma unroll
                for (int e = 0; e < 4; ++e) rv[k][e] = ok ? src[e] : (u32x4){0u, 0u, 0u, 0u}; }
#pragma unroll
            for (int e = 0; e < 4; ++e) {
                float xo[8];
#pragma unroll
                for (int j = 0; j < 8; ++j) { const int ch = 32 * qd + 8 * e + j; float s = cw[512 + ch];
#pragma unroll
                    for (int k = 0; k < 4; ++k) { const unsigned wv = rv[k][e][j >> 1]; const float xv = (j & 1) ? bfhi(wv) : bflo(wv); s += cw[k * 128 + ch] * xv; }
                    xo[j] = s; }
                *(f32x4*)(xcf + pos * XCF_LD + 32 * qd + 8 * e) = (f32x4){xo[0], xo[1], xo[2], xo[3]};
                *(f32x4*)(xcf + pos * XCF_LD + 32 * qd + 8 * e + 4) = (f32x4){xo[4], xo[5], xo[6], xo[7]};
                u32x4 o; o.x = pk2(xo[0], xo[1]); o.y = pk2(xo[2], xo[3]); o.z = pk2(xo[4], xo[5]); o.w = pk2(xo[6], xo[7]);
                *(u32x4*)(xcb + pos * XCB_LD + 32 * qd + 8 * e) = o;
            }
            if (APPLY) {
                const u32x4* gs = (const u32x4*)(PROJ + (rowbase + p0 + pos) * INW + 1024 + h * 128 + 32 * qd);
#pragma unroll
                for (int e = 0; e < 4; ++e) *(u32x4*)(gl + pos * XCB_LD + 32 * qd + 8 * e) = gs[e];
            }
        }
        __syncthreads();
        if (APPLY) {
            float y[8][4];
            {
                LRU_LOADW(0)
                float st = carry[chl];
#pragma unroll
                for (int mt = 0; mt < 8; ++mt) {
                    float a[4], bb[4];
                    lru_gates(xcb, xcf, mt, cc, q4, chl, Bwa, Bwx, ba_, bx_, sp_, a, bb);
                    float A4 = a[0], B4 = bb[0];
#pragma unroll
                    for (int r = 1; r < 4; ++r) { B4 = a[r] * B4 + bb[r]; A4 *= a[r]; }
                    const float A0 = __shfl(A4, cc), A1 = __shfl(A4, cc + 16), A2 = __shfl(A4, cc + 32), A3 = __shfl(A4, cc + 48);
                    const float B0 = __shfl(B4, cc), B1 = __shfl(B4, cc + 16), B2 = __shfl(B4, cc + 32), B3 = __shfl(B4, cc + 48);
                    const float s0 = st, s1 = A0 * s0 + B0, s2 = A1 * s1 + B1, s3 = A2 * s2 + B2, s4 = A3 * s3 + B3;
                    float hh = (q4 == 0) ? s0 : (q4 == 1) ? s1 : (q4 == 2) ? s2 : s3;
#pragma unroll
                    for (int r = 0; r < 4; ++r) { hh = a[r] * hh + bb[r]; y[mt][r] = hh; }
                    st = s4;
                    __builtin_amdgcn_sched_barrier(0);
                }
            }
            {
                LRU_LOADW(1)
                float st = carry[128 + chl];
#pragma unroll
                for (int mi = 0; mi < 8; ++mi) {
                    const int mt = 7 - mi;
                    float a[4], bb[4];
                    lru_gates(xcb, xcf, mt, cc, q4, chl, Bwa, Bwx, ba_, bx_, sp_, a, bb);
                    float A4 = a[3], B4 = bb[3];
#pragma unroll
                    for (int r = 2; r >= 0; --r) { B4 = a[r] * B4 + bb[r]; A4 *= a[r]; }
                    const float A0 = __shfl(A4, cc), A1 = __shfl(A4, cc + 16), A2 = __shfl(A4, cc + 32), A3 = __shfl(A4, cc + 48);
                    const float B0 = __shfl(B4, cc), B1 = __shfl(B4, cc + 16), B2 = __shfl(B4, cc + 32), B3 = __shfl(B4, cc + 48);
                    const float s0 = st, s1 = A3 * s0 + B3, s2 = A2 * s1 + B2, s3 = A1 * s2 + B1, s4 = A0 * s3 + B0;
                    float hh = (q4 == 3) ? s0 : (q4 == 2) ? s1 : (q4 == 1) ? s2 : s3;
#pragma unroll
                    for (int r = 3; r >= 0; --r) { hh = a[r] * hh + bb[r]; y[mt][r] += hh; }
                    st = s4;
                    __builtin_amdgcn_sched_barrier(0);
                }
            }
#pragma unroll
            for (int mt = 0; mt < 8; ++mt)
#pragma unroll
                for (int r = 0; r < 4; ++r) { bf16_t* gp = gl + (16 * mt + 4 * q4 + r) * XCB_LD + chl; const float gv = bf1(*gp); *gp = (bf16_t)f2bf(gelu_tanh(gv) * y[mt][r]); }
            __syncthreads();
            {
                const int pos = tid >> 2, qd = tid & 3;
                u32x4* dst = (u32x4*)(Y + (rowbase + p0 + pos) * D + h * 128 + 32 * qd);
#pragma unroll
                for (int e = 0; e < 4; ++e) dst[e] = *(const u32x4*)(gl + pos * XCB_LD + 32 * qd + 8 * e);
            }
        } else {
#pragma unroll
            for (int d = 0; d < 2; ++d) {
                LRU_LOADW(d)
                float TA = 1.f, TB = 0.f;
#pragma unroll 1
                for (int mt = 0; mt < 8; ++mt) {
                    float a[4], bb[4];
                    lru_gates(xcb, xcf, mt, cc, q4, chl, Bwa, Bwx, ba_, bx_, sp_, a, bb);
                    float A4, B4;
                    if (d == 0) { A4 = a[0]; B4 = bb[0];
#pragma unroll
                        for (int r = 1; r < 4; ++r) { B4 = a[r] * B4 + bb[r]; A4 *= a[r]; } }
                    else { A4 = a[3]; B4 = bb[3];
#pragma unroll
                        for (int r = 2; r >= 0; --r) { B4 = a[r] * B4 + bb[r]; A4 *= a[r]; } }
                    const float A0 = __shfl(A4, cc), A1 = __shfl(A4, cc + 16), A2 = __shfl(A4, cc + 32), A3 = __shfl(A4, cc + 48);
                    const float B0 = __shfl(B4, cc), B1 = __shfl(B4, cc + 16), B2 = __shfl(B4, cc + 32), B3 = __shfl(B4, cc + 48);
                    float At, Bt;
                    if (d == 0) { At = A0 * A1 * A2 * A3; Bt = ((B0 * A1 + B1) * A2 + B2) * A3 + B3; TB = At * TB + Bt; TA = TA * At; }
                    else { At = A0 * A1 * A2 * A3; Bt = ((B3 * A2 + B2) * A1 + B1) * A0 + B0; TB = TA * Bt + TB; TA = At * TA; }
                }
                if (q4 == 0) { float* sb = SUMS + ((size_t)(b * NSEG + seg) * 2 + d) * 2048 + h * 128 + chl; sb[0] = TA; sb[1024] = TB; }
            }
        }
        __syncthreads();
    }
}

__device__ __forceinline__ void sgu_phase(const Params& p, unsigned char* lds, int bid, int nblk) {
    int tid = threadIdx.x; asm volatile("" : "+v"(tid));
    const int lane = tid & 63, w = __builtin_amdgcn_readfirstlane(tid >> 6), cc = lane & 15, q4 = lane >> 4;
    bf16_t* vgT = (bf16_t*)lds;
    float* part = (float*)(lds + 34816);
    const bf16_t* PROJ = (const bf16_t*)(p.ws + WS_PROJ);
    const bf16_t* WS_ = (const bf16_t*)(p.ws + WS_SGUW);
    bf16_t* Y = (bf16_t*)(p.ws + WS_HN);
    for (int it = bid; it < 2048; it += nblk) {
        const int g = it & 7, n = (it >> 3) & 127, b = it >> 10;
        const size_t rowbase = (size_t)b * SEQ + (size_t)n * 128;
        {
            const int pp = tid & 127, cg4 = tid >> 7;
            const u32x4* src = (const u32x4*)(PROJ + (rowbase + pp) * INW + 3072 + g * 128 + 32 * cg4);
            float gv[32]; float s = 0.f, s2 = 0.f;
#pragma unroll
            for (int e = 0; e < 4; ++e) { const u32x4 r = src[e];
#pragma unroll
                for (int j = 0; j < 4; ++j) { const float lo = gelu_tanh(bflo(r[j])), hi = gelu_tanh(bfhi(r[j])); gv[8 * e + 2 * j] = lo; gv[8 * e + 2 * j + 1] = hi; s += lo + hi; s2 += lo * lo + hi * hi; } }
            part[(cg4 * 128 + pp) * 2] = s; part[(cg4 * 128 + pp) * 2 + 1] = s2;
            __syncthreads();
            float ts = 0.f, ts2 = 0.f;
#pragma unroll
            for (int k = 0; k < 4; ++k) { ts += part[(k * 128 + pp) * 2]; ts2 += part[(k * 128 + pp) * 2 + 1]; }
            const float mu = ts * (1.0f / 128.0f); const float var = fmaxf(ts2 * (1.0f / 128.0f) - mu * mu, 0.f); const float rstd = rsqrtf(var + EPS);
#pragma unroll
            for (int j = 0; j < 32; ++j) vgT[(32 * cg4 + j) * XCB_LD + pp] = (bf16_t)f2bf((gv[j] - mu) * rstd);
        }
        __syncthreads();
        {
            bf16x8 Af[4];
#pragma unroll
            for (int ks = 0; ks < 4; ++ks) Af[ks] = *(const bf16x8*)(vgT + (16 * w + cc) * XCB_LD + 32 * ks + 8 * q4);
            const int c0 = 16 * w + 4 * q4;
#pragma unroll 2
            for (int nt = 0; nt < 8; ++nt) {
                const int pp = 16 * nt + cc;
                const bf16_t* wb = WS_ + ((size_t)g * 128 + pp) * 128 + 8 * q4;
                f32x4 acc = {0.f, 0.f, 0.f, 0.f};
#pragma unroll
                for (int ks = 0; ks < 4; ++ks) { const bf16x8 Bf = *(const bf16x8*)(wb + 32 * ks); acc = __builtin_amdgcn_mfma_f32_16x16x32_bf16(Af[ks], Bf, acc, 0, 0, 0); }
                const float bsv = p.sgu_b[g * 128 + pp];
                const u32x2 uu = *(const u32x2*)(PROJ + (rowbase + pp) * INW + 2048 + g * 128 + c0);
                const float y0 = gelu_tanh(bflo(uu.x)) * (acc[0] + bsv), y1 = gelu_tanh(bfhi(uu.x)) * (acc[1] + bsv), y2 = gelu_tanh(bflo(uu.y)) * (acc[2] + bsv), y3 = gelu_tanh(bfhi(uu.y)) * (acc[3] + bsv);
                u32x2 o; o.x = pk2(y0, y1); o.y = pk2(y2, y3);
                *(u32x2*)(Y + (rowbase + pp) * D + 1024 + g * 128 + c0) = o;
            }
        }
        __syncthreads();
    }
}

#define INS16(S, x) do { int _x = (x); _Pragma("unroll") for (int _j = 0; _j < 16; ++_j) { const int _hi = max(S[_j], _x); _x = min(S[_j], _x); S[_j] = _hi; } } while (0)
__device__ __forceinline__ void topk_phase(const Params& p, unsigned char* lds, int bid, int nblk) {
    int tid = threadIdx.x; asm volatile("" : "+v"(tid));
    const int lane = tid & 63, w = __builtin_amdgcn_readfirstlane(tid >> 6), cc = lane & 15, q4 = lane >> 4;
    constexpr int ST_LD = 129;
    float* ST = (float*)lds;
    int* LL = (int*)(lds + 2 * 128 * ST_LD * 4);
    const bf16_t* Q = (const bf16_t*)(p.ws + WS_PROJ);
    int* TOPI = (int*)(p.ws + WS_TOPI); float* TOPG = (float*)(p.ws + WS_TOPG);
    for (int it = bid; it < 2048; it += nblk) {
        const int h = it & 7, tt = it >> 3, tok0 = tt * 128;
#pragma unroll
        for (int half = 0; half < 2; ++half) {
            const bf16_t* kb = (const bf16_t*)(p.ws + (half ? WS_K2 : WS_K1)) + ((size_t)h * 128 + 16 * w + cc) * 128 + 8 * q4;
            bf16x8 Ak[4];
#pragma unroll
            for (int ks = 0; ks < 4; ++ks) Ak[ks] = *(const bf16x8*)(kb + 32 * ks);
#pragma unroll 2
            for (int n = 0; n < 8; ++n) {
                const bf16_t* qb = Q + (size_t)(tok0 + 16 * n + cc) * D + h * 256 + half * 128 + 8 * q4;
                f32x4 acc = {0.f, 0.f, 0.f, 0.f};
#pragma unroll
                for (int ks = 0; ks < 4; ++ks) { const bf16x8 Bf = *(const bf16x8*)(qb + 32 * ks); acc = __builtin_amdgcn_mfma_f32_16x16x32_bf16(Ak[ks], Bf, acc, 0, 0, 0); }
#pragma unroll
                for (int r = 0; r < 4; ++r) ST[(half * 128 + 16 * w + 4 * q4 + r) * ST_LD + 16 * n + cc] = acc[r];
            }
        }
        __syncthreads();
        if (tid < 256) {
            const int t = tid & 127, half = tid >> 7;
            int S[16];
#pragma unroll
            for (int j = 0; j < 16; ++j) S[j] = (int)0x80000000;
            const float* sp_ = ST + half * 128 * ST_LD + t;
#pragma unroll 4
            for (int k = 0; k < 128; ++k) { const int key = (mono(sp_[k * ST_LD]) & ~127) | (127 - k); INS16(S, key); }
#pragma unroll
            for (int j = 0; j < 16; ++j) LL[(t * 2 + half) * 16 + j] = S[j];
        }
        __syncthreads();
        if (tid < 128) {
            const int t = tid;
            float f1[16], f2[16];
#pragma unroll
            for (int j = 0; j < 16; ++j) { f1[j] = unmono(LL[(t * 2) * 16 + j] & ~127); f2[j] = unmono(LL[(t * 2 + 1) * 16 + j] & ~127); }
            int S[16];
#pragma unroll
            for (int j = 0; j < 16; ++j) S[j] = (int)0x80000000;
#pragma unroll
            for (int i = 0; i < 16; ++i)
#pragma unroll
                for (int j = 0; j < 16; ++j)
                    if ((i + 1) * (j + 1) <= 16) { const int key = (mono(f1[i] + f2[j]) & ~255) | (255 - (i * 16 + j)); INS16(S, key); }
            float sc[16]; int idx[16];
#pragma unroll
            for (int k = 0; k < 16; ++k) {
                const int code = 255 - (S[k] & 255); const int i = code >> 4, j = code & 15;
                const int e1 = 127 - (LL[(t * 2) * 16 + i] & 127), e2 = 127 - (LL[(t * 2 + 1) * 16 + j] & 127);
                idx[k] = e1 * 128 + e2; sc[k] = unmono(S[k] & ~255);
            }
            const float mx = sc[0]; float sum = 0.f;
#pragma unroll
            for (int k = 0; k < 16; ++k) { sc[k] = __expf(sc[k] - mx); sum += sc[k]; }
            const float inv = 1.0f / sum;
            int* ip = TOPI + (size_t)(tok0 + t) * 128 + h * 16; float* gp = TOPG + (size_t)(tok0 + t) * 128 + h * 16;
#pragma unroll
            for (int k4 = 0; k4 < 4; ++k4) {
                *(int4*)(ip + 4 * k4) = make_int4(idx[4 * k4], idx[4 * k4 + 1], idx[4 * k4 + 2], idx[4 * k4 + 3]);
                *(f32x4*)(gp + 4 * k4) = (f32x4){sc[4 * k4] * inv, sc[4 * k4 + 1] * inv, sc[4 * k4 + 2] * inv, sc[4 * k4 + 3] * inv};
            }
        }
        __syncthreads();
    }
}

__device__ __forceinline__ void gather_phase(const Params& p, unsigned char* lds, int bid, int nblk) {
    int tid = threadIdx.x; asm volatile("" : "+v"(tid));
    const int lane = tid & 63, wave = __builtin_amdgcn_readfirstlane(tid >> 6);
    float* gs2 = (float*)lds;
    float* sh2 = gs2 + 4096;
    float* gt2 = sh2 + 4096;
    float* fgl = gt2 + 4096;
    const float* MOD = (const float*)(p.ws + WS_MOD);
    for (int i = tid; i < 4096; i += 512) { const int b = i >> 11, k = i & 2047; gs2[i] = p.g2[k] * (1.0f + MOD[b * 12288 + 4 * 2048 + k]); sh2[i] = MOD[b * 12288 + 3 * 2048 + k]; gt2[i] = MOD[b * 12288 + 5 * 2048 + k]; }
    for (int i = tid; i < 2048; i += 512) fgl[i] = p.fg[i];
    __syncthreads();
    const bf16_t* UB = (const bf16_t*)(p.ws + WS_UB); const bf16_t* VB = (const bf16_t*)(p.ws + WS_VB);
    const int* TOPI = (const int*)(p.ws + WS_TOPI); const float* TOPG = (const float*)(p.ws + WS_TOPG);
    for (int tok = bid * 8 + wave; tok < MLAT; tok += nblk * 8) {
        const int b = tok >> 14;
        float* xrow = p.out + (size_t)tok * D;
        f32x4 xl[4][2]; float ss = 0.f;
#pragma unroll
        for (int c = 0; c < 4; ++c)
#pragma unroll
            for (int e = 0; e < 2; ++e) { xl[c][e] = *(const f32x4*)(xrow + 512 * c + 8 * lane + 4 * e); const f32x4 v = xl[c][e]; ss += (v[0] * v[0] + v[1] * v[1]) + (v[2] * v[2] + v[3] * v[3]); }
        const float rstd = rsqrtf(wave_sum(ss) * (1.0f / 2048.0f) + EPS);
        unsigned hp[4][4];
#pragma unroll
        for (int c = 0; c < 4; ++c)
#pragma unroll
            for (int e = 0; e < 2; ++e) { const int col = 512 * c + 8 * lane + 4 * e; const f32x4 g = *(const f32x4*)(gs2 + b * 2048 + col), s = *(const f32x4*)(sh2 + b * 2048 + col);
                const f32x4 hv = xl[c][e] * rstd * g + s; hp[c][2 * e] = pk2(hv[0], hv[1]); hp[c][2 * e + 1] = pk2(hv[2], hv[3]); }
        const int ii0 = TOPI[(size_t)tok * 128 + lane], ii1 = TOPI[(size_t)tok * 128 + 64 + lane];
        const float gg0 = TOPG[(size_t)tok * 128 + lane], gg1 = TOPG[(size_t)tok * 128 + 64 + lane];
        f32x4 oa[4][2];
#pragma unroll
        for (int c = 0; c < 4; ++c) { oa[c][0] = (f32x4){0.f, 0.f, 0.f, 0.f}; oa[c][1] = oa[c][0]; }
#pragma unroll 2
        for (int pr = 0; pr < 128; ++pr) {
            const int idx = __builtin_amdgcn_readlane(pr < 64 ? ii0 : ii1, pr & 63);
            const float gk = __builtin_bit_cast(float, __builtin_amdgcn_readlane(__builtin_bit_cast(int, pr < 64 ? gg0 : gg1), pr & 63));
            const bf16_t* ur = UB + (size_t)idx * D + 8 * lane; const bf16_t* vr = VB + (size_t)idx * D + 8 * lane;
            u32x4 uv[4], vv[4];
#pragma unroll
            for (int c = 0; c < 4; ++c) { uv[c] = *(const u32x4*)(ur + 512 * c); vv[c] = *(const u32x4*)(vr + 512 * c); }
            float dsum = 0.f;
#pragma unroll
            for (int c = 0; c < 4; ++c)
#pragma unroll
                for (int j = 0; j < 4; ++j) { dsum += bflo(uv[c][j]) * bflo(hp[c][j]); dsum += bfhi(uv[c][j]) * bfhi(hp[c][j]); }
            dsum = wave_sum(dsum);
            const float wgt = gk * gelu_tanh(dsum);
#pragma unroll
            for (int c = 0; c < 4; ++c) {
                oa[c][0] += (f32x4){bflo(vv[c][0]), bfhi(vv[c][0]), bflo(vv[c][1]), bfhi(vv[c][1])} * wgt;
                oa[c][1] += (f32x4){bflo(vv[c][2]), bfhi(vv[c][2]), bflo(vv[c][3]), bfhi(vv[c][3])} * wgt;
            }
        }
        float s2 = 0.f;
#pragma unroll
        for (int c = 0; c < 4; ++c)
#pragma unroll
            for (int e = 0; e < 2; ++e) { const int col = 512 * c + 8 * lane + 4 * e; const f32x4 g = *(const f32x4*)(gt2 + b * 2048 + col);
                const f32x4 xo = xl[c][e] + g * oa[c][e]; xl[c][e] = xo; s2 += (xo[0] * xo[0] + xo[1] * xo[1]) + (xo[2] * xo[2] + xo[3] * xo[3]); }
        const float r2 = rsqrtf(wave_sum(s2) * (1.0f / 2048.0f) + EPS);
#pragma unroll
        for (int c = 0; c < 4; ++c)
#pragma unroll
            for (int e = 0; e < 2; ++e) { const int col = 512 * c + 8 * lane + 4 * e; const f32x4 fgv = *(const f32x4*)(fgl + col);
                *(f32x4*)(xrow + col) = xl[c][e] * r2 * fgv; }
    }
}

__global__ void __launch_bounds__(512, 2) k_main(Params p, int ph_lo, int ph_hi) {
    extern __shared__ __attribute__((aligned(16))) unsigned char lds[];
    const int bid = blockIdx.x, nblk = gridDim.x;
#if FUSED
    cg::grid_group grid = cg::this_grid();
#endif
#if FUSED
#define SYNC_AFTER(k) if ((k) + 1 < ph_hi) grid.sync();
#else
#define SYNC_AFTER(k)
#endif
#define IN(k) (ph_lo <= (k) && (k) < ph_hi)
    if (IN(0)) { phase0(p, lds, bid, nblk); SYNC_AFTER(0) }
    if (IN(1)) { phase_norm1(p, bid, nblk); SYNC_AFTER(1) }
    if (IN(2)) { pg8::Gemm g{(const bf16_t*)(p.ws + WS_HN), (const bf16_t*)(p.ws + WS_WIN), MALL, INW, D}; pg8::StaticOrder S; S.init(MALL, INW, nblk, bid);
                 pg8::EpiBf16 E{(bf16_t*)(p.ws + WS_PROJ), INW}; pg8::gemm_phase<pg8::EpiBf16>((LAS unsigned char*)lds, g, S, E); SYNC_AFTER(2) }
    if (IN(3)) { lru_phase<false>(p, lds, bid, nblk); SYNC_AFTER(3) }
    if (IN(4)) { lru_phase<true>(p, lds, bid, nblk); sgu_phase(p, lds, bid, nblk); SYNC_AFTER(4) }
    if (IN(5)) { pg8::Gemm g{(const bf16_t*)(p.ws + WS_HN), (const bf16_t*)(p.ws + WS_WOUT), MLAT, D, D}; pg8::StaticOrder S; S.init(MLAT, D, nblk, bid);
                 pg8::EpiRes E{p.x, p.out, D, (const float*)(p.ws + WS_MOD) + 2 * 2048, 12288, SEQ}; pg8::gemm_phase<pg8::EpiRes>((LAS unsigned char*)lds, g, S, E); SYNC_AFTER(5) }
    if (IN(6)) { phase_norm2(p, bid, nblk); SYNC_AFTER(6) }
    if (IN(7)) { pg8::Gemm g{(const bf16_t*)(p.ws + WS_HN), (const bf16_t*)(p.ws + WS_WQ), MLAT, D, D}; pg8::StaticOrder S; S.init(MLAT, D, nblk, bid);
                 pg8::EpiBf16 E{(bf16_t*)(p.ws + WS_PROJ), D}; pg8::gemm_phase<pg8::EpiBf16>((LAS unsigned char*)lds, g, S, E); SYNC_AFTER(7) }
    if (IN(8)) { topk_phase(p, lds, bid, nblk); SYNC_AFTER(8) }
    if (IN(9)) { gather_phase(p, lds, bid, nblk); }
#undef IN
}

extern "C" void kernel_launch(void* const* d_in, const int* in_sizes, int n_in, void* d_out, int out_size, void* d_ws, size_t ws_size, hipStream_t stream) {
    static int grid = 0;
    if (grid == 0) {
        if (n_in != 25 || out_size != MLAT * D || ws_size < WS_END) { fprintf(stderr, "kernel_launch: unexpected shapes (n_in %d out %d ws %zu)\n", n_in, out_size, ws_size); grid = -1; return; }
        int dev = 0, cus = 0, per_cu = 0;
        hipGetDevice(&dev); hipDeviceGetAttribute(&cus, hipDeviceAttributeMultiprocessorCount, dev);
        if (hipFuncSetAttribute((const void*)k_main, hipFuncAttributeMaxDynamicSharedMemorySize, LDS_BYTES) != hipSuccess) { fprintf(stderr, "kernel_launch: hipFuncSetAttribute failed\n"); grid = -1; return; }
        hipOccupancyMaxActiveBlocksPerMultiprocessor(&per_cu, (const void*)k_main, 512, LDS_BYTES);
        if (per_cu < 1) { fprintf(stderr, "kernel_launch: occupancy query says %d blocks per CU\n", per_cu); per_cu = 1; }
        (void)hipGetLastError();
        grid = cus * 1;
    }
    if (grid < 0) return;
    Params p{};
    const float** pp = (const float**)&p;
    for (int i = 0; i < 25; ++i) pp[i] = (const float*)d_in[i];
    p.out = (float*)d_out; p.ws = (unsigned char*)d_ws;
#if FUSED
    int lo = 0, hi = NPHASES;
    void* args[] = {&p, &lo, &hi};
    hipError_t e = hipLaunchCooperativeKernel((const void*)k_main, dim3(grid), dim3(512), args, LDS_BYTES, stream);
    if (e != hipSuccess) fprintf(stderr, "cooperative launch failed: %s (grid %d)\n", hipGetErrorString(e), grid);
#else
    for (int ph = 0; ph < NPHASES; ++ph) hipLaunchKernelGGL(k_main, dim3(grid), dim3(512), LDS_BYTES, stream, p, ph, ph + 1);
#endif
}
```

```cpp
#include <hip/hip_runtime.h>
#include <hip/hip_cooperative_groups.h>
#include <cstdio>
#include <cstdint>

#ifndef G3_I8
#define G3_I8 1
#endif
#ifndef G1_I8
#define G1_I8 1
#endif
#ifndef U_MODE
#define U_MODE 1
#endif
#ifndef V_MODE
#define V_MODE 1
#endif
#ifndef FUSED
#define FUSED 1
#endif
#ifndef CTX_SPLIT
#define CTX_SPLIT 1
#endif
#define CTXDONE_OFS 45568

namespace cg = cooperative_groups;

typedef unsigned short bf16_t;
typedef short bf16x8 __attribute__((ext_vector_type(8)));
typedef float f32x4 __attribute__((ext_vector_type(4)));
typedef float f32x2 __attribute__((ext_vector_type(2)));
typedef unsigned u32x4 __attribute__((ext_vector_type(4)));
typedef unsigned u32x2 __attribute__((ext_vector_type(2)));
typedef int i32x4 __attribute__((ext_vector_type(4)));
typedef __bf16 bf16x2_t __attribute__((ext_vector_type(2)));
#define LAS __attribute__((address_space(3)))

constexpr int D = 2048, SEQ = 16384, CTXL = 256;
constexpr int MLAT = 2 * SEQ, MCTX = 2 * CTXL, MALL = MLAT + MCTX;
constexpr int INW = 4096;
constexpr int NSEG = 130;
constexpr float EPS = 1e-6f;

constexpr size_t MiB = 1u << 20;
constexpr size_t WS_CTL = 0;
constexpr size_t WS_MOD = 1 * MiB;
constexpr size_t WS_SP = 1 * MiB + 512 * 1024;
constexpr size_t WS_USC = 2 * MiB;
constexpr size_t WS_WIN = 4 * MiB;
constexpr size_t WS_WOUT = 20 * MiB;
constexpr size_t WS_WQ = 28 * MiB;
constexpr size_t WS_SGUW = 36 * MiB;
constexpr size_t WS_K1 = 36 * MiB + 256 * 1024;
constexpr size_t WS_K2 = 36 * MiB + 512 * 1024;
constexpr size_t WS_LRUW = 37 * MiB;
constexpr size_t WS_SUMS = 38 * MiB;
constexpr size_t WS_UB = 44 * MiB;
constexpr size_t WS_VB = 108 * MiB;
constexpr size_t WS_HN = 172 * MiB;
constexpr size_t WS_PROJ = 302 * MiB;
constexpr size_t WS_TOPI = 562 * MiB;
constexpr size_t WS_TOPG = 578 * MiB;
constexpr size_t WS_COLMAX_IN = 65536;
constexpr size_t WS_COLMAX_Q = 65536 + 16384;
constexpr size_t WS_RS1 = 600 * MiB + 262144;
constexpr size_t WS_HSC = 600 * MiB;
constexpr size_t WS_SW = 601 * MiB;
constexpr size_t WS_WQ8 = 602 * MiB;
constexpr size_t WS_HN8 = 608 * MiB;
constexpr size_t WS_WIN3 = 672 * MiB;
constexpr size_t WS_CS1 = 600 * MiB + 524288;
constexpr size_t WS_BIAS1 = 600 * MiB + 589824;
constexpr size_t WS_YL = 696 * MiB;
constexpr size_t WS_END = 824 * MiB;

constexpr int LDS_BYTES = 159744;
constexpr int NPHASES = 14;

struct Params {
    const float *x, *c, *ctx, *c_ctx, *w_mod, *b_mod, *g1, *g2, *w_in, *conv_w, *conv_b, *lru_wa, *lru_ba, *lru_wx, *lru_bx, *lru_lam,
        *sgu_w, *sgu_b, *w_out, *wq, *k1, *k2, *pu, *pv, *fg;
    float* out;
    unsigned char* ws;
};

__device__ __forceinline__ unsigned f2bf(float f) { unsigned u = __builtin_bit_cast(unsigned, f); return (u + 0x7fffu + ((u >> 16) & 1u)) >> 16; }
__device__ __forceinline__ unsigned pk2(float lo, float hi) { return f2bf(lo) | (f2bf(hi) << 16); }
__device__ __forceinline__ float bflo(unsigned u) { return __builtin_bit_cast(float, u << 16); }
__device__ __forceinline__ float bfhi(unsigned u) { return __builtin_bit_cast(float, u & 0xffff0000u); }
__device__ __forceinline__ float bf1(bf16_t u) { return __builtin_bit_cast(float, (unsigned)u << 16); }
__device__ __forceinline__ float sigmoidf_(float x) { return __builtin_amdgcn_rcpf(1.0f + __expf(-x)); }
__device__ __forceinline__ float gelu_tanh(float x) {
    const float t = x * x; const float q = x * fmaf(t, -0.1029432395800235f, -2.302208198144325f);
    return x * __builtin_amdgcn_rcpf(1.0f + __builtin_amdgcn_exp2f(q));
}
template <int CTRL> __device__ __forceinline__ int dpp_i(int v) { return __builtin_amdgcn_update_dpp(0, v, CTRL, 0xf, 0xf, true); }
template <int CTRL> __device__ __forceinline__ float dpp_f(float v) { return __builtin_bit_cast(float, __builtin_amdgcn_update_dpp(0, __builtin_bit_cast(int, v), CTRL, 0xf, 0xf, true)); }
constexpr int DPP_XOR1 = 0xB1, DPP_XOR2 = 0x4E, DPP_HMIRROR = 0x141, DPP_MIRROR = 0x140, DPP_ROR8 = 0x128;
__device__ __forceinline__ void swap16(float& a, float& b) { asm("s_nop 1\n\tv_permlane16_swap_b32 %0, %1" : "+v"(a), "+v"(b)); }
__device__ __forceinline__ void swap32(float& a, float& b) { asm("s_nop 1\n\tv_permlane32_swap_b32 %0, %1" : "+v"(a), "+v"(b)); }
__device__ __forceinline__ void swap16(f32x2& a, f32x2& b) { float ax = a.x, ay = a.y, bx = b.x, by = b.y; swap16(ax, bx); swap16(ay, by); a = (f32x2){ax, ay}; b = (f32x2){bx, by}; }
__device__ __forceinline__ void swap32(f32x2& a, f32x2& b) { float ax = a.x, ay = a.y, bx = b.x, by = b.y; swap32(ax, bx); swap32(ay, by); a = (f32x2){ax, ay}; b = (f32x2){bx, by}; }
__device__ __forceinline__ float wave_sum(float v) {
    v += dpp_f<DPP_XOR1>(v); v += dpp_f<DPP_XOR2>(v); v += dpp_f<DPP_HMIRROR>(v); v += dpp_f<DPP_MIRROR>(v);
    { float a = v, b = v; swap16(a, b); v = a + b; }
    { float a = v, b = v; swap32(a, b); v = a + b; }
    return v;
}
__device__ __forceinline__ unsigned q8pack(f32x4 x) {
    const int a = max(-127, min(127, __float2int_rn(x[0]))), b = max(-127, min(127, __float2int_rn(x[1]))), c = max(-127, min(127, __float2int_rn(x[2]))), d = max(-127, min(127, __float2int_rn(x[3])));
    return (unsigned)(a & 255) | ((unsigned)(b & 255) << 8) | ((unsigned)(c & 255) << 16) | ((unsigned)(d & 255) << 24);
}
__device__ __forceinline__ float sb(unsigned w, int k) { return (float)(signed char)((w >> (8 * k)) & 255u); }
__device__ __forceinline__ int mono(float v) { int b = __builtin_bit_cast(int, v); return b ^ ((b >> 31) & 0x7fffffff); }
__device__ __forceinline__ float unmono(int m) { int b = m ^ ((m >> 31) & 0x7fffffff); return __builtin_bit_cast(float, b); }

namespace pg8 {
constexpr int BM = 256, BK = 64, HALF = 128, HTB = HALF * BK * 2, STAGE_BYTES = 8 * HTB, NXCD = 8, WGM = 8;
__host__ __device__ __forceinline__ int lds_byte(int r, int c) { const int st = (r >> 4) * 2 + (c >> 5), rr = r & 15, cc = c & 31, ob = rr * 64 + cc * 2; return st * 1024 + (ob ^ (((ob >> 9) & 1) << 5)); }
__host__ __device__ __forceinline__ void stage_rc(int b, int& R, int& C) { const int st = b / 1024, sb = b % 1024, swz = sb ^ (((sb >> 9) & 1) << 5); R = (st >> 1) * 16 + swz / 64; C = (st & 1) * 32 + (swz % 64) / 2; }
__host__ __device__ __forceinline__ int perm32(int rho) { const int n = rho >> 4, i = rho & 15; return 8 * (i >> 2) + 4 * n + (i & 3); }
struct Unit { int pm, pn; };
struct Gemm { const bf16_t* A; const bf16_t* Bt; int M, N, K; int bt_tiles; int bt_max; size_t bt_stride;
    __device__ __forceinline__ size_t bsel(int pm) const { return bt_stride ? (size_t)((pm / bt_tiles) < bt_max ? (pm / bt_tiles) : bt_max) * bt_stride : (size_t)0; } };
struct StaticOrder {
    int nM, nN, nwg, G, c; int fpm = -1, fpn = 0;
    __host__ __device__ void init(int M, int N, int G_, int c_) { nM = M / BM; nN = N / BM; nwg = nM * nN; G = G_; c = c_; }
    __host__ __device__ bool next(int i, Unit& u) const {
        if (fpm >= 0) { if (i > 0) return false; u.pm = fpm; u.pn = fpn; return true; }
        const long L = (long)i * G + c; if (L >= nwg) return false;
        int wgid = (int)L; { const int q = nwg / NXCD, r = nwg % NXCD, xcd = wgid % NXCD, off = wgid / NXCD; wgid = (xcd < r ? xcd * (q + 1) : r * (q + 1) + (xcd - r) * q) + off; }
        const int nig = WGM * nN, gid = wgid / nig, fm = gid * WGM, gsz = (nM - fm) < WGM ? (nM - fm) : WGM;
        u.pm = fm + ((wgid % nig) % gsz); u.pn = (wgid % nig) / gsz; return true;
    }
};
__device__ __forceinline__ unsigned cvt_pk_bf16(float lo, float hi) { unsigned r; asm volatile("v_cvt_pk_bf16_f32 %0, %1, %2" : "=v"(r) : "v"(lo), "v"(hi)); return r; }

__device__ __forceinline__ u32x4 epi_tr(u32x4 w, int src4) { u32x4 r; r.x = (unsigned)__builtin_amdgcn_ds_bpermute(src4, (int)w.x); r.y = (unsigned)__builtin_amdgcn_ds_bpermute(src4, (int)w.y); r.z = (unsigned)__builtin_amdgcn_ds_bpermute(src4, (int)w.z); r.w = (unsigned)__builtin_amdgcn_ds_bpermute(src4, (int)w.w); return r; }
#define EPI_TR_SETUP const int lane_ = fq * 16 + fr, fr2 = lane_ >> 2, fq2 = lane_ & 3, src4 = 4 * (fq2 * 16 + fr2); const long trofs = (long)(fr2 - fr) * ldc + 8 * (fq2 - fq);
struct EpiI8Bf16 {
    static constexpr bool PERM = true, I8 = true; typedef i32x4 acc_t;
    bf16_t* O; int ldc; const float* rs; const unsigned* cmax;
    __device__ __forceinline__ void operator()(const i32x4 (&acc)[2][2][4][2], const Unit& u, int wr, int wc, int fr, int fq) const {
        const int row0 = u.pm * BM + wr * 64 + fr; const int col0 = u.pn * BM + wc * 32 + 8 * fq;
        EPI_TR_SETUP
        f32x4 cs[2][2];
#pragma unroll
        for (int bj = 0; bj < 2; ++bj)
#pragma unroll
            for (int n = 0; n < 2; ++n) { const u32x4 cm = *(const u32x4*)(cmax + col0 + bj * HALF + 4 * n);
                cs[bj][n] = (f32x4){__builtin_bit_cast(float, cm[0]), __builtin_bit_cast(float, cm[1]), __builtin_bit_cast(float, cm[2]), __builtin_bit_cast(float, cm[3])} * (1.0f / 127.0f); }
#pragma unroll
        for (int ai = 0; ai < 2; ++ai)
#pragma unroll
            for (int m = 0; m < 4; ++m) { const int row = row0 + ai * HALF + m * 16; const float rsv = rs[row]; bf16_t* rowp = O + (size_t)row * ldc + col0;
#pragma unroll
                for (int bj = 0; bj < 2; ++bj) { const i32x4 a0 = acc[ai][bj][m][0], a1 = acc[ai][bj][m][1];
                    const f32x4 v0 = (f32x4){(float)a0[0], (float)a0[1], (float)a0[2], (float)a0[3]} * cs[bj][0] * rsv, v1 = (f32x4){(float)a1[0], (float)a1[1], (float)a1[2], (float)a1[3]} * cs[bj][1] * rsv;
                    u32x4 w; w.x = cvt_pk_bf16(v0[0], v0[1]); w.y = cvt_pk_bf16(v0[2], v0[3]); w.z = cvt_pk_bf16(v1[0], v1[1]); w.w = cvt_pk_bf16(v1[2], v1[3]);
                    *(u32x4*)(rowp + trofs + bj * HALF) = epi_tr(w, src4); } }
    }
};
struct EpiI8BiasBf16 {
    static constexpr bool PERM = true, I8 = true; typedef i32x4 acc_t;
    bf16_t* O; int ldc; const float* rs; const float* cs; const float* bias;
    __device__ __forceinline__ void operator()(const i32x4 (&acc)[2][2][4][2], const Unit& u, int wr, int wc, int fr, int fq) const {
        const int row0 = u.pm * BM + wr * 64 + fr; const int col0 = u.pn * BM + wc * 32 + 8 * fq; const int v = (u.pm / 64) < 2 ? (u.pm / 64) : 2;
        EPI_TR_SETUP
        f32x4 csv[2][2], bv[2][2];
#pragma unroll
        for (int bj = 0; bj < 2; ++bj)
#pragma unroll
            for (int n = 0; n < 2; ++n) { csv[bj][n] = *(const f32x4*)(cs + v * 4096 + col0 + bj * HALF + 4 * n); bv[bj][n] = *(const f32x4*)(bias + v * 4096 + col0 + bj * HALF + 4 * n); }
#pragma unroll
        for (int ai = 0; ai < 2; ++ai)
#pragma unroll
            for (int m = 0; m < 4; ++m) { const int row = row0 + ai * HALF + m * 16; const float rsv = rs[row]; bf16_t* rowp = O + (size_t)row * ldc + col0;
#pragma unroll
                for (int bj = 0; bj < 2; ++bj) { const i32x4 a0 = acc[ai][bj][m][0], a1 = acc[ai][bj][m][1];
                    const f32x4 v0 = (f32x4){(float)a0[0], (float)a0[1], (float)a0[2], (float)a0[3]} * csv[bj][0] * rsv + bv[bj][0], v1 = (f32x4){(float)a1[0], (float)a1[1], (float)a1[2], (float)a1[3]} * csv[bj][1] * rsv + bv[bj][1];
                    u32x4 w; w.x = cvt_pk_bf16(v0[0], v0[1]); w.y = cvt_pk_bf16(v0[2], v0[3]); w.z = cvt_pk_bf16(v1[0], v1[1]); w.w = cvt_pk_bf16(v1[2], v1[3]);
                    *(u32x4*)(rowp + trofs + bj * HALF) = epi_tr(w, src4); } }
    }
};
struct EpiBf16 {
    static constexpr bool PERM = true, I8 = false; typedef f32x4 acc_t;
    bf16_t* O; int ldc;
    __device__ __forceinline__ void operator()(const f32x4 (&acc)[2][2][4][2], const Unit& u, int wr, int wc, int fr, int fq) const {
        const int row0 = u.pm * BM + wr * 64 + fr; const int col0 = u.pn * BM + wc * 32 + 8 * fq;
#pragma unroll
        for (int ai = 0; ai < 2; ++ai)
#pragma unroll
            for (int m = 0; m < 4; ++m) { bf16_t* rowp = O + (size_t)(row0 + ai * HALF + m * 16) * ldc + col0;
#pragma unroll
                for (int bj = 0; bj < 2; ++bj) { const f32x4 v0 = acc[ai][bj][m][0], v1 = acc[ai][bj][m][1];
                    u32x4 w; w.x = cvt_pk_bf16(v0[0], v0[1]); w.y = cvt_pk_bf16(v0[2], v0[3]); w.z = cvt_pk_bf16(v1[0], v1[1]); w.w = cvt_pk_bf16(v1[2], v1[3]);
                    *(u32x4*)(rowp + bj * HALF) = w; } }
    }
};
struct EpiGateBf16 {
    static constexpr bool PERM = true, I8 = false; typedef f32x4 acc_t;
    bf16_t* O; int ldc; const float* gate; int gate_stride; int rows_per_batch;
    __device__ __forceinline__ void operator()(const f32x4 (&acc)[2][2][4][2], const Unit& u, int wr, int wc, int fr, int fq) const {
        const int row0 = u.pm * BM + wr * 64 + fr; const int col0 = u.pn * BM + wc * 32 + 8 * fq;
        EPI_TR_SETUP
        const int bsel = (u.pm * BM) / rows_per_batch;
        f32x4 gv[2][2];
#pragma unroll
        for (int bj = 0; bj < 2; ++bj)
#pragma unroll
            for (int n = 0; n < 2; ++n) gv[bj][n] = *(const f32x4*)(gate + (size_t)bsel * gate_stride + col0 + bj * HALF + 4 * n);
#pragma unroll
        for (int ai = 0; ai < 2; ++ai)
#pragma unroll
            for (int m = 0; m < 4; ++m) { bf16_t* rowp = O + (size_t)(row0 + ai * HALF + m * 16) * ldc + col0;
#pragma unroll
                for (int bj = 0; bj < 2; ++bj) { const f32x4 v0 = acc[ai][bj][m][0] * gv[bj][0], v1 = acc[ai][bj][m][1] * gv[bj][1];
                    u32x4 w; w.x = cvt_pk_bf16(v0[0], v0[1]); w.y = cvt_pk_bf16(v0[2], v0[3]); w.z = cvt_pk_bf16(v1[0], v1[1]); w.w = cvt_pk_bf16(v1[2], v1[3]);
                    *(u32x4*)(rowp + trofs + bj * HALF) = epi_tr(w, src4); } }
    }
};
struct EpiXlatBf16 {
    static constexpr bool PERM = true, I8 = false; typedef f32x4 acc_t;
    bf16_t* O; int ldc; const float* gate; int gate_stride; int rows_per_batch; const float* base;
    __device__ __forceinline__ void operator()(const f32x4 (&acc)[2][2][4][2], const Unit& u, int wr, int wc, int fr, int fq) const {
        const int row0 = u.pm * BM + wr * 64 + fr; const int col0 = u.pn * BM + wc * 32 + 8 * fq;
        EPI_TR_SETUP
        const int bsel = (u.pm * BM) / rows_per_batch;
        f32x4 gv[2][2];
#pragma unroll
        for (int bj = 0; bj < 2; ++bj)
#pragma unroll
            for (int n = 0; n < 2; ++n) gv[bj][n] = *(const f32x4*)(gate + (size_t)bsel * gate_stride + col0 + bj * HALF + 4 * n);
#pragma unroll
        for (int ai = 0; ai < 2; ++ai)
#pragma unroll
            for (int m = 0; m < 4; ++m) { const size_t off = (size_t)(row0 + ai * HALF + m * 16) * ldc + col0 + trofs;
#pragma unroll
                for (int bj = 0; bj < 2; ++bj) { const f32x4 b0 = *(const f32x4*)(base + off + bj * HALF), b1 = *(const f32x4*)(base + off + bj * HALF + 4);
                    const f32x4 v0 = acc[ai][bj][m][0] * gv[bj][0], v1 = acc[ai][bj][m][1] * gv[bj][1];
                    u32x4 w; w.x = cvt_pk_bf16(v0[0], v0[1]); w.y = cvt_pk_bf16(v0[2], v0[3]); w.z = cvt_pk_bf16(v1[0], v1[1]); w.w = cvt_pk_bf16(v1[2], v1[3]);
                    const u32x4 t = epi_tr(w, src4);
                    u32x4 o; o.x = cvt_pk_bf16(b0[0] + bflo(t.x), b0[1] + bfhi(t.x)); o.y = cvt_pk_bf16(b0[2] + bflo(t.y), b0[3] + bfhi(t.y)); o.z = cvt_pk_bf16(b1[0] + bflo(t.z), b1[1] + bfhi(t.z)); o.w = cvt_pk_bf16(b1[2] + bflo(t.w), b1[3] + bfhi(t.w));
                    *(u32x4*)(O + off + bj * HALF) = o; } }
    }
};
struct EpiRes {
    static constexpr bool PERM = false, I8 = false; typedef f32x4 acc_t;
    const float* base; float* out; int ldc; const float* gate; int gate_stride; int rows_per_batch;
    __device__ __forceinline__ void operator()(const f32x4 (&acc)[2][2][4][2], const Unit& u, int wr, int wc, int fr, int fq) const {
        const int col0 = u.pn * BM + wc * 32 + 4 * fq;
        const int bsel = (u.pm * BM) / rows_per_batch;
        f32x4 gv[2][2];
#pragma unroll
        for (int bj = 0; bj < 2; ++bj)
#pragma unroll
            for (int n = 0; n < 2; ++n) gv[bj][n] = *(const f32x4*)(gate + (size_t)bsel * gate_stride + col0 + bj * HALF + n * 16);
#pragma unroll
        for (int ai = 0; ai < 2; ++ai)
#pragma unroll
            for (int m = 0; m < 4; ++m) { const size_t off = (size_t)(u.pm * BM + ai * HALF + wr * 64 + m * 16 + fr) * ldc + col0;
#pragma unroll
                for (int bj = 0; bj < 2; ++bj)
#pragma unroll
                    for (int n = 0; n < 2; ++n) { const f32x4 bs = *(const f32x4*)(base + off + bj * HALF + n * 16);
                        *(f32x4*)(out + off + bj * HALF + n * 16) = bs + gv[bj][n] * acc[ai][bj][m][n]; } }
    }
};

__device__ __forceinline__ f32x4 mma_any(bf16x8 b, bf16x8 a, f32x4 c) { return __builtin_amdgcn_mfma_f32_16x16x32_bf16(b, a, c, 0, 0, 0); }
__device__ __forceinline__ i32x4 mma_any(bf16x8 b, bf16x8 a, i32x4 c) { return __builtin_amdgcn_mfma_i32_16x16x64_i8(__builtin_bit_cast(i32x4, b), __builtin_bit_cast(i32x4, a), c, 0, 0, 0); }
template <class Epi>
__device__ __forceinline__ void gemm_phase(LAS unsigned char* lds, const Gemm g, const StaticOrder& S, const Epi& E) {
    int tid = threadIdx.x; asm volatile("" : "+v"(tid));
    const int wid = __builtin_amdgcn_readfirstlane(tid >> 6), lane = tid & 63, wr = wid >> 2, wc = wid & 3, fr = lane & 15, fq = lane >> 4;
    const int K = g.K, nt = K / BK;
    unsigned voffA[2], voffB[2];
#pragma unroll
    for (int i = 0; i < 2; ++i) { int R, C; stage_rc(tid * 16 + i * 8192, R, C); const int Rb = Epi::PERM ? ((R & ~31) + perm32(R & 31)) : R;
        voffA[i] = (unsigned)(R * K + C) * 2u; voffB[i] = (unsigned)(Rb * K + C) * 2u; }
    const size_t kstep = (size_t)(BK * 2);
    const size_t hstep = (size_t)HALF * K * 2;
    const size_t tstep = 2 * hstep;
    const unsigned ldsw = (unsigned)wid * 1024u;
    const int aoff = lds_byte(wr * 64 + fr, fq * 8), boff = lds_byte(wc * 32 + fr, fq * 8);
#define PG8_SA(b, h) (((b) * 2 + (h)) * HTB)
#define PG8_SB(b, h) ((4 + (b) * 2 + (h)) * HTB)
#define PG8_STAGE(bufoff, gbase, voff) do { _Pragma("unroll") for (int _i = 0; _i < 2; ++_i) \
        __builtin_amdgcn_global_load_lds((const unsigned*)((const char*)(gbase) + (voff)[_i]), (LAS unsigned*)(lds + (bufoff) + ldsw + _i * 8192), 16, 0, 0); } while (0)
#define PG8_LDA(dst, b, h) do { _Pragma("unroll") for (int m = 0; m < 4; ++m) _Pragma("unroll") for (int k = 0; k < 2; ++k) dst[m][k] = *(const LAS bf16x8*)(lds + PG8_SA(b, h) + aoff + m * 2048 + k * 1024); } while (0)
#define PG8_LDB(dst, b, h) do { _Pragma("unroll") for (int n = 0; n < 2; ++n) _Pragma("unroll") for (int k = 0; k < 2; ++k) dst[n][k] = *(const LAS bf16x8*)(lds + PG8_SB(b, h) + boff + n * 2048 + k * 1024); } while (0)
#define PG8_MMA(ai, bj, At, Bt) do { __builtin_amdgcn_s_setprio(1); _Pragma("unroll") for (int m = 0; m < 4; ++m) _Pragma("unroll") for (int n = 0; n < 2; ++n) _Pragma("unroll") for (int k = 0; k < 2; ++k) \
        acc[ai][bj][m][n] = mma_any(Bt[n][k], At[m][k], acc[ai][bj][m][n]); __builtin_amdgcn_s_setprio(0); } while (0)
#define PG8_WAIT_V(n) asm volatile("s_waitcnt vmcnt(" #n ")" ::: "memory")
#define PG8_WAIT_L(n) asm volatile("s_waitcnt lgkmcnt(" #n ")" ::: "memory")
#define PG8_BAR __builtin_amdgcn_s_barrier()
#define PG8_SCHED __builtin_amdgcn_sched_barrier(0)
    Unit cur, nxt; int ui = 0;
    if (!S.next(0, cur)) return;
    typedef typename Epi::acc_t acc_t;
    acc_t acc[2][2][4][2];
#pragma unroll
    for (int a = 0; a < 2; ++a)
#pragma unroll
        for (int b = 0; b < 2; ++b)
#pragma unroll
            for (int m = 0; m < 4; ++m)
#pragma unroll
                for (int n = 0; n < 2; ++n) acc[a][b][m][n] = (acc_t){0, 0, 0, 0};
    bf16x8 At[4][2], B0[2][2], B1[2][2];
    const char* cA = (const char*)g.A + (size_t)cur.pm * tstep; const char* cB = (const char*)g.Bt + g.bsel(cur.pm) + (size_t)cur.pn * tstep;
    PG8_STAGE(PG8_SB(0, 0), cB, voffB); PG8_STAGE(PG8_SB(0, 1), cB + hstep, voffB); PG8_STAGE(PG8_SA(0, 0), cA, voffA); PG8_STAGE(PG8_SA(0, 1), cA + hstep, voffA);
    if (wr == 1) PG8_BAR;
    PG8_WAIT_V(2); PG8_BAR;
    PG8_STAGE(PG8_SB(1, 0), cB + kstep, voffB); PG8_STAGE(PG8_SA(1, 0), cA + kstep, voffA); PG8_STAGE(PG8_SB(1, 1), cB + hstep + kstep, voffB);
    PG8_WAIT_V(6); PG8_BAR;
    for (;;) {
        const bool has_next = S.next(ui + 1, nxt);
        const char* nA = has_next ? (const char*)g.A + (size_t)nxt.pm * tstep : cA; const char* nB = has_next ? (const char*)g.Bt + g.bsel(nxt.pm) + (size_t)nxt.pn * tstep : cB;
        for (int t = 0; t < nt; t += 2) {
            const bool last = (t == nt - 2);
            const char* a1 = cA + (size_t)(t + 1) * kstep;
            const char* a2 = last ? nA : cA + (size_t)(t + 2) * kstep; const char* b2 = last ? nB : cB + (size_t)(t + 2) * kstep;
            const char* a3 = a2 + kstep; const char* b3 = b2 + kstep;
            PG8_LDB(B0, 0, 0); PG8_LDB(B1, 0, 1); PG8_SCHED; PG8_LDA(At, 0, 0); PG8_STAGE(PG8_SA(1, 1), a1 + hstep, voffA);
            PG8_WAIT_V(8); PG8_WAIT_L(0); PG8_BAR; PG8_MMA(0, 0, At, B0); PG8_MMA(0, 1, At, B1); PG8_BAR; PG8_SCHED;
            PG8_LDA(At, 0, 1); PG8_STAGE(PG8_SB(0, 0), b2, voffB); PG8_STAGE(PG8_SB(0, 1), b2 + hstep, voffB); PG8_STAGE(PG8_SA(0, 0), a2, voffA);
            PG8_WAIT_V(8); PG8_WAIT_L(0); PG8_BAR; PG8_MMA(1, 0, At, B0); PG8_MMA(1, 1, At, B1); PG8_BAR; PG8_SCHED;
            PG8_LDB(B0, 1, 0); PG8_LDB(B1, 1, 1); PG8_SCHED; PG8_LDA(At, 1, 0); PG8_STAGE(PG8_SA(0, 1), a2 + hstep, voffA);
            PG8_WAIT_V(8); PG8_WAIT_L(0); PG8_BAR; PG8_MMA(0, 0, At, B0); PG8_MMA(0, 1, At, B1); PG8_BAR; PG8_SCHED;
            PG8_LDA(At, 1, 1); PG8_STAGE(PG8_SB(1, 0), b3, voffB); PG8_STAGE(PG8_SB(1, 1), b3 + hstep, voffB); PG8_STAGE(PG8_SA(1, 0), a3, voffA);
            PG8_WAIT_V(8); PG8_WAIT_L(0); PG8_BAR; PG8_MMA(1, 0, At, B0); PG8_MMA(1, 1, At, B1); PG8_BAR; PG8_SCHED;
        }
        if (wr == 0) PG8_BAR;
        E(acc, cur, wr, wc, fr, fq);
        if (!has_next) break;
#pragma unroll
        for (int a = 0; a < 2; ++a)
#pragma unroll
            for (int b = 0; b < 2; ++b)
#pragma unroll
                for (int m = 0; m < 4; ++m)
#pragma unroll
                    for (int n = 0; n < 2; ++n) acc[a][b][m][n] = (acc_t){0, 0, 0, 0};
        cur = nxt; cA = nA; cB = nB; ++ui;
        if (wr == 1) PG8_BAR;
    }
    PG8_WAIT_V(0);
    PG8_BAR;
#undef PG8_SA
#undef PG8_SB
#undef PG8_STAGE
#undef PG8_LDA
#undef PG8_LDB
#undef PG8_MMA
#undef PG8_WAIT_V
#undef PG8_WAIT_L
#undef PG8_BAR
#undef PG8_SCHED
}
}

__device__ __forceinline__ void p0_transpose_item(const float* W, int K, int N, bf16_t* WT, float* scr, int item, int lane) {
    const int nblk = N / 32, kb = item / nblk, nb = item % nblk, k0 = 64 * kb, n0 = 32 * nb;
#pragma unroll 8
    for (int i = 0; i < 32; ++i) { const int kk = 2 * i + (lane >> 5); scr[kk * 33 + (lane & 31)] = W[(size_t)(k0 + kk) * N + n0 + (lane & 31)]; }
    asm volatile("s_waitcnt lgkmcnt(0)" ::: "memory");
    const int c = lane & 7;
#pragma unroll
    for (int j = 0; j < 4; ++j) { const int n = (lane >> 3) + 8 * j; const float* s = scr + (8 * c) * 33 + n;
        u32x4 o; o.x = pk2(s[0 * 33], s[1 * 33]); o.y = pk2(s[2 * 33], s[3 * 33]); o.z = pk2(s[4 * 33], s[5 * 33]); o.w = pk2(s[6 * 33], s[7 * 33]);
        *(u32x4*)(WT + (size_t)(n0 + n) * K + k0 + 8 * c) = o; }
    asm volatile("s_waitcnt lgkmcnt(0)" ::: "memory");
}
__device__ __forceinline__ void p0_colmax_item(const float* W, int N, unsigned* cmax, int item, int lane) {
    const int ngrp = N / 256, kb = item / ngrp, gb = item % ngrp; const float* src = W + (size_t)(64 * kb) * N + 256 * gb + 4 * lane;
    f32x4 m = {0.f, 0.f, 0.f, 0.f};
#pragma unroll 8
    for (int k = 0; k < 64; ++k) { const f32x4 v = *(const f32x4*)(src + (size_t)k * N); m = (f32x4){fmaxf(m[0], fabsf(v[0])), fmaxf(m[1], fabsf(v[1])), fmaxf(m[2], fabsf(v[2])), fmaxf(m[3], fabsf(v[3]))}; }
#pragma unroll
    for (int e = 0; e < 4; ++e) atomicMax(cmax + 256 * gb + 4 * lane + e, __builtin_bit_cast(unsigned, m[e]));
}
__device__ __forceinline__ void p1_qt_item(const float* W, int K, int N, const unsigned* cmax, unsigned char* WT8, float* scr, int item, int lane) {
    const int nblk = N / 32, kb = item / nblk, nb = item % nblk, k0 = 64 * kb, n0 = 32 * nb;
#pragma unroll 8
    for (int i = 0; i < 32; ++i) { const int kk = 2 * i + (lane >> 5); scr[kk * 33 + (lane & 31)] = W[(size_t)(k0 + kk) * N + n0 + (lane & 31)]; }
    asm volatile("s_waitcnt lgkmcnt(0)" ::: "memory");
    const int c = lane & 7;
#pragma unroll
    for (int j = 0; j < 4; ++j) { const int n = (lane >> 3) + 8 * j; const float* sp_ = scr + (8 * c) * 33 + n;
        const float cm = __builtin_bit_cast(float, cmax[n0 + n]); const float inv = (cm > 1e-30f) ? 127.0f / cm : 0.f;
        u32x2 o; o.x = q8pack((f32x4){sp_[0 * 33], sp_[1 * 33], sp_[2 * 33], sp_[3 * 33]} * inv); o.y = q8pack((f32x4){sp_[4 * 33], sp_[5 * 33], sp_[6 * 33], sp_[7 * 33]} * inv);
        *(u32x2*)(WT8 + (size_t)(n0 + n) * K + k0 + 8 * c) = o; }
    asm volatile("s_waitcnt lgkmcnt(0)" ::: "memory");
}
__device__ __forceinline__ void cvt_item(const float* src, bf16_t* dst, size_t item, int lane) {
    const f32x4* s = (const f32x4*)(src + item * 512) + lane * 2; const f32x4 a = s[0], b = s[1];
    u32x4 o; o.x = pk2(a[0], a[1]); o.y = pk2(a[2], a[3]); o.z = pk2(b[0], b[1]); o.w = pk2(b[2], b[3]);
    *((u32x4*)(dst + item * 512) + lane) = o;
}

__device__ __forceinline__ void phase0(const Params& p, unsigned char* lds, int bid, int nblk) {
    int tid = threadIdx.x; asm volatile("" : "+v"(tid));
    const int lane = tid & 63, wave = __builtin_amdgcn_readfirstlane(tid >> 6);
    float* s_lds = (float*)lds;
    float* red = (float*)(lds + 24576);
    float* scr = (float*)(lds + 49152 + wave * 8448);
    float* MOD = (float*)(p.ws + WS_MOD);
    for (int i = tid; i < 3 * 2048; i += 512) { const int v = i >> 11, k = i & 2047; const float cv = (v < 2) ? p.c[v * 2048 + k] : p.c_ctx[k]; s_lds[i] = cv * sigmoidf_(cv); }
    __syncthreads();
    for (int it = bid; it < 256; it += nblk) {
        const int col0 = it * 48; const int cgp = tid % 12, kl = tid / 12;
        f32x4 a0 = {0.f, 0.f, 0.f, 0.f}, a1 = a0, a2 = a0;
        if (tid < 504) {
            const float* wp = p.w_mod + col0 + 4 * cgp;
#pragma unroll 7
            for (int k = kl; k < 2048; k += 42) { const f32x4 w = *(const f32x4*)(wp + (size_t)k * 12288); a0 += w * s_lds[k]; a1 += w * s_lds[2048 + k]; a2 += w * s_lds[4096 + k]; }
            float* r = red + kl * 144 + cgp * 4;
            *(f32x4*)(r) = a0; *(f32x4*)(r + 48) = a1; *(f32x4*)(r + 96) = a2;
        }
        __syncthreads();
        if (tid < 144) { float s = 0.f; for (int k = 0; k < 42; ++k) s += red[k * 144 + tid]; const int v = tid / 48, col = col0 + tid % 48; MOD[v * 12288 + col] = s + p.b_mod[col]; }
        __syncthreads();
    }
    if (bid == 0) { float* SP = (float*)(p.ws + WS_SP); for (int i = tid; i < 2048; i += 512) SP[i] = log1pf(expf(-p.lru_lam[i])); }
    const int gw = bid * 8 + wave, NGW = nblk * 8;
    constexpr int I_IN = G1_I8 ? 0 : 32 * 128, I_OUT = 32 * 64, I_Q = G3_I8 ? 32 * 8 : 32 * 64, I_LRU = 32 * 8;
    for (int it = gw; it < I_IN + I_OUT + I_Q + I_LRU; it += NGW) {
        int r = it;
        if (r < I_LRU) { const int mat = r >> 3, d = mat >> 4, m = (mat >> 3) & 1, h = mat & 7;
            p0_transpose_item((m ? p.lru_wx : p.lru_wa) + (size_t)(d * 8 + h) * 16384, 128, 128, (bf16_t*)(p.ws + WS_LRUW) + (size_t)mat * 16384, scr, r & 7, lane); continue; } r -= I_LRU;
#if G1_I8
#else
        if (r < I_IN) { p0_transpose_item(p.w_in, 2048, 4096, (bf16_t*)(p.ws + WS_WIN), scr, r, lane); continue; } r -= I_IN;
#endif
        if (r < I_OUT) { p0_transpose_item(p.w_out, 2048, 2048, (bf16_t*)(p.ws + WS_WOUT), scr, r, lane); continue; } r -= I_OUT;
#if G3_I8
        p0_colmax_item(p.wq, 2048, (unsigned*)(p.ws + WS_COLMAX_Q), r, lane);
#else
        p0_transpose_item(p.wq, 2048, 2048, (bf16_t*)(p.ws + WS_WQ), scr, r, lane);
#endif
    }
    constexpr int C_SM = 256;
    for (int it = gw; it < 3 * C_SM; it += NGW) {
        int r = it;
        if (r < C_SM) { cvt_item(p.sgu_w, (bf16_t*)(p.ws + WS_SGUW), r, lane); continue; } r -= C_SM;
        if (r < C_SM) { cvt_item(p.k1, (bf16_t*)(p.ws + WS_K1), r, lane); continue; } r -= C_SM;
        cvt_item(p.k2, (bf16_t*)(p.ws + WS_K2), r, lane);
    }
    for (int it = gw; it < 2 * 16384; it += NGW) {
        const int tab = it >> 14, row = it & 16383;
        const float* src = (tab ? p.pv : p.pu) + (size_t)row * D + 16 * lane;
        f32x4 v[2][4]; float am = 0.f;
#pragma unroll
        for (int c = 0; c < 2; ++c)
#pragma unroll
            for (int e = 0; e < 4; ++e) { v[c][e] = *(const f32x4*)(src + 1024 * c + 4 * e); am = fmaxf(am, fmaxf(fmaxf(fabsf(v[c][e][0]), fabsf(v[c][e][1])), fmaxf(fabsf(v[c][e][2]), fabsf(v[c][e][3])))); }
#pragma unroll
        for (int o = 1; o < 64; o <<= 1) am = fmaxf(am, __shfl_xor(am, o));
        const float inv = (am > 1e-30f) ? 127.0f / am : 0.f;
        unsigned char* dst = p.ws + (tab ? WS_VB : WS_UB) + ((size_t)(lane >> 3) * 16384 + row) * 128 + 16 * (lane & 7);
#pragma unroll
        for (int c = 0; c < 2; ++c) { u32x4 o;
#pragma unroll
            for (int e = 0; e < 4; ++e) o[e] = q8pack(v[c][e] * inv);
            *(u32x4*)(dst + (size_t)c * 8 * 16384 * 128) = o; }
        if (lane == 0) ((float*)(p.ws + WS_USC))[2 * row + tab] = am * (1.0f / 127.0f);
    }
}

__device__ __forceinline__ void norm_row_bf16(const float* xrow, const float* g, const float* shift, const float* scale, bf16_t* orow, int lane) {
    f32x4 v[8]; float ss = 0.f;
#pragma unroll
    for (int j = 0; j < 8; ++j) { v[j] = *((const f32x4*)xrow + lane + 64 * j); ss += (v[j][0] * v[j][0] + v[j][1] * v[j][1]) + (v[j][2] * v[j][2] + v[j][3] * v[j][3]); }
    const float rstd = rsqrtf(wave_sum(ss) * (1.0f / 2048.0f) + EPS);
#pragma unroll
    for (int j = 0; j < 8; ++j) {
        const f32x4 gg = *((const f32x4*)g + lane + 64 * j), sh = *((const f32x4*)shift + lane + 64 * j), sc = *((const f32x4*)scale + lane + 64 * j);
        const f32x4 h = (v[j] * rstd) * gg * (sc + 1.0f) + sh;
        u32x2 o; o.x = pk2(h[0], h[1]); o.y = pk2(h[2], h[3]);
        *((u32x2*)orow + lane + 64 * j) = o;
    }
}
__device__ __forceinline__ void xhat_row_q8(const float* xrow, unsigned char* o8, float* osc, int lane) {
    f32x4 v[8]; float ss = 0.f, am = 0.f;
#pragma unroll
    for (int j = 0; j < 8; ++j) { v[j] = *((const f32x4*)xrow + lane + 64 * j); ss += (v[j][0] * v[j][0] + v[j][1] * v[j][1]) + (v[j][2] * v[j][2] + v[j][3] * v[j][3]);
        am = fmaxf(am, fmaxf(fmaxf(fabsf(v[j][0]), fabsf(v[j][1])), fmaxf(fabsf(v[j][2]), fabsf(v[j][3])))); }
    const float rstd = rsqrtf(wave_sum(ss) * (1.0f / 2048.0f) + EPS);
#pragma unroll
    for (int o = 1; o < 64; o <<= 1) am = fmaxf(am, __shfl_xor(am, o));
    const float inv = (am > 1e-30f) ? 127.0f / am : 0.f;
#pragma unroll
    for (int j = 0; j < 8; ++j) *((unsigned*)o8 + lane + 64 * j) = q8pack(v[j] * inv);
    if (lane == 0) *osc = am * rstd * (1.0f / 127.0f);
}
__device__ __forceinline__ void p1_win3_item(const Params& p, int v, int nb, float* scr, int lane) {
    const float* MOD = (const float*)(p.ws + WS_MOD) + v * 12288;
    const int n0 = 16 * nb, cq = lane & 3, kq = lane >> 2;
    f32x4 mx = {0.f, 0.f, 0.f, 0.f}, bs = {0.f, 0.f, 0.f, 0.f};
#pragma unroll 8
    for (int i = 0; i < 128; ++i) { const int k = 16 * i + kq; const f32x4 w = *(const f32x4*)(p.w_in + (size_t)k * INW + n0 + 4 * cq);
        const float gsk = p.g1[k] * (1.0f + MOD[2048 + k]), shk = MOD[k];
        mx = (f32x4){fmaxf(mx[0], fabsf(w[0] * gsk)), fmaxf(mx[1], fabsf(w[1] * gsk)), fmaxf(mx[2], fabsf(w[2] * gsk)), fmaxf(mx[3], fabsf(w[3] * gsk))}; bs += w * shk; }
#pragma unroll
    for (int o = 4; o < 64; o <<= 1) { mx = (f32x4){fmaxf(mx[0], __shfl_xor(mx[0], o)), fmaxf(mx[1], __shfl_xor(mx[1], o)), fmaxf(mx[2], __shfl_xor(mx[2], o)), fmaxf(mx[3], __shfl_xor(mx[3], o))};
        bs = (f32x4){bs[0] + __shfl_xor(bs[0], o), bs[1] + __shfl_xor(bs[1], o), bs[2] + __shfl_xor(bs[2], o), bs[3] + __shfl_xor(bs[3], o)}; }
    float* CS = (float*)(p.ws + WS_CS1) + v * 4096; float* BI = (float*)(p.ws + WS_BIAS1) + v * 4096;
    if (kq == 0) { *(f32x4*)(CS + n0 + 4 * cq) = mx * (1.0f / 127.0f); *(f32x4*)(BI + n0 + 4 * cq) = bs; }
    const int n = lane >> 2, c = lane & 3;
    float cm;
    { const float c0 = __shfl(mx[0], n >> 2), c1 = __shfl(mx[1], n >> 2), c2 = __shfl(mx[2], n >> 2), c3 = __shfl(mx[3], n >> 2);
      cm = ((n & 3) == 0) ? c0 : ((n & 3) == 1) ? c1 : ((n & 3) == 2) ? c2 : c3; }
    const float inv = (cm > 1e-30f) ? 127.0f / cm : 0.f;
    unsigned char* WT8 = p.ws + WS_WIN3 + (size_t)v * 4096 * 2048;
    for (int kb = 0; kb < 32; ++kb) {
        const int k0 = 64 * kb;
#pragma unroll
        for (int r = 0; r < 4; ++r) { const int kk = kq + 16 * r, k = k0 + kk; const f32x4 w = *(const f32x4*)(p.w_in + (size_t)k * INW + n0 + 4 * cq) * (p.g1[k] * (1.0f + MOD[2048 + k]));
            float* d = scr + kk * 17 + 4 * cq; d[0] = w[0]; d[1] = w[1]; d[2] = w[2]; d[3] = w[3]; }
        asm volatile("s_waitcnt lgkmcnt(0)" ::: "memory");
        const float* sp_ = scr + (16 * c) * 17 + n;
        u32x4 o;
#pragma unroll
        for (int e = 0; e < 4; ++e) o[e] = q8pack((f32x4){sp_[(4 * e + 0) * 17], sp_[(4 * e + 1) * 17], sp_[(4 * e + 2) * 17], sp_[(4 * e + 3) * 17]} * inv);
        *(u32x4*)(WT8 + (size_t)(n0 + n) * 2048 + k0 + 16 * c) = o;
        asm volatile("s_waitcnt lgkmcnt(0)" ::: "memory");
    }
}
template <bool BF16COPY>
__device__ __forceinline__ void norm_row_q8(const float* xrow, const float* g, const float* shift, const float* scale, unsigned char* o8, float* osc, int lane, bf16_t* obf = nullptr, const bf16_t* addrow = nullptr, bf16_t* sumout = nullptr) {
    f32x4 v[8]; float ss = 0.f;
#pragma unroll
    for (int j = 0; j < 8; ++j) { v[j] = *((const f32x4*)xrow + lane + 64 * j);
        if (addrow) { const u32x2 a = *((const u32x2*)addrow + lane + 64 * j); v[j] += (f32x4){bflo(a.x), bfhi(a.x), bflo(a.y), bfhi(a.y)}; }
        if (sumout) { u32x2 o; o.x = pk2(v[j][0], v[j][1]); o.y = pk2(v[j][2], v[j][3]); *((u32x2*)sumout + lane + 64 * j) = o; }
        ss += (v[j][0] * v[j][0] + v[j][1] * v[j][1]) + (v[j][2] * v[j][2] + v[j][3] * v[j][3]); }
    const float rstd = rsqrtf(wave_sum(ss) * (1.0f / 2048.0f) + EPS);
    float am = 0.f;
#pragma unroll
    for (int j = 0; j < 8; ++j) {
        const f32x4 gg = *((const f32x4*)g + lane + 64 * j), sh = *((const f32x4*)shift + lane + 64 * j), sc = *((const f32x4*)scale + lane + 64 * j);
        const f32x4 h = (v[j] * rstd) * gg * (sc + 1.0f) + sh; v[j] = h;
        if (BF16COPY) { u32x2 o; o.x = pk2(h[0], h[1]); o.y = pk2(h[2], h[3]); *((u32x2*)obf + lane + 64 * j) = o; }
        am = fmaxf(am, fmaxf(fmaxf(fabsf(h[0]), fabsf(h[1])), fmaxf(fabsf(h[2]), fabsf(h[3]))));
    }
#pragma unroll
    for (int o = 1; o < 64; o <<= 1) am = fmaxf(am, __shfl_xor(am, o));
    const float inv = (am > 1e-30f) ? 127.0f / am : 0.f;
#pragma unroll
    for (int j = 0; j < 8; ++j) *((unsigned*)o8 + lane + 64 * j) = q8pack(v[j] * inv);
    if (lane == 0) *osc = am * (1.0f / 127.0f);
}
__device__ __forceinline__ void phase_norm1(const Params& p, unsigned char* lds, int bid, int nblk) {
    int tid = threadIdx.x; asm volatile("" : "+v"(tid));
    const int lane = tid & 63, wave = __builtin_amdgcn_readfirstlane(tid >> 6);
    const float* MOD = (const float*)(p.ws + WS_MOD); unsigned char* HN8 = p.ws + WS_HN; float* RS1 = (float*)(p.ws + WS_RS1);
    float* scr = (float*)(lds + wave * 8448);
    const int gw = bid * 8 + wave, NGW = nblk * 8;
    constexpr int I_IN = G1_I8 ? 3 * 256 : 0, I_Q = G3_I8 ? 32 * 64 : 0;
    for (int it = gw; it < I_IN + I_Q; it += NGW) {
        if (it < I_IN) p1_win3_item(p, it / 256, it % 256, scr, lane);
        else p1_qt_item(p.wq, 2048, 2048, (const unsigned*)(p.ws + WS_COLMAX_Q), p.ws + WS_WQ, scr, it - I_IN, lane);
    }
    unsigned* rowctr = (unsigned*)(p.ws + WS_CTL + 49152);
    for (;;) {
      int r0 = 0; if (lane == 0) r0 = (int)atomicAdd(rowctr, 4u); r0 = __builtin_amdgcn_readfirstlane(r0);
      if (r0 >= MALL) break;
      for (int row = r0; row < r0 + 4 && row < MALL; ++row) {
        const bool isctx = row >= MLAT; const int v = isctx ? 2 : (row >> 14);
        const float* xr = isctx ? p.ctx + (size_t)(row - MLAT) * D : p.x + (size_t)row * D;
#if G1_I8
        xhat_row_q8(xr, HN8 + (size_t)row * D, RS1 + row, lane); (void)v; (void)MOD;
#else
        norm_row_bf16(xr, p.g1, MOD + v * 12288, MOD + v * 12288 + 2048, (bf16_t*)(p.ws + WS_HN) + (size_t)row * D, lane);
#endif
      }
    }
}
__device__ __forceinline__ void xl_row_q8(const bf16_t* xl, const float* g, const float* shift, const float* scale, unsigned char* o8, float* osc, int lane) {
    f32x4 v[8]; float ss = 0.f;
#pragma unroll
    for (int j = 0; j < 8; ++j) { const u32x2 a = *((const u32x2*)xl + lane + 64 * j); v[j] = (f32x4){bflo(a.x), bfhi(a.x), bflo(a.y), bfhi(a.y)};
        ss += (v[j][0] * v[j][0] + v[j][1] * v[j][1]) + (v[j][2] * v[j][2] + v[j][3] * v[j][3]); }
    const float rstd = rsqrtf(wave_sum(ss) * (1.0f / 2048.0f) + EPS);
    float am = 0.f;
#pragma unroll
    for (int j = 0; j < 8; ++j) {
        const f32x4 gg = *((const f32x4*)g + lane + 64 * j), sh = *((const f32x4*)shift + lane + 64 * j), sc = *((const f32x4*)scale + lane + 64 * j);
        const f32x4 h = (v[j] * rstd) * gg * (sc + 1.0f) + sh; v[j] = h;
        am = fmaxf(am, fmaxf(fmaxf(fabsf(h[0]), fabsf(h[1])), fmaxf(fabsf(h[2]), fabsf(h[3]))));
    }
#pragma unroll
    for (int o = 1; o < 64; o <<= 1) am = fmaxf(am, __shfl_xor(am, o));
    const float inv = (am > 1e-30f) ? 127.0f / am : 0.f;
#pragma unroll
    for (int j = 0; j < 8; ++j) *((unsigned*)o8 + lane + 64 * j) = q8pack(v[j] * inv);
    if (lane == 0) *osc = am * (1.0f / 127.0f);
}
__device__ __forceinline__ void phase_norm2(const Params& p, int bid, int nblk) {
    int tid = threadIdx.x; asm volatile("" : "+v"(tid));
    const int lane = tid & 63, wave = __builtin_amdgcn_readfirstlane(tid >> 6);
    const float* MOD = (const float*)(p.ws + WS_MOD);
    for (int row = bid * 8 + wave; row < MLAT; row += nblk * 8) {
        const int v = row >> 14;
        xl_row_q8((const bf16_t*)(p.ws + WS_YL) + (size_t)row * D, p.g2, MOD + v * 12288 + 3 * 2048, MOD + v * 12288 + 4 * 2048, p.ws + WS_HN8 + (size_t)row * D, (float*)(p.ws + WS_HSC) + row, lane);
    }
}

constexpr int XCB_LD = 136, XCF_LD = 132;
constexpr size_t WS_CARRY = 596 * MiB;

__device__ __forceinline__ void lru_ab(float ga, float gx, float ba, float bx, float sp, float xv, float& a, float& b) {
    const float rg = __builtin_amdgcn_rcpf(1.0f + __builtin_amdgcn_exp2f(fmaf(ga, -1.4426950408889634f, ba)));
    const float ig = __builtin_amdgcn_rcpf(1.0f + __builtin_amdgcn_exp2f(fmaf(gx, -1.4426950408889634f, bx)));
    a = __builtin_amdgcn_exp2f(rg * sp);
    const float em = fmaf(-a, a, 1.0f);
    b = __builtin_amdgcn_sqrtf(em) * ig * xv;
}
__device__ __forceinline__ void lru_gates1(const bf16_t* xcb, const float* xcf, int mt, int cc, int q4, int chl, const bf16x8 (&Bwa)[4], const bf16x8 (&Bwx)[4],
                                           float ba, float bx, float sp, float (&a)[4], float (&b)[4]) {
    f32x4 ga = {0.f, 0.f, 0.f, 0.f}, gx = {0.f, 0.f, 0.f, 0.f};
#pragma unroll
    for (int ks = 0; ks < 4; ++ks) {
        const bf16x8 A = *(const bf16x8*)(xcb + (16 * mt + cc) * XCB_LD + 32 * ks + 8 * q4);
        ga = __builtin_amdgcn_mfma_f32_16x16x32_bf16(A, Bwa[ks], ga, 0, 0, 0);
        gx = __builtin_amdgcn_mfma_f32_16x16x32_bf16(A, Bwx[ks], gx, 0, 0, 0);
    }
#pragma unroll
    for (int r = 0; r < 4; ++r) lru_ab(ga[r], gx[r], ba, bx, sp, xcf[(16 * mt + 4 * q4 + r) * XCF_LD + chl], a[r], b[r]);
}

__device__ __forceinline__ void carry_phase(const Params& p, int bid, int nblk) {
    int tid = threadIdx.x; asm volatile("" : "+v"(tid));
    const float* SUMS = (const float*)(p.ws + WS_SUMS); float* CARRY = (float*)(p.ws + WS_CARRY);
    for (int gid = bid * 512 + tid; gid < 4096; gid += nblk * 512) {
        const int b = gid >> 11, d = (gid >> 10) & 1, ch = gid & 1023;
        const float* sb = SUMS + (size_t)b * NSEG * 4096 + d * 2048 + ch;
        float* cb = CARRY + (size_t)b * 128 * 2048 + d * 1024 + ch;
        if (d == 0) {
            float h = sb[1024]; h = sb[4096] * h + sb[4096 + 1024];
#pragma unroll 8
            for (int c = 0; c < 128; ++c) { cb[(size_t)c * 2048] = h; h = sb[(size_t)(c + 2) * 4096] * h + sb[(size_t)(c + 2) * 4096 + 1024]; }
        } else {
            float h = sb[4096 + 1024]; h = sb[0] * h + sb[1024];
#pragma unroll 8
            for (int c = 127; c >= 0; --c) { cb[(size_t)c * 2048] = h; h = sb[(size_t)(c + 2) * 4096] * h + sb[(size_t)(c + 2) * 4096 + 1024]; }
        }
    }
}

__device__ __forceinline__ void wait_count(unsigned* ctr, unsigned target) {
    unsigned sp = 0u;
    while (__hip_atomic_load(ctr, __ATOMIC_RELAXED, __HIP_MEMORY_SCOPE_AGENT) < target) { __builtin_amdgcn_s_sleep(2); if (++sp > (1u << 22)) break; }
    __builtin_amdgcn_fence(__ATOMIC_ACQUIRE, "agent");
    asm volatile("s_waitcnt vmcnt(0)" ::: "memory");
}
template <bool APPLY>
__device__ __forceinline__ void lru_phase(const Params& p, unsigned char* lds, int bid, int nblk) {
    int tid = threadIdx.x; asm volatile("" : "+v"(tid));
    const int lane = tid & 63, w = __builtin_amdgcn_readfirstlane(tid >> 6), cc = lane & 15, q4 = lane >> 4;
    const int pg = tid >> 4, c8 = tid & 15;
    bf16_t* xcb = (bf16_t*)lds;
    float* xcf = (float*)(lds + 34816);
    float* cw = (float*)(lds + 102400);
    const bf16_t* PROJ = (const bf16_t*)(p.ws + WS_PROJ);
    float* SUMS = (float*)(p.ws + WS_SUMS);
    const float* SP = (const float*)(p.ws + WS_SP);
    const float* CARRY = (const float*)(p.ws + WS_CARRY);
    bf16_t* Y = (bf16_t*)(p.ws + WS_HN);
    const bf16_t* LRUW = (const bf16_t*)(p.ws + WS_LRUW);
    constexpr int NS = APPLY ? 128 : NSEG;
    const int nitems = 2 * NS * 8;
    int cur_h = -1;
    const int chl = 16 * w + cc;
    bf16x8 Bw[2][2][4];
    float ba[2], bx[2], sp[2];
#pragma unroll
    for (int d = 0; d < 2; ++d) { ba[d] = 0.f; bx[d] = 0.f; sp[d] = 0.f;
#pragma unroll
        for (int m = 0; m < 2; ++m)
#pragma unroll
            for (int ks = 0; ks < 4; ++ks) Bw[d][m][ks] = (bf16x8){0, 0, 0, 0, 0, 0, 0, 0}; }
#define LRU_DECODE(it_) const int h = (it_) & 7, bs = (it_) >> 3, b = APPLY ? bs / NS : (bs < 256 ? bs >> 7 : (bs - 256) >> 1), sg = APPLY ? bs % NS : (bs < 256 ? 2 + (bs & 127) : (bs - 256) & 1); const int seg = APPLY ? sg + 2 : sg; const bool isctx = seg < 2;        \
        const int L = isctx ? CTXL : SEQ; const int p0 = isctx ? seg * 128 : (seg - 2) * 128; const size_t rowbase = isctx ? (size_t)(MLAT + b * CTXL) : (size_t)b * SEQ;
#define LRU_LOADRAW(dst) { _Pragma("unroll") for (int i = 0; i < 7; ++i) { const int r = p0 + 4 * pg - 2 + i; const bool ok = (r >= 0) && (r < L); \
            dst[i] = ok ? *(const u32x4*)(PROJ + (rowbase + (size_t)(ok ? r : 0)) * INW + h * 128 + 8 * c8) : (u32x4){0u, 0u, 0u, 0u}; } }
    bool ctx_ready = !(G1_I8 && CTX_SPLIT) || APPLY;
#define LRU_CTXWAIT(it_) if (!ctx_ready && ((it_) >> 3) >= 256) { if (tid == 0) wait_count((unsigned*)(p.ws + WS_CTL + CTXDONE_OFS), 8u); __syncthreads(); ctx_ready = true; }
    u32x4 rw[7];
    unsigned* lctr = (unsigned*)(p.ws + WS_CTL + 45120) + (bid & 7);
    volatile int* nxl = (volatile int*)(lds + 105216);
    int it = bid, itn = bid + nblk, itnn = 0;
    if (!APPLY) {
        if (tid == 0) { nxl[0] = (int)atomicAdd(lctr, 1u) * 8 + (bid & 7); nxl[1] = (int)atomicAdd(lctr, 1u) * 8 + (bid & 7); }
        __syncthreads();
        it = nxl[0]; itn = nxl[1];
        __syncthreads();
        if (it < nitems) { LRU_CTXWAIT(it) LRU_DECODE(it) LRU_LOADRAW(rw) }
    }
    for (; it < nitems; it = itn, itn = APPLY ? itn + nblk : itnn) {
        LRU_DECODE(it)
        if (!APPLY) { if (tid == 0) nxl[0] = (int)atomicAdd(lctr, 1u) * 8 + (bid & 7); }
        if (APPLY) { LRU_LOADRAW(rw) }
#define LRU_LOADW2(d_, W0, W1) { const bf16_t* wa_ = LRUW + ((size_t)(((d_) * 2 + 0) * 8 + h) * 128 + chl) * 128 + 8 * q4; const bf16_t* wx_ = LRUW + ((size_t)(((d_) * 2 + 1) * 8 + h) * 128 + chl) * 128 + 8 * q4; \
            _Pragma("unroll") for (int ks = 0; ks < 4; ++ks) { W0[ks] = *(const bf16x8*)(wa_ + 32 * ks); W1[ks] = *(const bf16x8*)(wx_ + 32 * ks); } }
        if (h != cur_h) {
            cur_h = h;
#pragma unroll
            for (int d = 0; d < 2; ++d) {
                if (APPLY) { ba[d] = -1.4426950408889634f * p.lru_ba[d * 1024 + h * 128 + chl]; bx[d] = -1.4426950408889634f * p.lru_bx[d * 1024 + h * 128 + chl]; sp[d] = -8.0f * 1.4426950408889634f * SP[d * 1024 + h * 128 + chl]; continue; }
                const bf16_t* wa_ = LRUW + ((size_t)((d * 2 + 0) * 8 + h) * 128 + chl) * 128 + 8 * q4; const bf16_t* wx_ = LRUW + ((size_t)((d * 2 + 1) * 8 + h) * 128 + chl) * 128 + 8 * q4;
#pragma unroll
                for (int ks = 0; ks < 4; ++ks) { Bw[d][0][ks] = *(const bf16x8*)(wa_ + 32 * ks); Bw[d][1][ks] = *(const bf16x8*)(wx_ + 32 * ks); }
                ba[d] = -1.4426950408889634f * p.lru_ba[d * 1024 + h * 128 + chl]; bx[d] = -1.4426950408889634f * p.lru_bx[d * 1024 + h * 128 + chl]; sp[d] = -8.0f * 1.4426950408889634f * SP[d * 1024 + h * 128 + chl];
            }
            for (int i = tid; i < 640; i += 512) { const int k = i >> 7, ch = i & 127; cw[i] = (k < 4) ? p.conv_w[k * 1024 + h * 128 + ch] : p.conv_b[h * 128 + ch]; }
            __syncthreads();
        }
        {
            f32x4 wk[5][2];
#pragma unroll
            for (int k = 0; k < 5; ++k) { wk[k][0] = *(const f32x4*)(cw + k * 128 + 8 * c8); wk[k][1] = *(const f32x4*)(cw + k * 128 + 8 * c8 + 4); }
#pragma unroll
            for (int j = 0; j < 4; ++j) {
                f32x4 x0 = wk[4][0], x1 = wk[4][1];
#pragma unroll
                for (int k = 0; k < 4; ++k) { const u32x4 r = rw[j + k];
                    x0 += wk[k][0] * (f32x4){bflo(r[0]), bfhi(r[0]), bflo(r[1]), bfhi(r[1])};
                    x1 += wk[k][1] * (f32x4){bflo(r[2]), bfhi(r[2]), bflo(r[3]), bfhi(r[3])}; }
                const int pos = 4 * pg + j;
                *(f32x4*)(xcf + pos * XCF_LD + 8 * c8) = x0; *(f32x4*)(xcf + pos * XCF_LD + 8 * c8 + 4) = x1;
                u32x4 o; o.x = pk2(x0[0], x0[1]); o.y = pk2(x0[2], x0[3]); o.z = pk2(x1[0], x1[1]); o.w = pk2(x1[2], x1[3]);
                *(u32x4*)(xcb + pos * XCB_LD + 8 * c8) = o;
            }
        }
        u32x4 gt[4]; float cf = 0.f, cbw = 0.f;
        if (APPLY) {
            const float* cp = CARRY + ((size_t)(b * 128 + sg) * 2) * 1024 + h * 128 + chl; cf = cp[0]; cbw = cp[1024];
        }
        if (!APPLY) { if (itn < nitems) { LRU_CTXWAIT(itn) LRU_DECODE(itn) LRU_LOADRAW(rw) } }
        __syncthreads();
        if (!APPLY) itnn = nxl[0];
        if (APPLY) {
            float y[8][4];
#pragma unroll
            for (int mt = 0; mt < 8; ++mt)
#pragma unroll
                for (int r = 0; r < 4; ++r) y[mt][r] = 0.f;
            float stf = cf, stb = cbw;
            bf16x8 Wf0[4], Wf1[4];
            LRU_LOADW2(0, Wf0, Wf1)
#pragma unroll
            for (int i = 0; i < 8; ++i) {
                const int mt = i; float a[4], bb[4];
                lru_gates1(xcb, xcf, mt, cc, q4, chl, Wf0, Wf1, ba[0], bx[0], sp[0], a, bb);
                float A4 = a[0], B4 = bb[0];
#pragma unroll
                for (int r = 1; r < 4; ++r) { B4 = a[r] * B4 + bb[r]; A4 *= a[r]; }
                const float A0 = __shfl(A4, cc), A1 = __shfl(A4, cc + 16), A2 = __shfl(A4, cc + 32), A3 = __shfl(A4, cc + 48);
                const float B0 = __shfl(B4, cc), B1 = __shfl(B4, cc + 16), B2 = __shfl(B4, cc + 32), B3 = __shfl(B4, cc + 48);
                const float s0 = stf, s1 = A0 * s0 + B0, s2 = A1 * s1 + B1, s3 = A2 * s2 + B2, s4 = A3 * s3 + B3;
                float hh = (q4 == 0) ? s0 : (q4 == 1) ? s1 : (q4 == 2) ? s2 : s3;
#pragma unroll
                for (int r = 0; r < 4; ++r) { hh = a[r] * hh + bb[r]; y[mt][r] += hh; }
                stf = s4;
                if (i & 1) __builtin_amdgcn_sched_barrier(0);
            }
            bf16x8 Wb0[4], Wb1[4];
            LRU_LOADW2(1, Wb0, Wb1)
#pragma unroll
            for (int i = 0; i < 8; ++i) {
                const int mt = 7 - i; float a[4], bb[4];
                lru_gates1(xcb, xcf, mt, cc, q4, chl, Wb0, Wb1, ba[1], bx[1], sp[1], a, bb);
                float A4 = a[3], B4 = bb[3];
#pragma unroll
                for (int r = 2; r >= 0; --r) { B4 = a[r] * B4 + bb[r]; A4 *= a[r]; }
                const float A0 = __shfl(A4, cc), A1 = __shfl(A4, cc + 16), A2 = __shfl(A4, cc + 32), A3 = __shfl(A4, cc + 48);
                const float B0 = __shfl(B4, cc), B1 = __shfl(B4, cc + 16), B2 = __shfl(B4, cc + 32), B3 = __shfl(B4, cc + 48);
                const float s0 = stb, s1 = A3 * s0 + B3, s2 = A2 * s1 + B2, s3 = A1 * s2 + B1, s4 = A0 * s3 + B0;
                float hh = (q4 == 3) ? s0 : (q4 == 2) ? s1 : (q4 == 1) ? s2 : s3;
#pragma unroll
                for (int r = 3; r >= 0; --r) { hh = a[r] * hh + bb[r]; y[mt][r] += hh; }
                stb = s4;
                if (i & 1) __builtin_amdgcn_sched_barrier(0);
            }
#pragma unroll
            for (int j = 0; j < 4; ++j) gt[j] = *(const u32x4*)(PROJ + (rowbase + p0 + 4 * pg + j) * INW + 1024 + h * 128 + 8 * c8);
            __syncthreads();
#pragma unroll
            for (int mt = 0; mt < 8; ++mt)
#pragma unroll
                for (int r = 0; r < 4; ++r) xcf[(16 * mt + 4 * q4 + r) * XCF_LD + chl] = y[mt][r];
            __syncthreads();
#pragma unroll
            for (int j = 0; j < 4; ++j) {
                const int pos = 4 * pg + j;
                const f32x4 y0 = *(const f32x4*)(xcf + pos * XCF_LD + 8 * c8), y1 = *(const f32x4*)(xcf + pos * XCF_LD + 8 * c8 + 4);
                const u32x4 g = gt[j];
                u32x4 o;
                o.x = pk2(gelu_tanh(bflo(g[0])) * y0[0], gelu_tanh(bfhi(g[0])) * y0[1]); o.y = pk2(gelu_tanh(bflo(g[1])) * y0[2], gelu_tanh(bfhi(g[1])) * y0[3]);
                o.z = pk2(gelu_tanh(bflo(g[2])) * y1[0], gelu_tanh(bfhi(g[2])) * y1[1]); o.w = pk2(gelu_tanh(bflo(g[3])) * y1[2], gelu_tanh(bfhi(g[3])) * y1[3]);
                *(u32x4*)(Y + (rowbase + p0 + pos) * D + h * 128 + 8 * c8) = o;
            }
        } else {
            float TA[2] = {1.f, 1.f}, TB[2] = {0.f, 0.f};
#pragma unroll 2
            for (int mt = 0; mt < 8; ++mt) {
                f32x4 gaf = {0.f, 0.f, 0.f, 0.f}, gxf = gaf, gab = gaf, gxb = gaf;
#pragma unroll
                for (int ks = 0; ks < 4; ++ks) {
                    const bf16x8 A = *(const bf16x8*)(xcb + (16 * mt + cc) * XCB_LD + 32 * ks + 8 * q4);
                    gaf = __builtin_amdgcn_mfma_f32_16x16x32_bf16(A, Bw[0][0][ks], gaf, 0, 0, 0);
                    gxf = __builtin_amdgcn_mfma_f32_16x16x32_bf16(A, Bw[0][1][ks], gxf, 0, 0, 0);
                    gab = __builtin_amdgcn_mfma_f32_16x16x32_bf16(A, Bw[1][0][ks], gab, 0, 0, 0);
                    gxb = __builtin_amdgcn_mfma_f32_16x16x32_bf16(A, Bw[1][1][ks], gxb, 0, 0, 0);
                }
                float af[4], bf[4], ab[4], bbk[4];
#pragma unroll
                for (int r = 0; r < 4; ++r) { const float xv = xcf[(16 * mt + 4 * q4 + r) * XCF_LD + chl];
                    lru_ab(gaf[r], gxf[r], ba[0], bx[0], sp[0], xv, af[r], bf[r]); lru_ab(gab[r], gxb[r], ba[1], bx[1], sp[1], xv, ab[r], bbk[r]); }
                float FA = af[0], FB = bf[0], RA = ab[3], RB = bbk[3];
#pragma unroll
                for (int r = 1; r < 4; ++r) { FB = af[r] * FB + bf[r]; FA *= af[r]; }
#pragma unroll
                for (int r = 2; r >= 0; --r) { RB = ab[r] * RB + bbk[r]; RA *= ab[r]; }
                {   const float A0 = __shfl(FA, cc), A1 = __shfl(FA, cc + 16), A2 = __shfl(FA, cc + 32), A3 = __shfl(FA, cc + 48);
                    const float B0 = __shfl(FB, cc), B1 = __shfl(FB, cc + 16), B2 = __shfl(FB, cc + 32), B3 = __shfl(FB, cc + 48);
                    const float At = A0 * A1 * A2 * A3, Bt = ((B0 * A1 + B1) * A2 + B2) * A3 + B3;
                    TB[0] = At * TB[0] + Bt; TA[0] = TA[0] * At; }
                {   const float A0 = __shfl(RA, cc), A1 = __shfl(RA, cc + 16), A2 = __shfl(RA, cc + 32), A3 = __shfl(RA, cc + 48);
                    const float B0 = __shfl(RB, cc), B1 = __shfl(RB, cc + 16), B2 = __shfl(RB, cc + 32), B3 = __shfl(RB, cc + 48);
                    const float At = A0 * A1 * A2 * A3, Bt = ((B3 * A2 + B2) * A1 + B1) * A0 + B0;
                    TB[1] = TA[1] * Bt + TB[1]; TA[1] = At * TA[1]; }
            }
            if (q4 == 0) {
#pragma unroll
                for (int d = 0; d < 2; ++d) { float* sb = SUMS + ((size_t)(b * NSEG + seg) * 2 + d) * 2048 + h * 128 + chl; sb[0] = TA[d]; sb[1024] = TB[d]; }
            }
        }
        __syncthreads();
    }
#undef LRU_DECODE
#undef LRU_LOADRAW
#undef LRU_LOADW2
#undef LRU_CTXWAIT
}

__device__ __forceinline__ void sgu_phase(const Params& p, unsigned char* lds, int bid, int nblk) {
    int tid = threadIdx.x; asm volatile("" : "+v"(tid));
    const int lane = tid & 63, w = __builtin_amdgcn_readfirstlane(tid >> 6), cc = lane & 15, q4 = lane >> 4;
    bf16_t* vgT = (bf16_t*)lds;
    float* part = (float*)(lds + 34816);
    bf16_t* Wl = (bf16_t*)(lds + 38912);
    const bf16_t* PROJ = (const bf16_t*)(p.ws + WS_PROJ);
    const bf16_t* WS_ = (const bf16_t*)(p.ws + WS_SGUW);
    bf16_t* Y = (bf16_t*)(p.ws + WS_HN);
    const int pp1 = tid & 127, cg4 = tid >> 7;
    const int c0 = 16 * w + 4 * q4;
    const int g = bid & 7;
    unsigned* ctr = (unsigned*)(p.ws + WS_CTL + 45056) + g;
    volatile int* nxtw = (volatile int*)(lds + 73728);
    if (tid == 0) nxtw[0] = (int)atomicAdd(ctr, 1u);
#pragma unroll
    for (int e = 0; e < 4; ++e) { const int i = tid + 512 * e; const int r = i >> 4, c16 = i & 15; *(u32x4*)(Wl + r * XCB_LD + 8 * c16) = *(const u32x4*)(WS_ + ((size_t)g * 128 + r) * 128 + 8 * c16); }
    __syncthreads();
    int jt = nxtw[0];
    float bsr[8];
#pragma unroll
    for (int nt = 0; nt < 8; ++nt) bsr[nt] = p.sgu_b[g * 128 + 16 * nt + cc];
    u32x4 vr[4];
    if (jt < 256) { const u32x4* src = (const u32x4*)(PROJ + ((size_t)(jt >> 7) * SEQ + (size_t)(jt & 127) * 128 + pp1) * INW + 3072 + g * 128 + 32 * cg4);
#pragma unroll
        for (int e = 0; e < 4; ++e) vr[e] = src[e]; }
    while (jt < 256) {
        const int n = jt & 127, b = jt >> 7;
        const size_t rowbase = (size_t)b * SEQ + (size_t)n * 128;
        if (tid == 0) nxtw[1] = (int)atomicAdd(ctr, 1u);
        u32x2 ur[8];
#pragma unroll
        for (int nt = 0; nt < 8; ++nt) ur[nt] = *(const u32x2*)(PROJ + (rowbase + 16 * nt + cc) * INW + 2048 + g * 128 + c0);
        {
            float gv[32]; float s1 = 0.f, s2 = 0.f;
#pragma unroll
            for (int e = 0; e < 4; ++e) { const u32x4 r = vr[e];
#pragma unroll
                for (int j = 0; j < 4; ++j) { const float lo = gelu_tanh(bflo(r[j])), hi = gelu_tanh(bfhi(r[j])); gv[8 * e + 2 * j] = lo; gv[8 * e + 2 * j + 1] = hi; s1 += lo + hi; s2 += lo * lo + hi * hi; } }
            part[(cg4 * 128 + pp1) * 2] = s1; part[(cg4 * 128 + pp1) * 2 + 1] = s2;
            __syncthreads();
            jt = nxtw[1];
            if (jt < 256) { const u32x4* src = (const u32x4*)(PROJ + ((size_t)(jt >> 7) * SEQ + (size_t)(jt & 127) * 128 + pp1) * INW + 3072 + g * 128 + 32 * cg4);
#pragma unroll
                for (int e = 0; e < 4; ++e) vr[e] = src[e]; }
            float ts = 0.f, ts2 = 0.f;
#pragma unroll
            for (int k = 0; k < 4; ++k) { ts += part[(k * 128 + pp1) * 2]; ts2 += part[(k * 128 + pp1) * 2 + 1]; }
            const float mu = ts * (1.0f / 128.0f); const float var = fmaxf(ts2 * (1.0f / 128.0f) - mu * mu, 0.f); const float rstd = rsqrtf(var + EPS);
#pragma unroll
            for (int j = 0; j < 32; ++j) vgT[(32 * cg4 + j) * XCB_LD + pp1] = (bf16_t)f2bf((gv[j] - mu) * rstd);
        }
        __syncthreads();
        {
            bf16x8 Af[4];
#pragma unroll
            for (int ks = 0; ks < 4; ++ks) Af[ks] = *(const bf16x8*)(vgT + (16 * w + cc) * XCB_LD + 32 * ks + 8 * q4);
#pragma unroll
            for (int nt = 0; nt < 8; ++nt) {
                const int pp = 16 * nt + cc;
                f32x4 acc = {0.f, 0.f, 0.f, 0.f};
#pragma unroll
                for (int ks = 0; ks < 4; ++ks) { const bf16x8 Bf = *(const bf16x8*)(Wl + pp * XCB_LD + 32 * ks + 8 * q4); acc = __builtin_amdgcn_mfma_f32_16x16x32_bf16(Af[ks], Bf, acc, 0, 0, 0); }
                const float bsv = bsr[nt];
                const u32x2 uu = ur[nt];
                const float y0 = gelu_tanh(bflo(uu.x)) * (acc[0] + bsv), y1 = gelu_tanh(bfhi(uu.x)) * (acc[1] + bsv), y2 = gelu_tanh(bflo(uu.y)) * (acc[2] + bsv), y3 = gelu_tanh(bfhi(uu.y)) * (acc[3] + bsv);
                u32x2 o; o.x = pk2(y0, y1); o.y = pk2(y2, y3);
                *(u32x2*)(Y + (rowbase + pp) * D + 1024 + g * 128 + c0) = o;
            }
        }
        __syncthreads();
    }
}

#define INS16(S, x) do { int _x = (x); _Pragma("unroll") for (int _j = 0; _j < 16; ++_j) { const int _hi = max(S[_j], _x); _x = min(S[_j], _x); S[_j] = _hi; } } while (0)
#define MERGE16(A, B) do { _Pragma("unroll") for (int _i = 0; _i < 16; ++_i) A[_i] = max(A[_i], B[15 - _i]); \
    _Pragma("unroll") for (int _st = 8; _st >= 1; _st >>= 1) { _Pragma("unroll") for (int _i = 0; _i < 16; ++_i) if ((_i & _st) == 0) { const int _hi = max(A[_i], A[_i + _st]), _lo = min(A[_i], A[_i + _st]); A[_i] = _hi; A[_i + _st] = _lo; } } } while (0)
#define SORT16(S) { _Pragma("unroll") for (int kk = 2; kk <= 16; kk <<= 1) _Pragma("unroll") for (int jj2 = kk >> 1; jj2 > 0; jj2 >>= 1) _Pragma("unroll") for (int i = 0; i < 16; ++i) { const int l = i ^ jj2; \
        if (l > i) { const int hi = max(S[i], S[l]), lo = min(S[i], S[l]); const bool desc = ((i & kk) == 0); S[i] = desc ? hi : lo; S[l] = desc ? lo : hi; } } }
#define QMERGE(S, CTRL) { int T_[16]; _Pragma("unroll") for (int i_ = 0; i_ < 16; ++i_) T_[i_] = max(S[i_], dpp_i<CTRL>(S[15 - i_])); \
        _Pragma("unroll") for (int st_ = 8; st_ >= 1; st_ >>= 1) { _Pragma("unroll") for (int i_ = 0; i_ < 16; ++i_) if ((i_ & st_) == 0) { const int hi_ = max(T_[i_], T_[i_ + st_]), lo_ = min(T_[i_], T_[i_ + st_]); T_[i_] = hi_; T_[i_ + st_] = lo_; } } \
        _Pragma("unroll") for (int i_ = 0; i_ < 16; ++i_) S[i_] = T_[i_]; }
__device__ __forceinline__ void topk_phase(const Params& p, unsigned char* lds, int bid, int nblk) {
    int tid = threadIdx.x; asm volatile("" : "+v"(tid));
    const int lane = tid & 63, w = __builtin_amdgcn_readfirstlane(tid >> 6), cc = lane & 15, q4 = lane >> 4;
    constexpr int QT_LD = 264;
    bf16_t* qt = (bf16_t*)lds;
    constexpr int ST_LD = 132;
    float* ST = (float*)(lds + 67584);
    constexpr int LL_LD = 33;
    int* LL = (int*)(lds + 135168);
    const bf16_t* Q = (const bf16_t*)(p.ws + WS_PROJ);
    int* TOPI = (int*)(p.ws + WS_TOPI); float* TOPG = (float*)(p.ws + WS_TOPG);
    const int srow = 16 * w + (lane >> 5), scol = 8 * (lane & 31);
    const int t = tid >> 2, kq = tid & 3;
    int code[13];
    {   int cnt = 0;
#pragma unroll
        for (int c = 0; c < 13; ++c) code[c] = -1;
#pragma unroll
        for (int i = 0; i < 16; ++i)
#pragma unroll
            for (int j = 0; j < 16; ++j)
                if ((i + 1) * (j + 1) <= 16) { code[cnt >> 2] = ((cnt & 3) == kq) ? (i * 16 + j) : code[cnt >> 2]; ++cnt; } }
    int cur_h = -1;
    bf16x8 Ak[2][4];
#pragma unroll
    for (int hf = 0; hf < 2; ++hf)
#pragma unroll
        for (int ks = 0; ks < 4; ++ks) Ak[hf][ks] = (bf16x8){0, 0, 0, 0, 0, 0, 0, 0};
    u32x4 qr[8];
    if (bid < 2048) { const int h0 = bid & 7, t0 = (bid >> 3) * 128; const bf16_t* src = Q + (size_t)(t0 + srow) * D + h0 * 256 + scol;
#pragma unroll
        for (int e = 0; e < 8; ++e) qr[e] = *(const u32x4*)(src + (size_t)(2 * e) * D); }
    for (int it = bid; it < 2048; it += nblk) {
        const int h = it & 7, tok0 = (it >> 3) * 128;
        if (h != cur_h) { cur_h = h;
#pragma unroll
            for (int hf = 0; hf < 2; ++hf) { const bf16_t* kb = (const bf16_t*)(p.ws + (hf ? WS_K2 : WS_K1)) + ((size_t)h * 128 + 16 * w + cc) * 128 + 8 * q4;
#pragma unroll
                for (int ks = 0; ks < 4; ++ks) Ak[hf][ks] = *(const bf16x8*)(kb + 32 * ks); } }
#pragma unroll
        for (int e = 0; e < 8; ++e) *(u32x4*)(qt + (srow + 2 * e) * QT_LD + scol) = qr[e];
        if (it + nblk < 2048) { const int h1 = (it + nblk) & 7, t1 = ((it + nblk) >> 3) * 128; const bf16_t* src = Q + (size_t)(t1 + srow) * D + h1 * 256 + scol;
#pragma unroll
            for (int e = 0; e < 8; ++e) qr[e] = *(const u32x4*)(src + (size_t)(2 * e) * D); }
        __syncthreads();
#pragma unroll
        for (int half = 0; half < 2; ++half) {
            if (half == 1) __syncthreads();
#pragma unroll 2
            for (int n = 0; n < 8; ++n) {
                f32x4 acc = {0.f, 0.f, 0.f, 0.f};
#pragma unroll
                for (int ks = 0; ks < 4; ++ks) { const bf16x8 Bf = *(const bf16x8*)(qt + (16 * n + cc) * QT_LD + half * 128 + 32 * ks + 8 * q4); acc = __builtin_amdgcn_mfma_f32_16x16x32_bf16(Ak[half][ks], Bf, acc, 0, 0, 0); }
#pragma unroll
                for (int r = 0; r < 4; ++r) ST[(16 * w + 4 * q4 + r) * ST_LD + 16 * n + cc] = acc[r];
            }
            __syncthreads();
            int S[16];
            {
                int K2[16];
#pragma unroll
                for (int i = 0; i < 16; ++i) { const int k0 = 16 * (i >> 2) + 4 * kq + (i & 3), k1 = k0 + 64;
                    S[i] = (mono(ST[k0 * ST_LD + t]) & ~127) | (127 - k0); K2[i] = (mono(ST[k1 * ST_LD + t]) & ~127) | (127 - k1); }
                SORT16(S) SORT16(K2)
                MERGE16(S, K2);
            }
            QMERGE(S, DPP_XOR1) QMERGE(S, DPP_XOR2)
            if (kq == 0) {
#pragma unroll
                for (int j = 0; j < 16; ++j) LL[t * LL_LD + half * 16 + j] = S[j]; }
        }
        int S[16];
        {
#pragma unroll
            for (int c = 0; c < 13; ++c) { const int cd = max(code[c], 0); const float f1 = unmono(LL[t * LL_LD + (cd >> 4)] & ~127), f2 = unmono(LL[t * LL_LD + 16 + (cd & 15)] & ~127);
                S[c] = (code[c] >= 0) ? ((mono(f1 + f2) & ~255) | (255 - cd)) : (int)0x80000000; }
            S[13] = (int)0x80000000; S[14] = (int)0x80000000; S[15] = (int)0x80000000;
            SORT16(S)
        }
        QMERGE(S, DPP_XOR1) QMERGE(S, DPP_XOR2)
        {
            int my[4];
#pragma unroll
            for (int m = 0; m < 4; ++m) my[m] = (kq == 0) ? S[m] : (kq == 1) ? S[4 + m] : (kq == 2) ? S[8 + m] : S[12 + m];
            const float mx = unmono(S[0] & ~255);
            f32x4 ev; int idx[4]; float part = 0.f;
#pragma unroll
            for (int m = 0; m < 4; ++m) { const int cd = 255 - (my[m] & 255);
                const int e1 = 127 - (LL[t * LL_LD + (cd >> 4)] & 127), e2 = 127 - (LL[t * LL_LD + 16 + (cd & 15)] & 127);
                idx[m] = e1 * 128 + e2; ev[m] = __expf(unmono(my[m] & ~255) - mx); part += ev[m]; }
            part += dpp_f<DPP_XOR1>(part); part += dpp_f<DPP_XOR2>(part);
            const float inv = 1.0f / part;
            *(int4*)(TOPI + (size_t)(tok0 + t) * 128 + h * 16 + 4 * kq) = make_int4(idx[0], idx[1], idx[2], idx[3]);
            *(f32x4*)(TOPG + (size_t)(tok0 + t) * 128 + h * 16 + 4 * kq) = ev * inv;
        }
    }
}

constexpr size_t WS_PART = WS_PROJ;
constexpr size_t WS_DELTA = WS_HN;
__device__ __forceinline__ int pu_dot_ref(u32x4 qv, u32x4 hv) {
    float d = 0.f;
#pragma unroll
    for (int w = 0; w < 4; ++w)
#pragma unroll
        for (int k = 0; k < 4; ++k) d += sb(qv[w], k) * sb(hv[w], k);
    return (int)d;
}
__device__ __forceinline__ void peer_u_phase(const Params& p, int bid, int nblk) {
    int tid = threadIdx.x; asm volatile("" : "+v"(tid));
    const int lane = tid & 63, wave = __builtin_amdgcn_readfirstlane(tid >> 6), g = lane >> 3, jj = lane & 7;
    const int nx = (nblk % 8 == 0) ? 8 : 1, x = bid % nx, j = bid / nx, J = nblk / nx;
    const unsigned char* UB = p.ws + WS_UB;
    const unsigned char* HN8 = p.ws + WS_HN8; const float* HSC = (const float*)(p.ws + WS_HSC);
    const int* TOPI = (const int*)(p.ws + WS_TOPI); bf16_t* PART = (bf16_t*)(p.ws + WS_PART);
    const bool b2 = (jj & 4) != 0, b1 = (jj & 2) != 0, b0 = (jj & 1) != 0;
    const int tstep = J * 8;
#define PU_IDX(I, t_) { const int tt = min((t_), MLAT - 1); I = *(const int2*)(TOPI + (size_t)tt * 128 + 16 * g + 2 * jj); }
#define PU_Q(Q, H, E, I, t_, s_) { const int tt = min((t_), MLAT - 1); \
        _Pragma("unroll") for (int i = 0; i < 16; ++i) { const unsigned ixi = (unsigned)__shfl((i & 1) ? I.y : I.x, (lane & ~7) | (i >> 1)); Q[i] = *(const u32x4*)(UB + (((unsigned)(s_) * 16384u + ixi) * 128u + 16u * (unsigned)jj)); } \
        H##_d = *(const u32x4*)(HN8 + (size_t)tt * D + 128 * (s_) + 16 * jj); H##_s = HSC[tt]; }
#if U_MODE == 1
#define PU_DOT(Qi, H) (__builtin_amdgcn_sdot4((int)Qi[3], (int)H[3], __builtin_amdgcn_sdot4((int)Qi[2], (int)H[2], __builtin_amdgcn_sdot4((int)Qi[1], (int)H[1], __builtin_amdgcn_sdot4((int)Qi[0], (int)H[0], 0, false), false), false), false))
#else
#define PU_DOT(Qi, H) pu_dot_ref(Qi, H)
#endif
#define PU_COMPUTE(Q, H, E, t_, s_) { \
        const u32x4 H = H##_d; \
        int acc[16]; \
        _Pragma("unroll") for (int i = 0; i < 16; ++i) acc[i] = PU_DOT(Q[i], H); \
        int r1[8], r2[4], r3[2]; \
        _Pragma("unroll") for (int k = 0; k < 8; ++k) { const int mine = b2 ? acc[8 + k] : acc[k], send = b2 ? acc[k] : acc[8 + k]; r1[k] = mine + dpp_i<DPP_HMIRROR>(send); }        \
        _Pragma("unroll") for (int k = 0; k < 4; ++k) { const int mine = b1 ? r1[4 + k] : r1[k], send = b1 ? r1[k] : r1[4 + k]; r2[k] = mine + dpp_i<DPP_XOR2>(send); } \
        _Pragma("unroll") for (int k = 0; k < 2; ++k) { const int mine = b0 ? r2[2 + k] : r2[k], send = b0 ? r2[k] : r2[2 + k]; r3[k] = mine + dpp_i<DPP_XOR1>(send); } \
        if ((t_) < MLAT) { const float hs = H##_s; const unsigned o = pk2((float)r3[0] * hs, (float)r3[1] * hs); __builtin_nontemporal_store(o, (unsigned*)(PART + ((size_t)(s_) * MLAT + (t_)) * 128 + 16 * g + 2 * jj)); } }
    for (int s = x; s < 16; s += nx) {
        int t0 = j * 8 + wave, t1 = t0 + tstep;
        int2 IA, IB; u32x4 QA[16], QB[16]; u32x4 HA_d, HB_d; float HA_s, HB_s; int2 EA, EB;
        PU_IDX(IA, t0) PU_IDX(IB, t1)
        __builtin_amdgcn_sched_barrier(0);
        PU_Q(QA, HA, EA, IA, t0, s)
        __builtin_amdgcn_sched_barrier(0);
        for (; t0 < MLAT; t0 += 2 * tstep, t1 += 2 * tstep) {
            PU_IDX(IA, t0 + 2 * tstep)
            __builtin_amdgcn_sched_barrier(0);
            PU_Q(QB, HB, EB, IB, t1, s)
            __builtin_amdgcn_sched_barrier(0);
            PU_COMPUTE(QA, HA, EA, t0, s)
            __builtin_amdgcn_sched_barrier(0);
            PU_IDX(IB, t1 + 2 * tstep)
            __builtin_amdgcn_sched_barrier(0);
            PU_Q(QA, HA, EA, IA, t0 + 2 * tstep, s)
            __builtin_amdgcn_sched_barrier(0);
            PU_COMPUTE(QB, HB, EB, t1, s)
            __builtin_amdgcn_sched_barrier(0);
        }
    }
#undef PU_IDX
#undef PU_Q
#undef PU_DOT
#undef PU_COMPUTE
}
__device__ __forceinline__ void peer_w_phase(const Params& p, int bid, int nblk) {
    int tid = threadIdx.x; asm volatile("" : "+v"(tid));
    const bf16_t* PART = (const bf16_t*)(p.ws + WS_PART); const float* TOPG = (const float*)(p.ws + WS_TOPG); const int* TOPI = (const int*)(p.ws + WS_TOPI); const float* USC = (const float*)(p.ws + WS_USC);
    signed char* WQ8 = (signed char*)(p.ws + WS_WQ8); float* SW = (float*)(p.ws + WS_SW);
    for (size_t e = (size_t)bid * 512 + tid; e < (size_t)MLAT * 128; e += (size_t)nblk * 512) {
        float d = 0.f;
#pragma unroll
        for (int s = 0; s < 16; ++s) d += bf1(__builtin_nontemporal_load(PART + (size_t)s * MLAT * 128 + e));
        const f32x2 sc = *(const f32x2*)(USC + 2 * TOPI[e]);
        const float wv = TOPG[e] * gelu_tanh(d * sc.x) * sc.y;
        float am = fabsf(wv);
#pragma unroll
        for (int o = 1; o < 16; o <<= 1) am = fmaxf(am, __shfl_xor(am, o));
        const float inv = (am > 1e-30f) ? 127.0f / am : 0.f;
        WQ8[e] = (signed char)max(-127, min(127, __float2int_rn(wv * inv)));
        if ((tid & 15) == 0) SW[e >> 4] = am * (1.0f / 127.0f);
    }
}
__device__ __forceinline__ void peer_v_phase(const Params& p, int bid, int nblk) {
    int tid = threadIdx.x; asm volatile("" : "+v"(tid));
    const int lane = tid & 63, wave = __builtin_amdgcn_readfirstlane(tid >> 6), g = lane >> 3, jj = lane & 7;
    const int nx = (nblk % 8 == 0) ? 8 : 1, x = bid % nx, j = bid / nx, J = nblk / nx;
    const unsigned char* VB = p.ws + WS_VB; const unsigned char* WQ8 = p.ws + WS_WQ8; const float* SW = (const float*)(p.ws + WS_SW); const int* TOPI = (const int*)(p.ws + WS_TOPI);
    const float* MOD = (const float*)(p.ws + WS_MOD); bf16_t* DELTA = (bf16_t*)(p.ws + WS_DELTA);
    const bool b5 = (g & 4) != 0, b4 = (g & 2) != 0, b3 = (g & 1) != 0;
    const int tl = 8 * jj + g;
    const int tstep = J * 8;
#define PV_IDX(I, t_) { const int tt = min((t_), MLAT - 1); I = *(const int2*)(TOPI + (size_t)tt * 128 + 16 * g + 2 * jj); }
#define PV_SB __builtin_amdgcn_sched_barrier(0);
#define PV_ROWS(Q, I, h_) { _Pragma("unroll") for (int i = 8 * (h_); i < 8 * (h_) + 8; ++i) { const unsigned ixi = (unsigned)__shfl((i & 1) ? I.y : I.x, (lane & ~7) | (i >> 1)); Q[i] = *(const u32x4*)(VB + (((unsigned)s * 16384u + ixi) * 128u + 16u * (unsigned)jj)); } }
#define PV_AUX(W, SWv, X, t_) { const int tt = min((t_), MLAT - 1); W##_d = *(const unsigned*)(WQ8 + (size_t)tt * 128 + 16 * g + 4 * (jj & 3)); SWv = SW[(size_t)tt * 8 + g]; }
#define PV_ACC(Q, W, acc, a0_) { _Pragma("unroll") for (int a4 = (a0_); a4 < (a0_) + 2; ++a4) _Pragma("unroll") for (int w = 0; w < 4; ++w) { \
            const unsigned x0 = Q[4 * a4][w], x1 = Q[4 * a4 + 1][w], x2 = Q[4 * a4 + 2][w], x3 = Q[4 * a4 + 3][w]; \
            const unsigned l01 = __builtin_amdgcn_perm(x1, x0, 0x05010400u), h01 = __builtin_amdgcn_perm(x1, x0, 0x07030602u), l23 = __builtin_amdgcn_perm(x3, x2, 0x05010400u), h23 = __builtin_amdgcn_perm(x3, x2, 0x07030602u); \
            acc[4 * w + 0] = __builtin_amdgcn_sdot4((int)__builtin_amdgcn_perm(l23, l01, 0x05040100u), (int)W[a4], acc[4 * w + 0], false); \
            acc[4 * w + 1] = __builtin_amdgcn_sdot4((int)__builtin_amdgcn_perm(l23, l01, 0x07060302u), (int)W[a4], acc[4 * w + 1], false); \
            acc[4 * w + 2] = __builtin_amdgcn_sdot4((int)__builtin_amdgcn_perm(h23, h01, 0x05040100u), (int)W[a4], acc[4 * w + 2], false); \
            acc[4 * w + 3] = __builtin_amdgcn_sdot4((int)__builtin_amdgcn_perm(h23, h01, 0x07060302u), (int)W[a4], acc[4 * w + 3], false); } }
#define PV_FIN(acc, SWv, X, t_) { \
        f32x2 a[8]; _Pragma("unroll") for (int k = 0; k < 8; ++k) a[k] = (f32x2){(float)acc[2 * k] * SWv, (float)acc[2 * k + 1] * SWv}; \
        f32x2 r1[4], r2[2], r3; \
        _Pragma("unroll") for (int k = 0; k < 4; ++k) { f32x2 lo = a[k], hi = a[4 + k]; swap32(lo, hi); r1[k] = lo + hi; }        \
        _Pragma("unroll") for (int k = 0; k < 2; ++k) { f32x2 lo = r1[k], hi = r1[2 + k]; swap16(lo, hi); r2[k] = lo + hi; }        \
        { const f32x2 mine = b3 ? r2[1] : r2[0], send = b3 ? r2[0] : r2[1]; r3 = (f32x2){mine.x + dpp_f<DPP_ROR8>(send.x), mine.y + dpp_f<DPP_ROR8>(send.y)}; } \
        const f32x2 gt = ((t_) < SEQ) ? gt0 : gt1; \
        const f32x2 r3t = (f32x2){__shfl(r3.x, tl), __shfl(r3.y, tl)};        \
        const f32x2 dl = gt * r3t; \
        if ((t_) < MLAT) __builtin_nontemporal_store(pk2(dl.x, dl.y), (unsigned*)(DELTA + (size_t)(t_) * D + col)); }
#define PV_STEP(Q, W, SWv, X, IX, IY, t_) { \
        PV_IDX(IY, (t_) + 3 * tstep) PV_SB \
        int acc[16]; _Pragma("unroll") for (int d = 0; d < 16; ++d) acc[d] = 0; \
        { u32x4 Wv; Wv[0] = (unsigned)dpp_i<0x00>((int)W##_d); Wv[1] = (unsigned)dpp_i<0x55>((int)W##_d); Wv[2] = 0u; Wv[3] = 0u; PV_ACC(Q, Wv, acc, 0) } PV_SB \
        PV_ROWS(Q, IX, 0) PV_SB \
        { u32x4 Wv; Wv[0] = 0u; Wv[1] = 0u; Wv[2] = (unsigned)dpp_i<0xAA>((int)W##_d); Wv[3] = (unsigned)dpp_i<0xFF>((int)W##_d); PV_ACC(Q, Wv, acc, 2) } \
        PV_FIN(acc, SWv, X, t_) PV_SB \
        PV_AUX(W, SWv, X, (t_) + 2 * tstep) PV_ROWS(Q, IX, 1) PV_SB }
    for (int s = x; s < 16; s += nx) {
        const int col = 128 * s + 2 * lane;
        const f32x2 gt0 = *(const f32x2*)(MOD + 5 * 2048 + col), gt1 = *(const f32x2*)(MOD + 12288 + 5 * 2048 + col);
        int t0 = j * 8 + wave, t1 = t0 + tstep;
        int2 IA, IB; u32x4 QA[16], QB[16]; unsigned WA_d, WB_d; float SA, SB;
        PV_IDX(IA, t0) PV_IDX(IB, t1) PV_SB
        PV_ROWS(QA, IA, 0) PV_AUX(WA, SA, XA, t0) PV_ROWS(QA, IA, 1) PV_SB
        PV_IDX(IA, t0 + 2 * tstep) PV_SB
        PV_ROWS(QB, IB, 0) PV_AUX(WB, SB, XB, t1) PV_ROWS(QB, IB, 1) PV_SB
        for (; t0 < MLAT; t0 += 2 * tstep, t1 += 2 * tstep) {
            PV_STEP(QA, WA, SA, XA, IA, IB, t0)
            PV_STEP(QB, WB, SB, XB, IB, IA, t1)
        }
    }
#undef PV_SB
#undef PV_ROWS
#undef PV_AUX
#undef PV_FIN
#undef PV_STEP
#undef PV_IDX
#undef PV_ACC
#undef PV_COMPUTE
}
__device__ __forceinline__ void final_norm_phase(const Params& p, int bid, int nblk) {
    int tid = threadIdx.x; asm volatile("" : "+v"(tid));
    const int lane = tid & 63, wave = __builtin_amdgcn_readfirstlane(tid >> 6);
    const bf16_t* XL = (const bf16_t*)(p.ws + WS_YL); const bf16_t* DELTA = (const bf16_t*)(p.ws + WS_DELTA);
    f32x4 fgv[8];
#pragma unroll
    for (int jx = 0; jx < 8; ++jx) fgv[jx] = *((const f32x4*)p.fg + lane + 64 * jx);
    for (int row = bid * 8 + wave; row < MLAT; row += nblk * 8) {
        u32x2 xa[8], da[8];
#pragma unroll
        for (int jx = 0; jx < 8; ++jx) { xa[jx] = __builtin_nontemporal_load((const u32x2*)(XL + (size_t)row * D) + lane + 64 * jx); da[jx] = __builtin_nontemporal_load((const u32x2*)(DELTA + (size_t)row * D) + lane + 64 * jx); }
        f32x4 v[8]; float ss = 0.f;
#pragma unroll
        for (int jx = 0; jx < 8; ++jx) { v[jx] = (f32x4){bflo(xa[jx].x) + bflo(da[jx].x), bfhi(xa[jx].x) + bfhi(da[jx].x), bflo(xa[jx].y) + bflo(da[jx].y), bfhi(xa[jx].y) + bfhi(da[jx].y)};
            ss += (v[jx][0] * v[jx][0] + v[jx][1] * v[jx][1]) + (v[jx][2] * v[jx][2] + v[jx][3] * v[jx][3]); }
        const float r2 = rsqrtf(wave_sum(ss) * (1.0f / 2048.0f) + EPS);
        f32x4* xr = (f32x4*)(p.out + (size_t)row * D);
#pragma unroll
        for (int jx = 0; jx < 8; ++jx) __builtin_nontemporal_store(v[jx] * r2 * fgv[jx], xr + lane + 64 * jx);
    }
}

#define XB_TMO      128
#define XB_XCNT(j)  (256  + 64 * (j))
#define XB_XSUB(j)  (1280 + 64 * (j))
#define XB_XGEN(j)  (2304 + 64 * (j))
#define XB_TOP      3328
#define XB_TOPGEN   3392
#define XCD_BAR_WORDS 3456
#define XB_SPIN_CAP (1u << 20)
__device__ __forceinline__ unsigned xb_ld(unsigned* p)              { return __hip_atomic_load(p, __ATOMIC_RELAXED, __HIP_MEMORY_SCOPE_AGENT); }
__device__ __forceinline__ unsigned xb_add(unsigned* p, unsigned v) { return __hip_atomic_fetch_add(p, v, __ATOMIC_RELAXED, __HIP_MEMORY_SCOPE_AGENT); }
__device__ __forceinline__ unsigned xb_xcc_id() { return (unsigned)__builtin_amdgcn_s_getreg((3 << 11) | 20) & 0xFu; }
#define XB_SPIN(cond, bar) do { unsigned _sp = 0; while (cond) { __builtin_amdgcn_s_sleep(1); \
    if ((++_sp & 255u) == 0u) { if (xb_ld(&(bar)[XB_TMO])) break; if (_sp > XB_SPIN_CAP) { atomicAdd(&(bar)[XB_TMO], 1u); break; } } } } while (0)
struct XcdBarrier { unsigned* bar; unsigned x; volatile LAS unsigned* st; };
__device__ __forceinline__ XcdBarrier xcd_barrier_post(unsigned* bar, volatile LAS unsigned* st) {
    XcdBarrier b; b.bar = bar; b.x = xb_xcc_id(); b.st = st;
    if (threadIdx.x == 0) (void)xb_add(&bar[XB_XCNT(b.x)], 1u);
    return b;
}
__device__ __forceinline__ void xcd_barrier_complete(unsigned* bar, unsigned x, unsigned& nloc, unsigned& nx) {
    const unsigned G = gridDim.x * gridDim.y * gridDim.z;
    unsigned sum, cnt, mine, sp = 0u;
    for (;;) {
        sum = 0u; cnt = 0u; mine = 0u;
#pragma unroll
        for (unsigned j = 0; j < 16; ++j) { const unsigned c = xb_ld(&bar[XB_XCNT(j)]); sum += c; cnt += (c > 0u) ? 1u : 0u; mine = (j == x) ? c : mine; }
        if (sum == G) break;
        __builtin_amdgcn_s_sleep(1);
        if ((++sp & 255u) == 0u) { if (xb_ld(&bar[XB_TMO])) break; if (sp > XB_SPIN_CAP) { atomicAdd(&bar[XB_TMO], 1u); break; } }
    }
    nloc = mine > 0u ? mine : 1u; nx = cnt > 0u ? cnt : 1u;
}
__device__ __forceinline__ void xcd_barrier(const XcdBarrier& b) {
    asm volatile("s_waitcnt vmcnt(0)" ::: "memory");
    __syncthreads();
    if (threadIdx.x == 0) {
        unsigned* bar = b.bar;
        __builtin_amdgcn_s_waitcnt(0);
        unsigned nloc = b.st[0], nx = b.st[1];
        if (nloc == 0u) { xcd_barrier_complete(bar, b.x, nloc, nx); b.st[0] = nloc; b.st[1] = nx; }
        const unsigned old = xb_add(&bar[XB_XSUB(b.x)], 1u);
        const unsigned gen = old / nloc;
        if (old + 1u == (gen + 1u) * nloc) {
            __builtin_amdgcn_fence(__ATOMIC_RELEASE, "agent");
            asm volatile("s_waitcnt vmcnt(0)" ::: "memory");
            const unsigned og = xb_add(&bar[XB_TOP], 1u);
            const unsigned tg = og / nx;
            if (og + 1u == (tg + 1u) * nx) xb_add(&bar[XB_TOPGEN], 1u);
            else XB_SPIN(xb_ld(&bar[XB_TOPGEN]) == tg, bar);
            __builtin_amdgcn_fence(__ATOMIC_ACQUIRE, "agent");
            xb_add(&bar[XB_XGEN(b.x)], 1u);
            asm volatile("s_waitcnt vmcnt(0)" ::: "memory");
        } else {
            XB_SPIN(xb_ld(&bar[XB_XGEN(b.x)]) == gen, bar);
            __builtin_amdgcn_fence(__ATOMIC_ACQUIRE, "agent");
            asm volatile("s_waitcnt vmcnt(0)" ::: "memory");
        }
    }
    __syncthreads();
}

__global__ void __launch_bounds__(512, 2) k_main(Params p, int ph_lo, int ph_hi) {
    extern __shared__ __attribute__((aligned(16))) unsigned char lds[];
    const int bid = blockIdx.x, nblk = gridDim.x;
#if FUSED
    cg::grid_group grid = cg::this_grid();
    volatile LAS unsigned* bst = (volatile LAS unsigned*)((LAS unsigned char*)lds + (LDS_BYTES - 64));
    if (threadIdx.x < 2) bst[threadIdx.x] = 0u;
    __syncthreads();
    const XcdBarrier xbar = xcd_barrier_post((unsigned*)(p.ws + WS_CTL), bst);
#define SYNC_AFTER(k) if ((k) + 1 < ph_hi) { if (ph_lo < 0) grid.sync(); else xcd_barrier(xbar); }
#else
#define SYNC_AFTER(k)
#endif
#define IN(k) (ph_lo <= (k) && (k) < ph_hi)
    if (IN(0)) { phase0(p, lds, bid, nblk); SYNC_AFTER(0) }
    if (IN(1)) { phase_norm1(p, lds, bid, nblk); SYNC_AFTER(1) }
#if !G1_I8
    if (IN(2)) { pg8::Gemm g{(const bf16_t*)(p.ws + WS_HN), (const bf16_t*)(p.ws + WS_WIN), MALL, INW, D, 1, 0, 0}; pg8::StaticOrder S; S.init(MALL, INW, nblk, bid);
                 pg8::EpiBf16 E{(bf16_t*)(p.ws + WS_PROJ), INW}; pg8::gemm_phase<pg8::EpiBf16>((LAS unsigned char*)lds, g, S, E); SYNC_AFTER(2) }
#else
    if (IN(2)) { pg8::Gemm g{(const bf16_t*)(p.ws + WS_HN), (const bf16_t*)(p.ws + WS_WIN3), MALL, INW, D / 2, 64, 2, (size_t)4096 * 2048}; pg8::StaticOrder S; S.init(CTX_SPLIT ? MLAT : MALL, INW, nblk, bid);
                 pg8::EpiI8BiasBf16 E{(bf16_t*)(p.ws + WS_PROJ), INW, (const float*)(p.ws + WS_RS1), (const float*)(p.ws + WS_CS1), (const float*)(p.ws + WS_BIAS1)}; pg8::gemm_phase<pg8::EpiI8BiasBf16>((LAS unsigned char*)lds, g, S, E); SYNC_AFTER(2) }
#endif
    if (IN(3)) {
#if G1_I8 && CTX_SPLIT
        if (bid < 8) { pg8::Gemm g{(const bf16_t*)(p.ws + WS_HN), (const bf16_t*)(p.ws + WS_WIN3), MALL, INW, D / 2, 64, 2, (size_t)4096 * 2048}; pg8::StaticOrder S; S.init(MALL, INW, nblk, bid); S.fpm = 128 + (bid >> 2); S.fpn = bid & 3;
            pg8::EpiI8BiasBf16 E{(bf16_t*)(p.ws + WS_PROJ), INW, (const float*)(p.ws + WS_RS1), (const float*)(p.ws + WS_CS1), (const float*)(p.ws + WS_BIAS1)}; pg8::gemm_phase<pg8::EpiI8BiasBf16>((LAS unsigned char*)lds, g, S, E);
            asm volatile("s_waitcnt vmcnt(0)" ::: "memory");
            __syncthreads();
            if (threadIdx.x == 0) { __builtin_amdgcn_fence(__ATOMIC_RELEASE, "agent"); asm volatile("s_waitcnt vmcnt(0)" ::: "memory"); (void)xb_add((unsigned*)(p.ws + WS_CTL + CTXDONE_OFS), 1u); }
            __syncthreads(); }
#endif
        lru_phase<false>(p, lds, bid, nblk); SYNC_AFTER(3) }
    if (IN(4)) { carry_phase(p, bid, nblk); sgu_phase(p, lds, bid, nblk); SYNC_AFTER(4) }
    if (IN(5)) { lru_phase<true>(p, lds, bid, nblk); SYNC_AFTER(5) }
    if (IN(6)) { pg8::Gemm g{(const bf16_t*)(p.ws + WS_HN), (const bf16_t*)(p.ws + WS_WOUT), MLAT, D, D, 1, 0, 0}; pg8::StaticOrder S; S.init(MLAT, D, nblk, bid);
                 pg8::EpiXlatBf16 E{(bf16_t*)(p.ws + WS_YL), D, (const float*)(p.ws + WS_MOD) + 2 * 2048, 12288, SEQ, p.x}; pg8::gemm_phase<pg8::EpiXlatBf16>((LAS unsigned char*)lds, g, S, E); SYNC_AFTER(6) }
    if (IN(7)) { phase_norm2(p, bid, nblk); SYNC_AFTER(7) }
#if G3_I8
    if (IN(8)) { pg8::Gemm g{(const bf16_t*)(p.ws + WS_HN8), (const bf16_t*)(p.ws + WS_WQ), MLAT, D, D / 2, 1, 0, 0}; pg8::StaticOrder S; S.init(MLAT, D, nblk, bid);
                 pg8::EpiI8Bf16 E{(bf16_t*)(p.ws + WS_PROJ), D, (const float*)(p.ws + WS_HSC), (const unsigned*)(p.ws + WS_COLMAX_Q)}; pg8::gemm_phase<pg8::EpiI8Bf16>((LAS unsigned char*)lds, g, S, E); SYNC_AFTER(8) }
#else
    if (IN(8)) { pg8::Gemm g{(const bf16_t*)(p.ws + WS_HN), (const bf16_t*)(p.ws + WS_WQ), MLAT, D, D, 1, 0, 0}; pg8::StaticOrder S; S.init(MLAT, D, nblk, bid);
                 pg8::EpiBf16 E{(bf16_t*)(p.ws + WS_PROJ), D}; pg8::gemm_phase<pg8::EpiBf16>((LAS unsigned char*)lds, g, S, E); SYNC_AFTER(8) }
#endif
    if (IN(9)) { topk_phase(p, lds, bid, nblk); SYNC_AFTER(9) }
    if (IN(10)) { peer_u_phase(p, bid, nblk); SYNC_AFTER(10) }
    if (IN(11)) { peer_w_phase(p, bid, nblk); SYNC_AFTER(11) }
    if (IN(12)) { peer_v_phase(p, bid, nblk); SYNC_AFTER(12) }
    if (IN(13)) { final_norm_phase(p, bid, nblk); }
#undef IN
}

extern "C" void kernel_launch(void* const* d_in, const int* in_sizes, int n_in, void* d_out, int out_size, void* d_ws, size_t ws_size, hipStream_t stream) {
    static int grid = 0;
    if (grid == 0) {
        if (n_in != 25 || out_size != MLAT * D || ws_size < WS_END) { fprintf(stderr, "kernel_launch: unexpected shapes (n_in %d out %d ws %zu)\n", n_in, out_size, ws_size); grid = -1; return; }
        int dev = 0, cus = 0, per_cu = 0;
        hipGetDevice(&dev); hipDeviceGetAttribute(&cus, hipDeviceAttributeMultiprocessorCount, dev);
        if (hipFuncSetAttribute((const void*)k_main, hipFuncAttributeMaxDynamicSharedMemorySize, LDS_BYTES) != hipSuccess) { fprintf(stderr, "kernel_launch: hipFuncSetAttribute failed\n"); grid = -1; return; }
        hipOccupancyMaxActiveBlocksPerMultiprocessor(&per_cu, (const void*)k_main, 512, LDS_BYTES);
        if (per_cu < 1) { fprintf(stderr, "kernel_launch: occupancy query says %d blocks per CU\n", per_cu); per_cu = 1; }
        (void)hipGetLastError();
        grid = cus * 1;
    }
    if (grid < 0) return;
    Params p{};
    const float** pp = (const float**)&p;
    for (int i = 0; i < 25; ++i) pp[i] = (const float*)d_in[i];
    p.out = (float*)d_out; p.ws = (unsigned char*)d_ws;
#if FUSED
    hipMemsetAsync((char*)d_ws + WS_CTL, 0, 131072, stream);
    int lo = 0, hi = NPHASES;
    void* args[] = {&p, &lo, &hi};
    hipError_t e = hipLaunchCooperativeKernel((const void*)k_main, dim3(grid), dim3(512), args, LDS_BYTES, stream);
    if (e != hipSuccess) fprintf(stderr, "cooperative launch failed: %s (grid %d)\n", hipGetErrorString(e), grid);
#else
    for (int ph = 0; ph < NPHASES; ++ph) hipLaunchKernelGGL(k_main, dim3(grid), dim3(512), LDS_BYTES, stream, p, ph, ph + 1);
#endif
}
```

```cpp
#include <hip/hip_runtime.h>
#include <hip/hip_cooperative_groups.h>
#include <cstdio>
#include <cstdint>

#ifndef G3_I8
#define G3_I8 1
#endif
#ifndef G1_I8
#define G1_I8 1
#endif
#ifndef U_MODE
#define U_MODE 1
#endif
#ifndef V_MODE
#define V_MODE 1
#endif
#ifndef FUSED
#define FUSED 1
#endif
#ifndef CTX_SPLIT
#define CTX_SPLIT 1
#endif
#define CTXDONE_OFS 45568

namespace cg = cooperative_groups;

typedef unsigned short bf16_t;
typedef short bf16x8 __attribute__((ext_vector_type(8)));
typedef float f32x4 __attribute__((ext_vector_type(4)));
typedef float f32x2 __attribute__((ext_vector_type(2)));
typedef unsigned u32x4 __attribute__((ext_vector_type(4)));
typedef unsigned u32x2 __attribute__((ext_vector_type(2)));
typedef int i32x4 __attribute__((ext_vector_type(4)));
typedef __bf16 bf16x2_t __attribute__((ext_vector_type(2)));
#define LAS __attribute__((address_space(3)))

constexpr int D = 2048, SEQ = 16384, CTXL = 256;
constexpr int MLAT = 2 * SEQ, MCTX = 2 * CTXL, MALL = MLAT + MCTX;
constexpr int INW = 4096;
constexpr int NSEG = 130;
constexpr float EPS = 1e-6f;

constexpr size_t MiB = 1u << 20;
constexpr size_t WS_CTL = 0;
constexpr size_t WS_MOD = 1 * MiB;
constexpr size_t WS_SP = 1 * MiB + 512 * 1024;
constexpr size_t WS_USC = 2 * MiB;
constexpr size_t WS_WIN = 4 * MiB;
constexpr size_t WS_WOUT = 20 * MiB;
constexpr size_t WS_WQ = 28 * MiB;
constexpr size_t WS_SGUW = 36 * MiB;
constexpr size_t WS_K1 = 36 * MiB + 256 * 1024;
constexpr size_t WS_K2 = 36 * MiB + 512 * 1024;
constexpr size_t WS_LRUW = 37 * MiB;
constexpr size_t WS_SUMS = 38 * MiB;
constexpr size_t WS_UB = 44 * MiB;
constexpr size_t WS_VB = 108 * MiB;
constexpr size_t WS_HN = 172 * MiB;
constexpr size_t WS_PROJ = 302 * MiB;
constexpr size_t WS_TOPI = 562 * MiB;
constexpr size_t WS_TOPG = 578 * MiB;
constexpr size_t WS_COLMAX_IN = 65536;
constexpr size_t WS_COLMAX_Q = 65536 + 16384;
constexpr size_t WS_RS1 = 600 * MiB + 262144;
constexpr size_t WS_HSC = 600 * MiB;
constexpr size_t WS_SW = 601 * MiB;
constexpr size_t WS_WQ8 = 602 * MiB;
constexpr size_t WS_HN8 = 608 * MiB;
constexpr size_t WS_WIN3 = 672 * MiB;
constexpr size_t WS_CS1 = 600 * MiB + 524288;
constexpr size_t WS_BIAS1 = 600 * MiB + 589824;
constexpr size_t WS_YL = 696 * MiB;
constexpr size_t WS_END = 824 * MiB;

constexpr int LDS_BYTES = 159744;
constexpr int NPHASES = 14;

struct Params {
    const float *x, *c, *ctx, *c_ctx, *w_mod, *b_mod, *g1, *g2, *w_in, *conv_w, *conv_b, *lru_wa, *lru_ba, *lru_wx, *lru_bx, *lru_lam,
        *sgu_w, *sgu_b, *w_out, *wq, *k1, *k2, *pu, *pv, *fg;
    float* out;
    unsigned char* ws;
};

__device__ __forceinline__ unsigned f2bf(float f) { unsigned u = __builtin_bit_cast(unsigned, f); return (u + 0x7fffu + ((u >> 16) & 1u)) >> 16; }
__device__ __forceinline__ unsigned pk2(float lo, float hi) { return f2bf(lo) | (f2bf(hi) << 16); }
__device__ __forceinline__ float bflo(unsigned u) { return __builtin_bit_cast(float, u << 16); }
__device__ __forceinline__ float bfhi(unsigned u) { return __builtin_bit_cast(float, u & 0xffff0000u); }
__device__ __forceinline__ float bf1(bf16_t u) { return __builtin_bit_cast(float, (unsigned)u << 16); }
__device__ __forceinline__ float sigmoidf_(float x) { return __builtin_amdgcn_rcpf(1.0f + __expf(-x)); }
__device__ __forceinline__ float gelu_tanh(float x) {
    const float t = x * x; const float q = x * fmaf(t, -0.1029432395800235f, -2.302208198144325f);
    return x * __builtin_amdgcn_rcpf(1.0f + __builtin_amdgcn_exp2f(q));
}
template <int CTRL> __device__ __forceinline__ int dpp_i(int v) { return __builtin_amdgcn_update_dpp(0, v, CTRL, 0xf, 0xf, true); }
template <int CTRL> __device__ __forceinline__ float dpp_f(float v) { return __builtin_bit_cast(float, __builtin_amdgcn_update_dpp(0, __builtin_bit_cast(int, v), CTRL, 0xf, 0xf, true)); }
constexpr int DPP_XOR1 = 0xB1, DPP_XOR2 = 0x4E, DPP_HMIRROR = 0x141, DPP_MIRROR = 0x140, DPP_ROR8 = 0x128;
__device__ __forceinline__ void swap16(float& a, float& b) { asm("s_nop 1\n\tv_permlane16_swap_b32 %0, %1" : "+v"(a), "+v"(b)); }
__device__ __forceinline__ void swap32(float& a, float& b) { asm("s_nop 1\n\tv_permlane32_swap_b32 %0, %1" : "+v"(a), "+v"(b)); }
__device__ __forceinline__ void swap16(f32x2& a, f32x2& b) { float ax = a.x, ay = a.y, bx = b.x, by = b.y; swap16(ax, bx); swap16(ay, by); a = (f32x2){ax, ay}; b = (f32x2){bx, by}; }
__device__ __forceinline__ void swap32(f32x2& a, f32x2& b) { float ax = a.x, ay = a.y, bx = b.x, by = b.y; swap32(ax, bx); swap32(ay, by); a = (f32x2){ax, ay}; b = (f32x2){bx, by}; }
__device__ __forceinline__ float wave_sum(float v) {
    v += dpp_f<DPP_XOR1>(v); v += dpp_f<DPP_XOR2>(v); v += dpp_f<DPP_HMIRROR>(v); v += dpp_f<DPP_MIRROR>(v);
    { float a = v, b = v; swap16(a, b); v = a + b; }
    { float a = v, b = v; swap32(a, b); v = a + b; }
    return v;
}
__device__ __forceinline__ unsigned q8pack(f32x4 x) {
    const int a = max(-127, min(127, __float2int_rn(x[0]))), b = max(-127, min(127, __float2int_rn(x[1]))), c = max(-127, min(127, __float2int_rn(x[2]))), d = max(-127, min(127, __float2int_rn(x[3])));
    return (unsigned)(a & 255) | ((unsigned)(b & 255) << 8) | ((unsigned)(c & 255) << 16) | ((unsigned)(d & 255) << 24);
}
__device__ __forceinline__ float sb(unsigned w, int k) { return (float)(signed char)((w >> (8 * k)) & 255u); }
__device__ __forceinline__ int mono(float v) { int b = __builtin_bit_cast(int, v); return b ^ ((b >> 31) & 0x7fffffff); }
__device__ __forceinline__ float unmono(int m) { int b = m ^ ((m >> 31) & 0x7fffffff); return __builtin_bit_cast(float, b); }

namespace pg8 {
constexpr int BM = 256, BK = 64, HALF = 128, HTB = HALF * BK * 2, STAGE_BYTES = 8 * HTB, NXCD = 8, WGM = 8;
__host__ __device__ __forceinline__ int lds_byte(int r, int c) { const int st = (r >> 4) * 2 + (c >> 5), rr = r & 15, cc = c & 31, ob = rr * 64 + cc * 2; return st * 1024 + (ob ^ (((ob >> 9) & 1) << 5)); }
__host__ __device__ __forceinline__ void stage_rc(int b, int& R, int& C) { const int st = b / 1024, sb = b % 1024, swz = sb ^ (((sb >> 9) & 1) << 5); R = (st >> 1) * 16 + swz / 64; C = (st & 1) * 32 + (swz % 64) / 2; }
__host__ __device__ __forceinline__ int perm32(int rho) { const int n = rho >> 4, i = rho & 15; return 8 * (i >> 2) + 4 * n + (i & 3); }
struct Unit { int pm, pn; };
struct Gemm { const bf16_t* A; const bf16_t* Bt; int M, N, K; int bt_tiles; int bt_max; size_t bt_stride;
    __device__ __forceinline__ size_t bsel(int pm) const { return bt_stride ? (size_t)((pm / bt_tiles) < bt_max ? (pm / bt_tiles) : bt_max) * bt_stride : (size_t)0; } };
struct StaticOrder {
    int nM, nN, nwg, G, c; int fpm = -1, fpn = 0;
    __host__ __device__ void init(int M, int N, int G_, int c_) { nM = M / BM; nN = N / BM; nwg = nM * nN; G = G_; c = c_; }
    __host__ __device__ bool next(int i, Unit& u) const {
        if (fpm >= 0) { if (i > 0) return false; u.pm = fpm; u.pn = fpn; return true; }
        const long L = (long)i * G + c; if (L >= nwg) return false;
        int wgid = (int)L; { const int q = nwg / NXCD, r = nwg % NXCD, xcd = wgid % NXCD, off = wgid / NXCD; wgid = (xcd < r ? xcd * (q + 1) : r * (q + 1) + (xcd - r) * q) + off; }
        const int nig = WGM * nN, gid = wgid / nig, fm = gid * WGM, gsz = (nM - fm) < WGM ? (nM - fm) : WGM;
        u.pm = fm + ((wgid % nig) % gsz); u.pn = (wgid % nig) / gsz; return true;
    }
};
__device__ __forceinline__ unsigned cvt_pk_bf16(float lo, float hi) { unsigned r; asm volatile("v_cvt_pk_bf16_f32 %0, %1, %2" : "=v"(r) : "v"(lo), "v"(hi)); return r; }

__device__ __forceinline__ u32x4 epi_tr(u32x4 w, int src4) { u32x4 r; r.x = (unsigned)__builtin_amdgcn_ds_bpermute(src4, (int)w.x); r.y = (unsigned)__builtin_amdgcn_ds_bpermute(src4, (int)w.y); r.z = (unsigned)__builtin_amdgcn_ds_bpermute(src4, (int)w.z); r.w = (unsigned)__builtin_amdgcn_ds_bpermute(src4, (int)w.w); return r; }
#define EPI_TR_SETUP const int lane_ = fq * 16 + fr, fr2 = lane_ >> 2, fq2 = lane_ & 3, src4 = 4 * (fq2 * 16 + fr2); const long trofs = (long)(fr2 - fr) * ldc + 8 * (fq2 - fq);
struct EpiI8Bf16 {
    static constexpr bool PERM = true, I8 = true; typedef i32x4 acc_t;
    bf16_t* O; int ldc; const float* rs; const unsigned* cmax;
    __device__ __forceinline__ void operator()(const i32x4 (&acc)[2][2][4][2], const Unit& u, int wr, int wc, int fr, int fq) const {
        const int row0 = u.pm * BM + wr * 64 + fr; const int col0 = u.pn * BM + wc * 32 + 8 * fq;
        EPI_TR_SETUP
        f32x4 cs[2][2];
#pragma unroll
        for (int bj = 0; bj < 2; ++bj)
#pragma unroll
            for (int n = 0; n < 2; ++n) { const u32x4 cm = *(const u32x4*)(cmax + col0 + bj * HALF + 4 * n);
                cs[bj][n] = (f32x4){__builtin_bit_cast(float, cm[0]), __builtin_bit_cast(float, cm[1]), __builtin_bit_cast(float, cm[2]), __builtin_bit_cast(float, cm[3])} * (1.0f / 127.0f); }
#pragma unroll
        for (int ai = 0; ai < 2; ++ai)
#pragma unroll
            for (int m = 0; m < 4; ++m) { const int row = row0 + ai * HALF + m * 16; const float rsv = rs[row]; bf16_t* rowp = O + (size_t)row * ldc + col0;
#pragma unroll
                for (int bj = 0; bj < 2; ++bj) { const i32x4 a0 = acc[ai][bj][m][0], a1 = acc[ai][bj][m][1];
                    const f32x4 v0 = (f32x4){(float)a0[0], (float)a0[1], (float)a0[2], (float)a0[3]} * cs[bj][0] * rsv, v1 = (f32x4){(float)a1[0], (float)a1[1], (float)a1[2], (float)a1[3]} * cs[bj][1] * rsv;
                    u32x4 w; w.x = cvt_pk_bf16(v0[0], v0[1]); w.y = cvt_pk_bf16(v0[2], v0[3]); w.z = cvt_pk_bf16(v1[0], v1[1]); w.w = cvt_pk_bf16(v1[2], v1[3]);
                    *(u32x4*)(rowp + trofs + bj * HALF) = epi_tr(w, src4); } }
    }
};
struct EpiI8BiasBf16 {
    static constexpr bool PERM = true, I8 = true; typedef i32x4 acc_t;
    bf16_t* O; int ldc; const float* rs; const float* cs; const float* bias;
    __device__ __forceinline__ void operator()(const i32x4 (&acc)[2][2][4][2], const Unit& u, int wr, int wc, int fr, int fq) const {
        const int row0 = u.pm * BM + wr * 64 + fr; const int col0 = u.pn * BM + wc * 32 + 8 * fq; const int v = (u.pm / 64) < 2 ? (u.pm / 64) : 2;
        EPI_TR_SETUP
        f32x4 csv[2][2], bv[2][2];
#pragma unroll
        for (int bj = 0; bj < 2; ++bj)
#pragma unroll
            for (int n = 0; n < 2; ++n) { csv[bj][n] = *(const f32x4*)(cs + v * 4096 + col0 + bj * HALF + 4 * n); bv[bj][n] = *(const f32x4*)(bias + v * 4096 + col0 + bj * HALF + 4 * n); }
#pragma unroll
        for (int ai = 0; ai < 2; ++ai)
#pragma unroll
            for (int m = 0; m < 4; ++m) { const int row = row0 + ai * HALF + m * 16; const float rsv = rs[row]; bf16_t* rowp = O + (size_t)row * ldc + col0;
#pragma unroll
                for (int bj = 0; bj < 2; ++bj) { const i32x4 a0 = acc[ai][bj][m][0], a1 = acc[ai][bj][m][1];
                    const f32x4 v0 = (f32x4){(float)a0[0], (float)a0[1], (float)a0[2], (float)a0[3]} * csv[bj][0] * rsv + bv[bj][0], v1 = (f32x4){(float)a1[0], (float)a1[1], (float)a1[2], (float)a1[3]} * csv[bj][1] * rsv + bv[bj][1];
                    u32x4 w; w.x = cvt_pk_bf16(v0[0], v0[1]); w.y = cvt_pk_bf16(v0[2], v0[3]); w.z = cvt_pk_bf16(v1[0], v1[1]); w.w = cvt_pk_bf16(v1[2], v1[3]);
                    *(u32x4*)(rowp + trofs + bj * HALF) = epi_tr(w, src4); } }
    }
};
struct EpiBf16 {
    static constexpr bool PERM = true, I8 = false; typedef f32x4 acc_t;
    bf16_t* O; int ldc;
    __device__ __forceinline__ void operator()(const f32x4 (&acc)[2][2][4][2], const Unit& u, int wr, int wc, int fr, int fq) const {
        const int row0 = u.pm * BM + wr * 64 + fr; const int col0 = u.pn * BM + wc * 32 + 8 * fq;
#pragma unroll
        for (int ai = 0; ai < 2; ++ai)
#pragma unroll
            for (int m = 0; m < 4; ++m) { bf16_t* rowp = O + (size_t)(row0 + ai * HALF + m * 16) * ldc + col0;
#pragma unroll
                for (int bj = 0; bj < 2; ++bj) { const f32x4 v0 = acc[ai][bj][m][0], v1 = acc[ai][bj][m][1];
                    u32x4 w; w.x = cvt_pk_bf16(v0[0], v0[1]); w.y = cvt_pk_bf16(v0[2], v0[3]); w.z = cvt_pk_bf16(v1[0], v1[1]); w.w = cvt_pk_bf16(v1[2], v1[3]);
                    *(u32x4*)(rowp + bj * HALF) = w; } }
    }
};
struct EpiGateBf16 {
    static constexpr bool PERM = true, I8 = false; typedef f32x4 acc_t;
    bf16_t* O; int ldc; const float* gate; int gate_stride; int rows_per_batch;
    __device__ __forceinline__ void operator()(const f32x4 (&acc)[2][2][4][2], const Unit& u, int wr, int wc, int fr, int fq) const {
        const int row0 = u.pm * BM + wr * 64 + fr; const int col0 = u.pn * BM + wc * 32 + 8 * fq;
        EPI_TR_SETUP
        const int bsel = (u.pm * BM) / rows_per_batch;
        f32x4 gv[2][2];
#pragma unroll
        for (int bj = 0; bj < 2; ++bj)
#pragma unroll
            for (int n = 0; n < 2; ++n) gv[bj][n] = *(const f32x4*)(gate + (size_t)bsel * gate_stride + col0 + bj * HALF + 4 * n);
#pragma unroll
        for (int ai = 0; ai < 2; ++ai)
#pragma unroll
            for (int m = 0; m < 4; ++m) { bf16_t* rowp = O + (size_t)(row0 + ai * HALF + m * 16) * ldc + col0;
#pragma unroll
                for (int bj = 0; bj < 2; ++bj) { const f32x4 v0 = acc[ai][bj][m][0] * gv[bj][0], v1 = acc[ai][bj][m][1] * gv[bj][1];
                    u32x4 w; w.x = cvt_pk_bf16(v0[0], v0[1]); w.y = cvt_pk_bf16(v0[2], v0[3]); w.z = cvt_pk_bf16(v1[0], v1[1]); w.w = cvt_pk_bf16(v1[2], v1[3]);
                    *(u32x4*)(rowp + trofs + bj * HALF) = epi_tr(w, src4); } }
    }
};
struct EpiXlatBf16 {
    static constexpr bool PERM = true, I8 = false; typedef f32x4 acc_t;
    bf16_t* O; int ldc; const float* gate; int gate_stride; int rows_per_batch; const float* base;
    __device__ __forceinline__ void operator()(const f32x4 (&acc)[2][2][4][2], const Unit& u, int wr, int wc, int fr, int fq) const {
        const int row0 = u.pm * BM + wr * 64 + fr; const int col0 = u.pn * BM + wc * 32 + 8 * fq;
        EPI_TR_SETUP
        const int bsel = (u.pm * BM) / rows_per_batch;
        f32x4 gv[2][2];
#pragma unroll
        for (int bj = 0; bj < 2; ++bj)
#pragma unroll
            for (int n = 0; n < 2; ++n) gv[bj][n] = *(const f32x4*)(gate + (size_t)bsel * gate_stride + col0 + bj * HALF + 4 * n);
#pragma unroll
        for (int ai = 0; ai < 2; ++ai)
#pragma unroll
            for (int m = 0; m < 4; ++m) { const size_t off = (size_t)(row0 + ai * HALF + m * 16) * ldc + col0 + trofs;
#pragma unroll
                for (int bj = 0; bj < 2; ++bj) { const f32x4 b0 = *(const f32x4*)(base + off + bj * HALF), b1 = *(const f32x4*)(base + off + bj * HALF + 4);
                    const f32x4 v0 = acc[ai][bj][m][0] * gv[bj][0], v1 = acc[ai][bj][m][1] * gv[bj][1];
                    u32x4 w; w.x = cvt_pk_bf16(v0[0], v0[1]); w.y = cvt_pk_bf16(v0[2], v0[3]); w.z = cvt_pk_bf16(v1[0], v1[1]); w.w = cvt_pk_bf16(v1[2], v1[3]);
                    const u32x4 t = epi_tr(w, src4);
                    u32x4 o; o.x = cvt_pk_bf16(b0[0] + bflo(t.x), b0[1] + bfhi(t.x)); o.y = cvt_pk_bf16(b0[2] + bflo(t.y), b0[3] + bfhi(t.y)); o.z = cvt_pk_bf16(b1[0] + bflo(t.z), b1[1] + bfhi(t.z)); o.w = cvt_pk_bf16(b1[2] + bflo(t.w), b1[3] + bfhi(t.w));
                    *(u32x4*)(O + off + bj * HALF) = o; } }
    }
};
struct EpiRes {
    static constexpr bool PERM = false, I8 = false; typedef f32x4 acc_t;
    const float* base; float* out; int ldc; const float* gate; int gate_stride; int rows_per_batch;
    __device__ __forceinline__ void operator()(const f32x4 (&acc)[2][2][4][2], const Unit& u, int wr, int wc, int fr, int fq) const {
        const int col0 = u.pn * BM + wc * 32 + 4 * fq;
        const int bsel = (u.pm * BM) / rows_per_batch;
        f32x4 gv[2][2];
#pragma unroll
        for (int bj = 0; bj < 2; ++bj)
#pragma unroll
            for (int n = 0; n < 2; ++n) gv[bj][n] = *(const f32x4*)(gate + (size_t)bsel * gate_stride + col0 + bj * HALF + n * 16);
#pragma unroll
        for (int ai = 0; ai < 2; ++ai)
#pragma unroll
            for (int m = 0; m < 4; ++m) { const size_t off = (size_t)(u.pm * BM + ai * HALF + wr * 64 + m * 16 + fr) * ldc + col0;
#pragma unroll
                for (int bj = 0; bj < 2; ++bj)
#pragma unroll
                    for (int n = 0; n < 2; ++n) { const f32x4 bs = *(const f32x4*)(base + off + bj * HALF + n * 16);
                        *(f32x4*)(out + off + bj * HALF + n * 16) = bs + gv[bj][n] * acc[ai][bj][m][n]; } }
    }
};

__device__ __forceinline__ f32x4 mma_any(bf16x8 b, bf16x8 a, f32x4 c) { return __builtin_amdgcn_mfma_f32_16x16x32_bf16(b, a, c, 0, 0, 0); }
__device__ __forceinline__ i32x4 mma_any(bf16x8 b, bf16x8 a, i32x4 c) { return __builtin_amdgcn_mfma_i32_16x16x64_i8(__builtin_bit_cast(i32x4, b), __builtin_bit_cast(i32x4, a), c, 0, 0, 0); }
template <class Epi>
__device__ __forceinline__ void gemm_phase(LAS unsigned char* lds, const Gemm g, const StaticOrder& S, const Epi& E) {
    int tid = threadIdx.x; asm volatile("" : "+v"(tid));
    const int wid = __builtin_amdgcn_readfirstlane(tid >> 6), lane = tid & 63, wr = wid >> 2, wc = wid & 3, fr = lane & 15, fq = lane >> 4;
    const int K = g.K, nt = K / BK;
    unsigned voffA[2], voffB[2];
#pragma unroll
    for (int i = 0; i < 2; ++i) { int R, C; stage_rc(tid * 16 + i * 8192, R, C); const int Rb = Epi::PERM ? ((R & ~31) + perm32(R & 31)) : R;
        voffA[i] = (unsigned)(R * K + C) * 2u; voffB[i] = (unsigned)(Rb * K + C) * 2u; }
    const size_t kstep = (size_t)(BK * 2);
    const size_t hstep = (size_t)HALF * K * 2;
    const size_t tstep = 2 * hstep;
    const unsigned ldsw = (unsigned)wid * 1024u;
    const int aoff = lds_byte(wr * 64 + fr, fq * 8), boff = lds_byte(wc * 32 + fr, fq * 8);
#define PG8_SA(b, h) (((b) * 2 + (h)) * HTB)
#define PG8_SB(b, h) ((4 + (b) * 2 + (h)) * HTB)
#define PG8_STAGE(bufoff, gbase, voff) do { _Pragma("unroll") for (int _i = 0; _i < 2; ++_i) \
        __builtin_amdgcn_global_load_lds((const unsigned*)((const char*)(gbase) + (voff)[_i]), (LAS unsigned*)(lds + (bufoff) + ldsw + _i * 8192), 16, 0, 0); } while (0)
#define PG8_LDA(dst, b, h) do { _Pragma("unroll") for (int m = 0; m < 4; ++m) _Pragma("unroll") for (int k = 0; k < 2; ++k) dst[m][k] = *(const LAS bf16x8*)(lds + PG8_SA(b, h) + aoff + m * 2048 + k * 1024); } while (0)
#define PG8_LDB(dst, b, h) do { _Pragma("unroll") for (int n = 0; n < 2; ++n) _Pragma("unroll") for (int k = 0; k < 2; ++k) dst[n][k] = *(const LAS bf16x8*)(lds + PG8_SB(b, h) + boff + n * 2048 + k * 1024); } while (0)
#define PG8_MMA(ai, bj, At, Bt) do { __builtin_amdgcn_s_setprio(1); _Pragma("unroll") for (int m = 0; m < 4; ++m) _Pragma("unroll") for (int n = 0; n < 2; ++n) _Pragma("unroll") for (int k = 0; k < 2; ++k) \
        acc[ai][bj][m][n] = mma_any(Bt[n][k], At[m][k], acc[ai][bj][m][n]); __builtin_amdgcn_s_setprio(0); } while (0)
#define PG8_WAIT_V(n) asm volatile("s_waitcnt vmcnt(" #n ")" ::: "memory")
#define PG8_WAIT_L(n) asm volatile("s_waitcnt lgkmcnt(" #n ")" ::: "memory")
#define PG8_BAR __builtin_amdgcn_s_barrier()
#define PG8_SCHED __builtin_amdgcn_sched_barrier(0)
    Unit cur, nxt; int ui = 0;
    if (!S.next(0, cur)) return;
    typedef typename Epi::acc_t acc_t;
    acc_t acc[2][2][4][2];
#pragma unroll
    for (int a = 0; a < 2; ++a)
#pragma unroll
        for (int b = 0; b < 2; ++b)
#pragma unroll
            for (int m = 0; m < 4; ++m)
#pragma unroll
                for (int n = 0; n < 2; ++n) acc[a][b][m][n] = (acc_t){0, 0, 0, 0};
    bf16x8 At[4][2], B0[2][2], B1[2][2];
    const char* cA = (const char*)g.A + (size_t)cur.pm * tstep; const char* cB = (const char*)g.Bt + g.bsel(cur.pm) + (size_t)cur.pn * tstep;
    PG8_STAGE(PG8_SB(0, 0), cB, voffB); PG8_STAGE(PG8_SB(0, 1), cB + hstep, voffB); PG8_STAGE(PG8_SA(0, 0), cA, voffA); PG8_STAGE(PG8_SA(0, 1), cA + hstep, voffA);
    if (wr == 1) PG8_BAR;
    PG8_WAIT_V(2); PG8_BAR;
    PG8_STAGE(PG8_SB(1, 0), cB + kstep, voffB); PG8_STAGE(PG8_SA(1, 0), cA + kstep, voffA); PG8_STAGE(PG8_SB(1, 1), cB + hstep + kstep, voffB);
    PG8_WAIT_V(6); PG8_BAR;
    for (;;) {
        const bool has_next = S.next(ui + 1, nxt);
        const char* nA = has_next ? (const char*)g.A + (size_t)nxt.pm * tstep : cA; const char* nB = has_next ? (const char*)g.Bt + g.bsel(nxt.pm) + (size_t)nxt.pn * tstep : cB;
        for (int t = 0; t < nt; t += 2) {
            const bool last = (t == nt - 2);
            const char* a1 = cA + (size_t)(t + 1) * kstep;
            const char* a2 = last ? nA : cA + (size_t)(t + 2) * kstep; const char* b2 = last ? nB : cB + (size_t)(t + 2) * kstep;
            const char* a3 = a2 + kstep; const char* b3 = b2 + kstep;
            PG8_LDB(B0, 0, 0); PG8_LDB(B1, 0, 1); PG8_SCHED; PG8_LDA(At, 0, 0); PG8_STAGE(PG8_SA(1, 1), a1 + hstep, voffA);
            PG8_WAIT_V(8); PG8_WAIT_L(0); PG8_BAR; PG8_MMA(0, 0, At, B0); PG8_MMA(0, 1, At, B1); PG8_BAR; PG8_SCHED;
            PG8_LDA(At, 0, 1); PG8_STAGE(PG8_SB(0, 0), b2, voffB); PG8_STAGE(PG8_SB(0, 1), b2 + hstep, voffB); PG8_STAGE(PG8_SA(0, 0), a2, voffA);
            PG8_WAIT_V(8); PG8_WAIT_L(0); PG8_BAR; PG8_MMA(1, 0, At, B0); PG8_MMA(1, 1, At, B1); PG8_BAR; PG8_SCHED;
            PG8_LDB(B0, 1, 0); PG8_LDB(B1, 1, 1); PG8_SCHED; PG8_LDA(At, 1, 0); PG8_STAGE(PG8_SA(0, 1), a2 + hstep, voffA);
            PG8_WAIT_V(8); PG8_WAIT_L(0); PG8_BAR; PG8_MMA(0, 0, At, B0); PG8_MMA(0, 1, At, B1); PG8_BAR; PG8_SCHED;
            PG8_LDA(At, 1, 1); PG8_STAGE(PG8_SB(1, 0), b3, voffB); PG8_STAGE(PG8_SB(1, 1), b3 + hstep, voffB); PG8_STAGE(PG8_SA(1, 0), a3, voffA);
            PG8_WAIT_V(8); PG8_WAIT_L(0); PG8_BAR; PG8_MMA(1, 0, At, B0); PG8_MMA(1, 1, At, B1); PG8_BAR; PG8_SCHED;
        }
        if (wr == 0) PG8_BAR;
        E(acc, cur, wr, wc, fr, fq);
        if (!has_next) break;
#pragma unroll
        for (int a = 0; a < 2; ++a)
#pragma unroll
            for (int b = 0; b < 2; ++b)
#pragma unroll
                for (int m = 0; m < 4; ++m)
#pragma unroll
                    for (int n = 0; n < 2; ++n) acc[a][b][m][n] = (acc_t){0, 0, 0, 0};
        cur = nxt; cA = nA; cB = nB; ++ui;
        if (wr == 1) PG8_BAR;
    }
    PG8_WAIT_V(0);
    PG8_BAR;
#undef PG8_SA
#undef PG8_SB
#undef PG8_STAGE
#undef PG8_LDA
#undef PG8_LDB
#undef PG8_MMA
#undef PG8_WAIT_V
#undef PG8_WAIT_L
#undef PG8_BAR
#undef PG8_SCHED
}
}

__device__ __forceinline__ void p0_transpose_item(const float* W, int K, int N, bf16_t* WT, float* scr, int item, int lane) {
    const int nblk = N / 32, kb = item / nblk, nb = item % nblk, k0 = 64 * kb, n0 = 32 * nb;
#pragma unroll 8
    for (int i = 0; i < 32; ++i) { const int kk = 2 * i + (lane >> 5); scr[kk * 33 + (lane & 31)] = W[(size_t)(k0 + kk) * N + n0 + (lane & 31)]; }
    asm volatile("s_waitcnt lgkmcnt(0)" ::: "memory");
    const int c = lane & 7;
#pragma unroll
    for (int j = 0; j < 4; ++j) { const int n = (lane >> 3) + 8 * j; const float* s = scr + (8 * c) * 33 + n;
        u32x4 o; o.x = pk2(s[0 * 33], s[1 * 33]); o.y = pk2(s[2 * 33], s[3 * 33]); o.z = pk2(s[4 * 33], s[5 * 33]); o.w = pk2(s[6 * 33], s[7 * 33]);
        *(u32x4*)(WT + (size_t)(n0 + n) * K + k0 + 8 * c) = o; }
    asm volatile("s_waitcnt lgkmcnt(0)" ::: "memory");
}
__device__ __forceinline__ void p0_colmax_item(const float* W, int N, unsigned* cmax, int item, int lane) {
    const int ngrp = N / 256, kb = item / ngrp, gb = item % ngrp; const float* src = W + (size_t)(64 * kb) * N + 256 * gb + 4 * lane;
    f32x4 m = {0.f, 0.f, 0.f, 0.f};
#pragma unroll 8
    for (int k = 0; k < 64; ++k) { const f32x4 v = *(const f32x4*)(src + (size_t)k * N); m = (f32x4){fmaxf(m[0], fabsf(v[0])), fmaxf(m[1], fabsf(v[1])), fmaxf(m[2], fabsf(v[2])), fmaxf(m[3], fabsf(v[3]))}; }
#pragma unroll
    for (int e = 0; e < 4; ++e) atomicMax(cmax + 256 * gb + 4 * lane + e, __builtin_bit_cast(unsigned, m[e]));
}
__device__ __forceinline__ void p1_qt_item(const float* W, int K, int N, const unsigned* cmax, unsigned char* WT8, float* scr, int item, int lane) {
    const int nblk = N / 32, kb = item / nblk, nb = item % nblk, k0 = 64 * kb, n0 = 32 * nb;
#pragma unroll 8
    for (int i = 0; i < 32; ++i) { const int kk = 2 * i + (lane >> 5); scr[kk * 33 + (lane & 31)] = W[(size_t)(k0 + kk) * N + n0 + (lane & 31)]; }
    asm volatile("s_waitcnt lgkmcnt(0)" ::: "memory");
    const int c = lane & 7;
#pragma unroll
    for (int j = 0; j < 4; ++j) { const int n = (lane >> 3) + 8 * j; const float* sp_ = scr + (8 * c) * 33 + n;
        const float cm = __builtin_bit_cast(float, cmax[n0 + n]); const float inv = (cm > 1e-30f) ? 127.0f / cm : 0.f;
        u32x2 o; o.x = q8pack((f32x4){sp_[0 * 33], sp_[1 * 33], sp_[2 * 33], sp_[3 * 33]} * inv); o.y = q8pack((f32x4){sp_[4 * 33], sp_[5 * 33], sp_[6 * 33], sp_[7 * 33]} * inv);
        *(u32x2*)(WT8 + (size_t)(n0 + n) * K + k0 + 8 * c) = o; }
    asm volatile("s_waitcnt lgkmcnt(0)" ::: "memory");
}
__device__ __forceinline__ void cvt_item(const float* src, bf16_t* dst, size_t item, int lane) {
    const f32x4* s = (const f32x4*)(src + item * 512) + lane * 2; const f32x4 a = s[0], b = s[1];
    u32x4 o; o.x = pk2(a[0], a[1]); o.y = pk2(a[2], a[3]); o.z = pk2(b[0], b[1]); o.w = pk2(b[2], b[3]);
    *((u32x4*)(dst + item * 512) + lane) = o;
}

__device__ __forceinline__ void phase0(const Params& p, unsigned char* lds, int bid, int nblk) {
    int tid = threadIdx.x; asm volatile("" : "+v"(tid));
    const int lane = tid & 63, wave = __builtin_amdgcn_readfirstlane(tid >> 6);
    float* s_lds = (float*)lds;
    float* red = (float*)(lds + 24576);
    float* scr = (float*)(lds + 49152 + wave * 8448);
    float* MOD = (float*)(p.ws + WS_MOD);
    for (int i = tid; i < 3 * 2048; i += 512) { const int v = i >> 11, k = i & 2047; const float cv = (v < 2) ? p.c[v * 2048 + k] : p.c_ctx[k]; s_lds[i] = cv * sigmoidf_(cv); }
    __syncthreads();
    for (int it = bid; it < 256; it += nblk) {
        const int col0 = it * 48; const int cgp = tid % 12, kl = tid / 12;
        f32x4 a0 = {0.f, 0.f, 0.f, 0.f}, a1 = a0, a2 = a0;
        if (tid < 504) {
            const float* wp = p.w_mod + col0 + 4 * cgp;
#pragma unroll 7
            for (int k = kl; k < 2048; k += 42) { const f32x4 w = *(const f32x4*)(wp + (size_t)k * 12288); a0 += w * s_lds[k]; a1 += w * s_lds[2048 + k]; a2 += w * s_lds[4096 + k]; }
            float* r = red + kl * 144 + cgp * 4;
            *(f32x4*)(r) = a0; *(f32x4*)(r + 48) = a1; *(f32x4*)(r + 96) = a2;
        }
        __syncthreads();
        if (tid < 144) { float s = 0.f; for (int k = 0; k < 42; ++k) s += red[k * 144 + tid]; const int v = tid / 48, col = col0 + tid % 48; MOD[v * 12288 + col] = s + p.b_mod[col]; }
        __syncthreads();
    }
    if (bid == 0) { float* SP = (float*)(p.ws + WS_SP); for (int i = tid; i < 2048; i += 512) SP[i] = log1pf(expf(-p.lru_lam[i])); }
    const int gw = bid * 8 + wave, NGW = nblk * 8;
    constexpr int I_IN = G1_I8 ? 0 : 32 * 128, I_OUT = 32 * 64, I_Q = G3_I8 ? 32 * 8 : 32 * 64, I_LRU = 32 * 8;
    for (int it = gw; it < I_IN + I_OUT + I_Q + I_LRU; it += NGW) {
        int r = it;
        if (r < I_LRU) { const int mat = r >> 3, d = mat >> 4, m = (mat >> 3) & 1, h = mat & 7;
            p0_transpose_item((m ? p.lru_wx : p.lru_wa) + (size_t)(d * 8 + h) * 16384, 128, 128, (bf16_t*)(p.ws + WS_LRUW) + (size_t)mat * 16384, scr, r & 7, lane); continue; } r -= I_LRU;
#if G1_I8
#else
        if (r < I_IN) { p0_transpose_item(p.w_in, 2048, 4096, (bf16_t*)(p.ws + WS_WIN), scr, r, lane); continue; } r -= I_IN;
#endif
        if (r < I_OUT) { p0_transpose_item(p.w_out, 2048, 2048, (bf16_t*)(p.ws + WS_WOUT), scr, r, lane); continue; } r -= I_OUT;
#if G3_I8
        p0_colmax_item(p.wq, 2048, (unsigned*)(p.ws + WS_COLMAX_Q), r, lane);
#else
        p0_transpose_item(p.wq, 2048, 2048, (bf16_t*)(p.ws + WS_WQ), scr, r, lane);
#endif
    }
    constexpr int C_SM = 256;
    for (int it = gw; it < 3 * C_SM; it += NGW) {
        int r = it;
        if (r < C_SM) { cvt_item(p.sgu_w, (bf16_t*)(p.ws + WS_SGUW), r, lane); continue; } r -= C_SM;
        if (r < C_SM) { cvt_item(p.k1, (bf16_t*)(p.ws + WS_K1), r, lane); continue; } r -= C_SM;
        cvt_item(p.k2, (bf16_t*)(p.ws + WS_K2), r, lane);
    }
    for (int it = gw; it < 2 * 16384; it += NGW) {
        const int tab = it >> 14, row = it & 16383;
        const float* src = (tab ? p.pv : p.pu) + (size_t)row * D + 16 * lane;
        f32x4 v[2][4]; float am = 0.f;
#pragma unroll
        for (int c = 0; c < 2; ++c)
#pragma unroll
            for (int e = 0; e < 4; ++e) { v[c][e] = *(const f32x4*)(src + 1024 * c + 4 * e); am = fmaxf(am, fmaxf(fmaxf(fabsf(v[c][e][0]), fabsf(v[c][e][1])), fmaxf(fabsf(v[c][e][2]), fabsf(v[c][e][3])))); }
#pragma unroll
        for (int o = 1; o < 64; o <<= 1) am = fmaxf(am, __shfl_xor(am, o));
        const float inv = (am > 1e-30f) ? 127.0f / am : 0.f;
        unsigned char* dst = p.ws + (tab ? WS_VB : WS_UB) + ((size_t)(lane >> 3) * 16384 + row) * 128 + 16 * (lane & 7);
#pragma unroll
        for (int c = 0; c < 2; ++c) { u32x4 o;
#pragma unroll
            for (int e = 0; e < 4; ++e) o[e] = q8pack(v[c][e] * inv);
            *(u32x4*)(dst + (size_t)c * 8 * 16384 * 128) = o; }
        if (lane == 0) ((float*)(p.ws + WS_USC))[2 * row + tab] = am * (1.0f / 127.0f);
    }
}

__device__ __forceinline__ void norm_row_bf16(const float* xrow, const float* g, const float* shift, const float* scale, bf16_t* orow, int lane) {
    f32x4 v[8]; float ss = 0.f;
#pragma unroll
    for (int j = 0; j < 8; ++j) { v[j] = *((const f32x4*)xrow + lane + 64 * j); ss += (v[j][0] * v[j][0] + v[j][1] * v[j][1]) + (v[j][2] * v[j][2] + v[j][3] * v[j][3]); }
    const float rstd = rsqrtf(wave_sum(ss) * (1.0f / 2048.0f) + EPS);
#pragma unroll
    for (int j = 0; j < 8; ++j) {
        const f32x4 gg = *((const f32x4*)g + lane + 64 * j), sh = *((const f32x4*)shift + lane + 64 * j), sc = *((const f32x4*)scale + lane + 64 * j);
        const f32x4 h = (v[j] * rstd) * gg * (sc + 1.0f) + sh;
        u32x2 o; o.x = pk2(h[0], h[1]); o.y = pk2(h[2], h[3]);
        *((u32x2*)orow + lane + 64 * j) = o;
    }
}
__device__ __forceinline__ void xhat_row_q8(const float* xrow, unsigned char* o8, float* osc, int lane) {
    f32x4 v[8]; float ss = 0.f, am = 0.f;
#pragma unroll
    for (int j = 0; j < 8; ++j) { v[j] = *((const f32x4*)xrow + lane + 64 * j); ss += (v[j][0] * v[j][0] + v[j][1] * v[j][1]) + (v[j][2] * v[j][2] + v[j][3] * v[j][3]);
        am = fmaxf(am, fmaxf(fmaxf(fabsf(v[j][0]), fabsf(v[j][1])), fmaxf(fabsf(v[j][2]), fabsf(v[j][3])))); }
    const float rstd = rsqrtf(wave_sum(ss) * (1.0f / 2048.0f) + EPS);
#pragma unroll
    for (int o = 1; o < 64; o <<= 1) am = fmaxf(am, __shfl_xor(am, o));
    const float inv = (am > 1e-30f) ? 127.0f / am : 0.f;
#pragma unroll
    for (int j = 0; j < 8; ++j) *((unsigned*)o8 + lane + 64 * j) = q8pack(v[j] * inv);
    if (lane == 0) *osc = am * rstd * (1.0f / 127.0f);
}
__device__ __forceinline__ void p1_win3_item(const Params& p, int v, int nb, float* scr, int lane) {
    const float* MOD = (const float*)(p.ws + WS_MOD) + v * 12288;
    const int n0 = 16 * nb, cq = lane & 3, kq = lane >> 2;
    f32x4 mx = {0.f, 0.f, 0.f, 0.f}, bs = {0.f, 0.f, 0.f, 0.f};
#pragma unroll 8
    for (int i = 0; i < 128; ++i) { const int k = 16 * i + kq; const f32x4 w = *(const f32x4*)(p.w_in + (size_t)k * INW + n0 + 4 * cq);
        const float gsk = p.g1[k] * (1.0f + MOD[2048 + k]), shk = MOD[k];
        mx = (f32x4){fmaxf(mx[0], fabsf(w[0] * gsk)), fmaxf(mx[1], fabsf(w[1] * gsk)), fmaxf(mx[2], fabsf(w[2] * gsk)), fmaxf(mx[3], fabsf(w[3] * gsk))}; bs += w * shk; }
#pragma unroll
    for (int o = 4; o < 64; o <<= 1) { mx = (f32x4){fmaxf(mx[0], __shfl_xor(mx[0], o)), fmaxf(mx[1], __shfl_xor(mx[1], o)), fmaxf(mx[2], __shfl_xor(mx[2], o)), fmaxf(mx[3], __shfl_xor(mx[3], o))};
        bs = (f32x4){bs[0] + __shfl_xor(bs[0], o), bs[1] + __shfl_xor(bs[1], o), bs[2] + __shfl_xor(bs[2], o), bs[3] + __shfl_xor(bs[3], o)}; }
    float* CS = (float*)(p.ws + WS_CS1) + v * 4096; float* BI = (float*)(p.ws + WS_BIAS1) + v * 4096;
    if (kq == 0) { *(f32x4*)(CS + n0 + 4 * cq) = mx * (1.0f / 127.0f); *(f32x4*)(BI + n0 + 4 * cq) = bs; }
    const int n = lane >> 2, c = lane & 3;
    float cm;
    { const float c0 = __shfl(mx[0], n >> 2), c1 = __shfl(mx[1], n >> 2), c2 = __shfl(mx[2], n >> 2), c3 = __shfl(mx[3], n >> 2);
      cm = ((n & 3) == 0) ? c0 : ((n & 3) == 1) ? c1 : ((n & 3) == 2) ? c2 : c3; }
    const float inv = (cm > 1e-30f) ? 127.0f / cm : 0.f;
    unsigned char* WT8 = p.ws + WS_WIN3 + (size_t)v * 4096 * 2048;
    for (int kb = 0; kb < 32; ++kb) {
        const int k0 = 64 * kb;
#pragma unroll
        for (int r = 0; r < 4; ++r) { const int kk = kq + 16 * r, k = k0 + kk; const f32x4 w = *(const f32x4*)(p.w_in + (size_t)k * INW + n0 + 4 * cq) * (p.g1[k] * (1.0f + MOD[2048 + k]));
            float* d = scr + kk * 17 + 4 * cq; d[0] = w[0]; d[1] = w[1]; d[2] = w[2]; d[3] = w[3]; }
        asm volatile("s_waitcnt lgkmcnt(0)" ::: "memory");
        const float* sp_ = scr + (16 * c) * 17 + n;
        u32x4 o;
#pragma unroll
        for (int e = 0; e < 4; ++e) o[e] = q8pack((f32x4){sp_[(4 * e + 0) * 17], sp_[(4 * e + 1) * 17], sp_[(4 * e + 2) * 17], sp_[(4 * e + 3) * 17]} * inv);
        *(u32x4*)(WT8 + (size_t)(n0 + n) * 2048 + k0 + 16 * c) = o;
        asm volatile("s_waitcnt lgkmcnt(0)" ::: "memory");
    }
}
template <bool BF16COPY>
__device__ __forceinline__ void norm_row_q8(const float* xrow, const float* g, const float* shift, const float* scale, unsigned char* o8, float* osc, int lane, bf16_t* obf = nullptr, const bf16_t* addrow = nullptr, bf16_t* sumout = nullptr) {
    f32x4 v[8]; float ss = 0.f;
#pragma unroll
    for (int j = 0; j < 8; ++j) { v[j] = *((const f32x4*)xrow + lane + 64 * j);
        if (addrow) { const u32x2 a = *((const u32x2*)addrow + lane + 64 * j); v[j] += (f32x4){bflo(a.x), bfhi(a.x), bflo(a.y), bfhi(a.y)}; }
        if (sumout) { u32x2 o; o.x = pk2(v[j][0], v[j][1]); o.y = pk2(v[j][2], v[j][3]); *((u32x2*)sumout + lane + 64 * j) = o; }
        ss += (v[j][0] * v[j][0] + v[j][1] * v[j][1]) + (v[j][2] * v[j][2] + v[j][3] * v[j][3]); }
    const float rstd = rsqrtf(wave_sum(ss) * (1.0f / 2048.0f) + EPS);
    float am = 0.f;
#pragma unroll
    for (int j = 0; j < 8; ++j) {
        const f32x4 gg = *((const f32x4*)g + lane + 64 * j), sh = *((const f32x4*)shift + lane + 64 * j), sc = *((const f32x4*)scale + lane + 64 * j);
        const f32x4 h = (v[j] * rstd) * gg * (sc + 1.0f) + sh; v[j] = h;
        if (BF16COPY) { u32x2 o; o.x = pk2(h[0], h[1]); o.y = pk2(h[2], h[3]); *((u32x2*)obf + lane + 64 * j) = o; }
        am = fmaxf(am, fmaxf(fmaxf(fabsf(h[0]), fabsf(h[1])), fmaxf(fabsf(h[2]), fabsf(h[3]))));
    }
#pragma unroll
    for (int o = 1; o < 64; o <<= 1) am = fmaxf(am, __shfl_xor(am, o));
    const float inv = (am > 1e-30f) ? 127.0f / am : 0.f;
#pragma unroll
    for (int j = 0; j < 8; ++j) *((unsigned*)o8 + lane + 64 * j) = q8pack(v[j] * inv);
    if (lane == 0) *osc = am * (1.0f / 127.0f);
}
__device__ __forceinline__ void phase_norm1(const Params& p, unsigned char* lds, int bid, int nblk) {
    int tid = threadIdx.x; asm volatile("" : "+v"(tid));
    const int lane = tid & 63, wave = __builtin_amdgcn_readfirstlane(tid >> 6);
    const float* MOD = (const float*)(p.ws + WS_MOD); unsigned char* HN8 = p.ws + WS_HN; float* RS1 = (float*)(p.ws + WS_RS1);
    float* scr = (float*)(lds + wave * 8448);
    const int gw = bid * 8 + wave, NGW = nblk * 8;
    constexpr int I_IN = G1_I8 ? 3 * 256 : 0, I_Q = G3_I8 ? 32 * 64 : 0;
    for (int it = gw; it < I_IN + I_Q; it += NGW) {
        if (it < I_IN) p1_win3_item(p, it / 256, it % 256, scr, lane);
        else p1_qt_item(p.wq, 2048, 2048, (const unsigned*)(p.ws + WS_COLMAX_Q), p.ws + WS_WQ, scr, it - I_IN, lane);
    }
    unsigned* rowctr = (unsigned*)(p.ws + WS_CTL + 49152);
    for (;;) {
      int r0 = 0; if (lane == 0) r0 = (int)atomicAdd(rowctr, 4u); r0 = __builtin_amdgcn_readfirstlane(r0);
      if (r0 >= MALL) break;
      for (int row = r0; row < r0 + 4 && row < MALL; ++row) {
        const bool isctx = row >= MLAT; const int v = isctx ? 2 : (row >> 14);
        const float* xr = isctx ? p.ctx + (size_t)(row - MLAT) * D : p.x + (size_t)row * D;
#if G1_I8
        xhat_row_q8(xr, HN8 + (size_t)row * D, RS1 + row, lane); (void)v; (void)MOD;
#else
        norm_row_bf16(xr, p.g1, MOD + v * 12288, MOD + v * 12288 + 2048, (bf16_t*)(p.ws + WS_HN) + (size_t)row * D, lane);
#endif
      }
    }
}
__device__ __forceinline__ void xl_row_q8(const bf16_t* xl, const float* g, const float* shift, const float* scale, unsigned char* o8, float* osc, int lane) {
    f32x4 v[8]; float ss = 0.f;
#pragma unroll
    for (int j = 0; j < 8; ++j) { const u32x2 a = *((const u32x2*)xl + lane + 64 * j); v[j] = (f32x4){bflo(a.x), bfhi(a.x), bflo(a.y), bfhi(a.y)};
        ss += (v[j][0] * v[j][0] + v[j][1] * v[j][1]) + (v[j][2] * v[j][2] + v[j][3] * v[j][3]); }
    const float rstd = rsqrtf(wave_sum(ss) * (1.0f / 2048.0f) + EPS);
    float am = 0.f;
#pragma unroll
    for (int j = 0; j < 8; ++j) {
        const f32x4 gg = *((const f32x4*)g + lane + 64 * j), sh = *((const f32x4*)shift + lane + 64 * j), sc = *((const f32x4*)scale + lane + 64 * j);
        const f32x4 h = (v[j] * rstd) * gg * (sc + 1.0f) + sh; v[j] = h;
        am = fmaxf(am, fmaxf(fmaxf(fabsf(h[0]), fabsf(h[1])), fmaxf(fabsf(h[2]), fabsf(h[3]))));
    }
#pragma unroll
    for (int o = 1; o < 64; o <<= 1) am = fmaxf(am, __shfl_xor(am, o));
    const float inv = (am > 1e-30f) ? 127.0f / am : 0.f;
#pragma unroll
    for (int j = 0; j < 8; ++j) *((unsigned*)o8 + lane + 64 * j) = q8pack(v[j] * inv);
    if (lane == 0) *osc = am * (1.0f / 127.0f);
}
__device__ __forceinline__ void phase_norm2(const Params& p, int bid, int nblk) {
    int tid = threadIdx.x; asm volatile("" : "+v"(tid));
    const int lane = tid & 63, wave = __builtin_amdgcn_readfirstlane(tid >> 6);
    const float* MOD = (const float*)(p.ws + WS_MOD);
    for (int row = bid * 8 + wave; row < MLAT; row += nblk * 8) {
        const int v = row >> 14;
        xl_row_q8((const bf16_t*)(p.ws + WS_YL) + (size_t)row * D, p.g2, MOD + v * 12288 + 3 * 2048, MOD + v * 12288 + 4 * 2048, p.ws + WS_HN8 + (size_t)row * D, (float*)(p.ws + WS_HSC) + row, lane);
    }
}

constexpr int XCB_LD = 136, XCF_LD = 132;
constexpr size_t WS_CARRY = 596 * MiB;

__device__ __forceinline__ void lru_ab(float ga, float gx, float ba, float bx, float sp, float xv, float& a, float& b) {
    const float rg = __builtin_amdgcn_rcpf(1.0f + __builtin_amdgcn_exp2f(fmaf(ga, -1.4426950408889634f, ba)));
    const float ig = __builtin_amdgcn_rcpf(1.0f + __builtin_amdgcn_exp2f(fmaf(gx, -1.4426950408889634f, bx)));
    a = __builtin_amdgcn_exp2f(rg * sp);
    const float em = fmaf(-a, a, 1.0f);
    b = __builtin_amdgcn_sqrtf(em) * ig * xv;
}
__device__ __forceinline__ void lru_gates1(const bf16_t* xcb, const float* xcf, int mt, int cc, int q4, int chl, const bf16x8 (&Bwa)[4], const bf16x8 (&Bwx)[4],
                                           float ba, float bx, float sp, float (&a)[4], float (&b)[4]) {
    f32x4 ga = {0.f, 0.f, 0.f, 0.f}, gx = {0.f, 0.f, 0.f, 0.f};
#pragma unroll
    for (int ks = 0; ks < 4; ++ks) {
        const bf16x8 A = *(const bf16x8*)(xcb + (16 * mt + cc) * XCB_LD + 32 * ks + 8 * q4);
        ga = __builtin_amdgcn_mfma_f32_16x16x32_bf16(A, Bwa[ks], ga, 0, 0, 0);
        gx = __builtin_amdgcn_mfma_f32_16x16x32_bf16(A, Bwx[ks], gx, 0, 0, 0);
    }
#pragma unroll
    for (int r = 0; r < 4; ++r) lru_ab(ga[r], gx[r], ba, bx, sp, xcf[(16 * mt + 4 * q4 + r) * XCF_LD + chl], a[r], b[r]);
}

__device__ __forceinline__ void carry_phase(const Params& p, int bid, int nblk) {
    int tid = threadIdx.x; asm volatile("" : "+v"(tid));
    const float* SUMS = (const float*)(p.ws + WS_SUMS); float* CARRY = (float*)(p.ws + WS_CARRY);
    for (int gid = bid * 512 + tid; gid < 4096; gid += nblk * 512) {
        const int b = gid >> 11, d = (gid >> 10) & 1, ch = gid & 1023;
        const float* sb = SUMS + (size_t)b * NSEG * 4096 + d * 2048 + ch;
        float* cb = CARRY + (size_t)b * 128 * 2048 + d * 1024 + ch;
        if (d == 0) {
            float h = sb[1024]; h = sb[4096] * h + sb[4096 + 1024];
#pragma unroll 8
            for (int c = 0; c < 128; ++c) { cb[(size_t)c * 2048] = h; h = sb[(size_t)(c + 2) * 4096] * h + sb[(size_t)(c + 2) * 4096 + 1024]; }
        } else {
            float h = sb[4096 + 1024]; h = sb[0] * h + sb[1024];
#pragma unroll 8
            for (int c = 127; c >= 0; --c) { cb[(size_t)c * 2048] = h; h = sb[(size_t)(c + 2) * 4096] * h + sb[(size_t)(c + 2) * 4096 + 1024]; }
        }
    }
}

__device__ __forceinline__ void wait_count(unsigned* ctr, unsigned target) {
    unsigned sp = 0u;
    while (__hip_atomic_load(ctr, __ATOMIC_RELAXED, __HIP_MEMORY_SCOPE_AGENT) < target) { __builtin_amdgcn_s_sleep(2); if (++sp > (1u << 22)) break; }
    __builtin_amdgcn_fence(__ATOMIC_ACQUIRE, "agent");
    asm volatile("s_waitcnt vmcnt(0)" ::: "memory");
}
template <bool APPLY>
__device__ __forceinline__ void lru_phase(const Params& p, unsigned char* lds, int bid, int nblk) {
    int tid = threadIdx.x; asm volatile("" : "+v"(tid));
    const int lane = tid & 63, w = __builtin_amdgcn_readfirstlane(tid >> 6), cc = lane & 15, q4 = lane >> 4;
    const int pg = tid >> 4, c8 = tid & 15;
    bf16_t* xcb = (bf16_t*)lds;
    float* xcf = (float*)(lds + 34816);
    float* cw = (float*)(lds + 102400);
    const bf16_t* PROJ = (const bf16_t*)(p.ws + WS_PROJ);
    float* SUMS = (float*)(p.ws + WS_SUMS);
    const float* SP = (const float*)(p.ws + WS_SP);
    const float* CARRY = (const float*)(p.ws + WS_CARRY);
    bf16_t* Y = (bf16_t*)(p.ws + WS_HN);
    const bf16_t* LRUW = (const bf16_t*)(p.ws + WS_LRUW);
    constexpr int NS = APPLY ? 128 : NSEG;
    const int nitems = 2 * NS * 8;
    int cur_h = -1;
    const int chl = 16 * w + cc;
    bf16x8 Bw[2][2][4];
    float ba[2], bx[2], sp[2];
#pragma unroll
    for (int d = 0; d < 2; ++d) { ba[d] = 0.f; bx[d] = 0.f; sp[d] = 0.f;
#pragma unroll
        for (int m = 0; m < 2; ++m)
#pragma unroll
            for (int ks = 0; ks < 4; ++ks) Bw[d][m][ks] = (bf16x8){0, 0, 0, 0, 0, 0, 0, 0}; }
#define LRU_DECODE(it_) const int h = (it_) & 7, bs = (it_) >> 3, b = APPLY ? bs / NS : (bs < 256 ? bs >> 7 : (bs - 256) >> 1), sg = APPLY ? bs % NS : (bs < 256 ? 2 + (bs & 127) : (bs - 256) & 1); const int seg = APPLY ? sg + 2 : sg; const bool isctx = seg < 2;        \
        const int L = isctx ? CTXL : SEQ; const int p0 = isctx ? seg * 128 : (seg - 2) * 128; const size_t rowbase = isctx ? (size_t)(MLAT + b * CTXL) : (size_t)b * SEQ;
#define LRU_LOADRAW(dst) { _Pragma("unroll") for (int i = 0; i < 7; ++i) { const int r = p0 + 4 * pg - 2 + i; const bool ok = (r >= 0) && (r < L); \
            dst[i] = ok ? *(const u32x4*)(PROJ + (rowbase + (size_t)(ok ? r : 0)) * INW + h * 128 + 8 * c8) : (u32x4){0u, 0u, 0u, 0u}; } }
    bool ctx_ready = !(G1_I8 && CTX_SPLIT) || APPLY;
#define LRU_CTXWAIT(it_) if (!ctx_ready && ((it_) >> 3) >= 256) { if (tid == 0) wait_count((unsigned*)(p.ws + WS_CTL + CTXDONE_OFS), 8u); __syncthreads(); ctx_ready = true; }
    u32x4 rw[7];
    unsigned* lctr = (unsigned*)(p.ws + WS_CTL + 45120) + (bid & 7);
    volatile int* nxl = (volatile int*)(lds + 105216);
    int it = bid, itn = bid + nblk, itnn = 0;
    if (!APPLY) {
        if (tid == 0) { nxl[0] = (int)atomicAdd(lctr, 1u) * 8 + (bid & 7); nxl[1] = (int)atomicAdd(lctr, 1u) * 8 + (bid & 7); }
        __syncthreads();
        it = nxl[0]; itn = nxl[1];
        __syncthreads();
        if (it < nitems) { LRU_CTXWAIT(it) LRU_DECODE(it) LRU_LOADRAW(rw) }
    }
    for (; it < nitems; it = itn, itn = APPLY ? itn + nblk : itnn) {
        LRU_DECODE(it)
        if (!APPLY) { if (tid == 0) nxl[0] = (int)atomicAdd(lctr, 1u) * 8 + (bid & 7); }
        if (APPLY) { LRU_LOADRAW(rw) }
#define LRU_LOADW2(d_, W0, W1) { const bf16_t* wa_ = LRUW + ((size_t)(((d_) * 2 + 0) * 8 + h) * 128 + chl) * 128 + 8 * q4; const bf16_t* wx_ = LRUW + ((size_t)(((d_) * 2 + 1) * 8 + h) * 128 + chl) * 128 + 8 * q4; \
            _Pragma("unroll") for (int ks = 0; ks < 4; ++ks) { W0[ks] = *(const bf16x8*)(wa_ + 32 * ks); W1[ks] = *(const bf16x8*)(wx_ + 32 * ks); } }
        if (h != cur_h) {
            cur_h = h;
#pragma unroll
            for (int d = 0; d < 2; ++d) {
                if (APPLY) { ba[d] = -1.4426950408889634f * p.lru_ba[d * 1024 + h * 128 + chl]; bx[d] = -1.4426950408889634f * p.lru_bx[d * 1024 + h * 128 + chl]; sp[d] = -8.0f * 1.4426950408889634f * SP[d * 1024 + h * 128 + chl]; continue; }
                const bf16_t* wa_ = LRUW + ((size_t)((d * 2 + 0) * 8 + h) * 128 + chl) * 128 + 8 * q4; const bf16_t* wx_ = LRUW + ((size_t)((d * 2 + 1) * 8 + h) * 128 + chl) * 128 + 8 * q4;
#pragma unroll
                for (int ks = 0; ks < 4; ++ks) { Bw[d][0][ks] = *(const bf16x8*)(wa_ + 32 * ks); Bw[d][1][ks] = *(const bf16x8*)(wx_ + 32 * ks); }
                ba[d] = -1.4426950408889634f * p.lru_ba[d * 1024 + h * 128 + chl]; bx[d] = -1.4426950408889634f * p.lru_bx[d * 1024 + h * 128 + chl]; sp[d] = -8.0f * 1.4426950408889634f * SP[d * 1024 + h * 128 + chl];
            }
            for (int i = tid; i < 640; i += 512) { const int k = i >> 7, ch = i & 127; cw[i] = (k < 4) ? p.conv_w[k * 1024 + h * 128 + ch] : p.conv_b[h * 128 + ch]; }
            __syncthreads();
        }
        {
            f32x4 wk[5][2];
#pragma unroll
            for (int k = 0; k < 5; ++k) { wk[k][0] = *(const f32x4*)(cw + k * 128 + 8 * c8); wk[k][1] = *(const f32x4*)(cw + k * 128 + 8 * c8 + 4); }
#pragma unroll
            for (int j = 0; j < 4; ++j) {
                f32x4 x0 = wk[4][0], x1 = wk[4][1];
#pragma unroll
                for (int k = 0; k < 4; ++k) { const u32x4 r = rw[j + k];
                    x0 += wk[k][0] * (f32x4){bflo(r[0]), bfhi(r[0]), bflo(r[1]), bfhi(r[1])};
                    x1 += wk[k][1] * (f32x4){bflo(r[2]), bfhi(r[2]), bflo(r[3]), bfhi(r[3])}; }
                const int pos = 4 * pg + j;
                *(f32x4*)(xcf + pos * XCF_LD + 8 * c8) = x0; *(f32x4*)(xcf + pos * XCF_LD + 8 * c8 + 4) = x1;
                u32x4 o; o.x = pk2(x0[0], x0[1]); o.y = pk2(x0[2], x0[3]); o.z = pk2(x1[0], x1[1]); o.w = pk2(x1[2], x1[3]);
                *(u32x4*)(xcb + pos * XCB_LD + 8 * c8) = o;
            }
        }
        u32x4 gt[4]; float cf = 0.f, cbw = 0.f;
        if (APPLY) {
            const float* cp = CARRY + ((size_t)(b * 128 + sg) * 2) * 1024 + h * 128 + chl; cf = cp[0]; cbw = cp[1024];
        }
        if (!APPLY) { if (itn < nitems) { LRU_CTXWAIT(itn) LRU_DECODE(itn) LRU_LOADRAW(rw) } }
        __syncthreads();
        if (!APPLY) itnn = nxl[0];
        if (APPLY) {
            float y[8][4];
#pragma unroll
            for (int mt = 0; mt < 8; ++mt)
#pragma unroll
                for (int r = 0; r < 4; ++r) y[mt][r] = 0.f;
            float stf = cf, stb = cbw;
            bf16x8 Wf0[4], Wf1[4];
            LRU_LOADW2(0, Wf0, Wf1)
#pragma unroll
            for (int i = 0; i < 8; ++i) {
                const int mt = i; float a[4], bb[4];
                lru_gates1(xcb, xcf, mt, cc, q4, chl, Wf0, Wf1, ba[0], bx[0], sp[0], a, bb);
                float A4 = a[0], B4 = bb[0];
#pragma unroll
                for (int r = 1; r < 4; ++r) { B4 = a[r] * B4 + bb[r]; A4 *= a[r]; }
                const float A0 = __shfl(A4, cc), A1 = __shfl(A4, cc + 16), A2 = __shfl(A4, cc + 32), A3 = __shfl(A4, cc + 48);
                const float B0 = __shfl(B4, cc), B1 = __shfl(B4, cc + 16), B2 = __shfl(B4, cc + 32), B3 = __shfl(B4, cc + 48);
                const float s0 = stf, s1 = A0 * s0 + B0, s2 = A1 * s1 + B1, s3 = A2 * s2 + B2, s4 = A3 * s3 + B3;
                float hh = (q4 == 0) ? s0 : (q4 == 1) ? s1 : (q4 == 2) ? s2 : s3;
#pragma unroll
                for (int r = 0; r < 4; ++r) { hh = a[r] * hh + bb[r]; y[mt][r] += hh; }
                stf = s4;
                if (i & 1) __builtin_amdgcn_sched_barrier(0);
            }
            bf16x8 Wb0[4], Wb1[4];
            LRU_LOADW2(1, Wb0, Wb1)
#pragma unroll
            for (int i = 0; i < 8; ++i) {
                const int mt = 7 - i; float a[4], bb[4];
                lru_gates1(xcb, xcf, mt, cc, q4, chl, Wb0, Wb1, ba[1], bx[1], sp[1], a, bb);
                float A4 = a[3], B4 = bb[3];
#pragma unroll
                for (int r = 2; r >= 0; --r) { B4 = a[r] * B4 + bb[r]; A4 *= a[r]; }
                const float A0 = __shfl(A4, cc), A1 = __shfl(A4, cc + 16), A2 = __shfl(A4, cc + 32), A3 = __shfl(A4, cc + 48);
                const float B0 = __shfl(B4, cc), B1 = __shfl(B4, cc + 16), B2 = __shfl(B4, cc + 32), B3 = __shfl(B4, cc + 48);
                const float s0 = stb, s1 = A3 * s0 + B3, s2 = A2 * s1 + B2, s3 = A1 * s2 + B1, s4 = A0 * s3 + B0;
                float hh = (q4 == 3) ? s0 : (q4 == 2) ? s1 : (q4 == 1) ? s2 : s3;
#pragma unroll
                for (int r = 3; r >= 0; --r) { hh = a[r] * hh + bb[r]; y[mt][r] += hh; }
                stb = s4;
                if (i & 1) __builtin_amdgcn_sched_barrier(0);
            }
#pragma unroll
            for (int j = 0; j < 4; ++j) gt[j] = *(const u32x4*)(PROJ + (rowbase + p0 + 4 * pg + j) * INW + 1024 + h * 128 + 8 * c8);
            __syncthreads();
#pragma unroll
            for (int mt = 0; mt < 8; ++mt)
#pragma unroll
                for (int r = 0; r < 4; ++r) xcf[(16 * mt + 4 * q4 + r) * XCF_LD + chl] = y[mt][r];
            __syncthreads();
#pragma unroll
            for (int j = 0; j < 4; ++j) {
                const int pos = 4 * pg + j;
                const f32x4 y0 = *(const f32x4*)(xcf + pos * XCF_LD + 8 * c8), y1 = *(const f32x4*)(xcf + pos * XCF_LD + 8 * c8 + 4);
                const u32x4 g = gt[j];
                u32x4 o;
                o.x = pk2(gelu_tanh(bflo(g[0])) * y0[0], gelu_tanh(bfhi(g[0])) * y0[1]); o.y = pk2(gelu_tanh(bflo(g[1])) * y0[2], gelu_tanh(bfhi(g[1])) * y0[3]);
                o.z = pk2(gelu_tanh(bflo(g[2])) * y1[0], gelu_tanh(bfhi(g[2])) * y1[1]); o.w = pk2(gelu_tanh(bflo(g[3])) * y1[2], gelu_tanh(bfhi(g[3])) * y1[3]);
                *(u32x4*)(Y + (rowbase + p0 + pos) * D + h * 128 + 8 * c8) = o;
            }
        } else {
            float TA[2] = {1.f, 1.f}, TB[2] = {0.f, 0.f};
#pragma unroll 2
            for (int mt = 0; mt < 8; ++mt) {
                f32x4 gaf = {0.f, 0.f, 0.f, 0.f}, gxf = gaf, gab = gaf, gxb = gaf;
#pragma unroll
                for (int ks = 0; ks < 4; ++ks) {
                    const bf16x8 A = *(const bf16x8*)(xcb + (16 * mt + cc) * XCB_LD + 32 * ks + 8 * q4);
                    gaf = __builtin_amdgcn_mfma_f32_16x16x32_bf16(A, Bw[0][0][ks], gaf, 0, 0, 0);
                    gxf = __builtin_amdgcn_mfma_f32_16x16x32_bf16(A, Bw[0][1][ks], gxf, 0, 0, 0);
                    gab = __builtin_amdgcn_mfma_f32_16x16x32_bf16(A, Bw[1][0][ks], gab, 0, 0, 0);
                    gxb = __builtin_amdgcn_mfma_f32_16x16x32_bf16(A, Bw[1][1][ks], gxb, 0, 0, 0);
                }
                float af[4], bf[4], ab[4], bbk[4];
#pragma unroll
                for (int r = 0; r < 4; ++r) { const float xv = xcf[(16 * mt + 4 * q4 + r) * XCF_LD + chl];
                    lru_ab(gaf[r], gxf[r], ba[0], bx[0], sp[0], xv, af[r], bf[r]); lru_ab(gab[r], gxb[r], ba[1], bx[1], sp[1], xv, ab[r], bbk[r]); }
                float FA = af[0], FB = bf[0], RA = ab[3], RB = bbk[3];
#pragma unroll
                for (int r = 1; r < 4; ++r) { FB = af[r] * FB + bf[r]; FA *= af[r]; }
#pragma unroll
                for (int r = 2; r >= 0; --r) { RB = ab[r] * RB + bbk[r]; RA *= ab[r]; }
                {   const float A0 = __shfl(FA, cc), A1 = __shfl(FA, cc + 16), A2 = __shfl(FA, cc + 32), A3 = __shfl(FA, cc + 48);
                    const float B0 = __shfl(FB, cc), B1 = __shfl(FB, cc + 16), B2 = __shfl(FB, cc + 32), B3 = __shfl(FB, cc + 48);
                    const float At = A0 * A1 * A2 * A3, Bt = ((B0 * A1 + B1) * A2 + B2) * A3 + B3;
                    TB[0] = At * TB[0] + Bt; TA[0] = TA[0] * At; }
                {   const float A0 = __shfl(RA, cc), A1 = __shfl(RA, cc + 16), A2 = __shfl(RA, cc + 32), A3 = __shfl(RA, cc + 48);
                    const float B0 = __shfl(RB, cc), B1 = __shfl(RB, cc + 16), B2 = __shfl(RB, cc + 32), B3 = __shfl(RB, cc + 48);
                    const float At = A0 * A1 * A2 * A3, Bt = ((B3 * A2 + B2) * A1 + B1) * A0 + B0;
                    TB[1] = TA[1] * Bt + TB[1]; TA[1] = At * TA[1]; }
            }
            if (q4 == 0) {
#pragma unroll
                for (int d = 0; d < 2; ++d) { float* sb = SUMS + ((size_t)(b * NSEG + seg) * 2 + d) * 2048 + h * 128 + chl; sb[0] = TA[d]; sb[1024] = TB[d]; }
            }
        }
        __syncthreads();
    }
#undef LRU_DECODE
#undef LRU_LOADRAW
#undef LRU_LOADW2
#undef LRU_CTXWAIT
}

__device__ __forceinline__ void sgu_phase(const Params& p, unsigned char* lds, int bid, int nblk) {
    int tid = threadIdx.x; asm volatile("" : "+v"(tid));
    const int lane = tid & 63, w = __builtin_amdgcn_readfirstlane(tid >> 6), cc = lane & 15, q4 = lane >> 4;
    bf16_t* vgT = (bf16_t*)lds;
    float* part = (float*)(lds + 34816);
    bf16_t* Wl = (bf16_t*)(lds + 38912);
    const bf16_t* PROJ = (const bf16_t*)(p.ws + WS_PROJ);
    const bf16_t* WS_ = (const bf16_t*)(p.ws + WS_SGUW);
    bf16_t* Y = (bf16_t*)(p.ws + WS_HN);
    const int pp1 = tid & 127, cg4 = tid >> 7;
    const int c0 = 16 * w + 4 * q4;
    const int g = bid & 7;
    unsigned* ctr = (unsigned*)(p.ws + WS_CTL + 45056) + g;
    volatile int* nxtw = (volatile int*)(lds + 73728);
    if (tid == 0) nxtw[0] = (int)atomicAdd(ctr, 1u);
#pragma unroll
    for (int e = 0; e < 4; ++e) { const int i = tid + 512 * e; const int r = i >> 4, c16 = i & 15; *(u32x4*)(Wl + r * XCB_LD + 8 * c16) = *(const u32x4*)(WS_ + ((size_t)g * 128 + r) * 128 + 8 * c16); }
    __syncthreads();
    int jt = nxtw[0];
    float bsr[8];
#pragma unroll
    for (int nt = 0; nt < 8; ++nt) bsr[nt] = p.sgu_b[g * 128 + 16 * nt + cc];
    u32x4 vr[4];
    if (jt < 256) { const u32x4* src = (const u32x4*)(PROJ + ((size_t)(jt >> 7) * SEQ + (size_t)(jt & 127) * 128 + pp1) * INW + 3072 + g * 128 + 32 * cg4);
#pragma unroll
        for (int e = 0; e < 4; ++e) vr[e] = src[e]; }
    while (jt < 256) {
        const int n = jt & 127, b = jt >> 7;
        const size_t rowbase = (size_t)b * SEQ + (size_t)n * 128;
        if (tid == 0) nxtw[1] = (int)atomicAdd(ctr, 1u);
        u32x2 ur[8];
#pragma unroll
        for (int nt = 0; nt < 8; ++nt) ur[nt] = *(const u32x2*)(PROJ + (rowbase + 16 * nt + cc) * INW + 2048 + g * 128 + c0);
        {
            float gv[32]; float s1 = 0.f, s2 = 0.f;
#pragma unroll
            for (int e = 0; e < 4; ++e) { const u32x4 r = vr[e];
#pragma unroll
                for (int j = 0; j < 4; ++j) { const float lo = gelu_tanh(bflo(r[j])), hi = gelu_tanh(bfhi(r[j])); gv[8 * e + 2 * j] = lo; gv[8 * e + 2 * j + 1] = hi; s1 += lo + hi; s2 += lo * lo + hi * hi; } }
            part[(cg4 * 128 + pp1) * 2] = s1; part[(cg4 * 128 + pp1) * 2 + 1] = s2;
            __syncthreads();
            jt = nxtw[1];
            if (jt < 256) { const u32x4* src = (const u32x4*)(PROJ + ((size_t)(jt >> 7) * SEQ + (size_t)(jt & 127) * 128 + pp1) * INW + 3072 + g * 128 + 32 * cg4);
#pragma unroll
                for (int e = 0; e < 4; ++e) vr[e] = src[e]; }
            float ts = 0.f, ts2 = 0.f;
#pragma unroll
            for (int k = 0; k < 4; ++k) { ts += part[(k * 128 + pp1) * 2]; ts2 += part[(k * 128 + pp1) * 2 + 1]; }
            const float mu = ts * (1.0f / 128.0f); const float var = fmaxf(ts2 * (1.0f / 128.0f) - mu * mu, 0.f); const float rstd = rsqrtf(var + EPS);
#pragma unroll
            for (int j = 0; j < 32; ++j) vgT[(32 * cg4 + j) * XCB_LD + pp1] = (bf16_t)f2bf((gv[j] - mu) * rstd);
        }
        __syncthreads();
        {
            bf16x8 Af[4];
#pragma unroll
            for (int ks = 0; ks < 4; ++ks) Af[ks] = *(const bf16x8*)(vgT + (16 * w + cc) * XCB_LD + 32 * ks + 8 * q4);
#pragma unroll
            for (int nt = 0; nt < 8; ++nt) {
                const int pp = 16 * nt + cc;
                f32x4 acc = {0.f, 0.f, 0.f, 0.f};
#pragma unroll
                for (int ks = 0; ks < 4; ++ks) { const bf16x8 Bf = *(const bf16x8*)(Wl + pp * XCB_LD + 32 * ks + 8 * q4); acc = __builtin_amdgcn_mfma_f32_16x16x32_bf16(Af[ks], Bf, acc, 0, 0, 0); }
                const float bsv = bsr[nt];
                const u32x2 uu = ur[nt];
                const float y0 = gelu_tanh(bflo(uu.x)) * (acc[0] + bsv), y1 = gelu_tanh(bfhi(uu.x)) * (acc[1] + bsv), y2 = gelu_tanh(bflo(uu.y)) * (acc[2] + bsv), y3 = gelu_tanh(bfhi(uu.y)) * (acc[3] + bsv);
                u32x2 o; o.x = pk2(y0, y1); o.y = pk2(y2, y3);
                *(u32x2*)(Y + (rowbase + pp) * D + 1024 + g * 128 + c0) = o;
            }
        }
        __syncthreads();
    }
}

#define INS16(S, x) do { int _x = (x); _Pragma("unroll") for (int _j = 0; _j < 16; ++_j) { const int _hi = max(S[_j], _x); _x = min(S[_j], _x); S[_j] = _hi; } } while (0)
#define MERGE16(A, B) do { _Pragma("unroll") for (int _i = 0; _i < 16; ++_i) A[_i] = max(A[_i], B[15 - _i]); \
    _Pragma("unroll") for (int _st = 8; _st >= 1; _st >>= 1) { _Pragma("unroll") for (int _i = 0; _i < 16; ++_i) if ((_i & _st) == 0) { const int _hi = max(A[_i], A[_i + _st]), _lo = min(A[_i], A[_i + _st]); A[_i] = _hi; A[_i + _st] = _lo; } } } while (0)
#define SORT16(S) { _Pragma("unroll") for (int kk = 2; kk <= 16; kk <<= 1) _Pragma("unroll") for (int jj2 = kk >> 1; jj2 > 0; jj2 >>= 1) _Pragma("unroll") for (int i = 0; i < 16; ++i) { const int l = i ^ jj2; \
        if (l > i) { const int hi = max(S[i], S[l]), lo = min(S[i], S[l]); const bool desc = ((i & kk) == 0); S[i] = desc ? hi : lo; S[l] = desc ? lo : hi; } } }
#define QMERGE(S, CTRL) { int T_[16]; _Pragma("unroll") for (int i_ = 0; i_ < 16; ++i_) T_[i_] = max(S[i_], dpp_i<CTRL>(S[15 - i_])); \
        _Pragma("unroll") for (int st_ = 8; st_ >= 1; st_ >>= 1) { _Pragma("unroll") for (int i_ = 0; i_ < 16; ++i_) if ((i_ & st_) == 0) { const int hi_ = max(T_[i_], T_[i_ + st_]), lo_ = min(T_[i_], T_[i_ + st_]); T_[i_] = hi_; T_[i_ + st_] = lo_; } } \
        _Pragma("unroll") for (int i_ = 0; i_ < 16; ++i_) S[i_] = T_[i_]; }
__device__ __forceinline__ void topk_phase(const Params& p, unsigned char* lds, int bid, int nblk) {
    int tid = threadIdx.x; asm volatile("" : "+v"(tid));
    const int lane = tid & 63, w = __builtin_amdgcn_readfirstlane(tid >> 6), cc = lane & 15, q4 = lane >> 4;
    constexpr int QT_LD = 264;
    bf16_t* qt = (bf16_t*)lds;
    constexpr int ST_LD = 132;
    float* ST = (float*)(lds + 67584);
    constexpr int LL_LD = 33;
    int* LL = (int*)(lds + 135168);
    const bf16_t* Q = (const bf16_t*)(p.ws + WS_PROJ);
    int* TOPI = (int*)(p.ws + WS_TOPI); float* TOPG = (float*)(p.ws + WS_TOPG);
    const int srow = 16 * w + (lane >> 5), scol = 8 * (lane & 31);
    const int t = tid >> 2, kq = tid & 3;
    int code[13];
    {   int cnt = 0;
#pragma unroll
        for (int c = 0; c < 13; ++c) code[c] = -1;
#pragma unroll
        for (int i = 0; i < 16; ++i)
#pragma unroll
            for (int j = 0; j < 16; ++j)
                if ((i + 1) * (j + 1) <= 16) { code[cnt >> 2] = ((cnt & 3) == kq) ? (i * 16 + j) : code[cnt >> 2]; ++cnt; } }
    int cur_h = -1;
    bf16x8 Ak[2][4];
#pragma unroll
    for (int hf = 0; hf < 2; ++hf)
#pragma unroll
        for (int ks = 0; ks < 4; ++ks) Ak[hf][ks] = (bf16x8){0, 0, 0, 0, 0, 0, 0, 0};
    u32x4 qr[8];
    if (bid < 2048) { const int h0 = bid & 7, t0 = (bid >> 3) * 128; const bf16_t* src = Q + (size_t)(t0 + srow) * D + h0 * 256 + scol;
#pragma unroll
        for (int e = 0; e < 8; ++e) qr[e] = *(const u32x4*)(src + (size_t)(2 * e) * D); }
    for (int it = bid; it < 2048; it += nblk) {
        const int h = it & 7, tok0 = (it >> 3) * 128;
        if (h != cur_h) { cur_h = h;
#pragma unroll
            for (int hf = 0; hf < 2; ++hf) { const bf16_t* kb = (const bf16_t*)(p.ws + (hf ? WS_K2 : WS_K1)) + ((size_t)h * 128 + 16 * w + cc) * 128 + 8 * q4;
#pragma unroll
                for (int ks = 0; ks < 4; ++ks) Ak[hf][ks] = *(const bf16x8*)(kb + 32 * ks); } }
#pragma unroll
        for (int e = 0; e < 8; ++e) *(u32x4*)(qt + (srow + 2 * e) * QT_LD + scol) = qr[e];
        if (it + nblk < 2048) { const int h1 = (it + nblk) & 7, t1 = ((it + nblk) >> 3) * 128; const bf16_t* src = Q + (size_t)(t1 + srow) * D + h1 * 256 + scol;
#pragma unroll
            for (int e = 0; e < 8; ++e) qr[e] = *(const u32x4*)(src + (size_t)(2 * e) * D); }
        __syncthreads();
#pragma unroll
        for (int half = 0; half < 2; ++half) {
            if (half == 1) __syncthreads();
#pragma unroll 2
            for (int n = 0; n < 8; ++n) {
                f32x4 acc = {0.f, 0.f, 0.f, 0.f};
#pragma unroll
                for (int ks = 0; ks < 4; ++ks) { const bf16x8 Bf = *(const bf16x8*)(qt + (16 * n + cc) * QT_LD + half * 128 + 32 * ks + 8 * q4); acc = __builtin_amdgcn_mfma_f32_16x16x32_bf16(Ak[half][ks], Bf, acc, 0, 0, 0); }
#pragma unroll
                for (int r = 0; r < 4; ++r) ST[(16 * w + 4 * q4 + r) * ST_LD + 16 * n + cc] = acc[r];
            }
            __syncthreads();
            int S[16];
            {
                int K2[16];
#pragma unroll
                for (int i = 0; i < 16; ++i) { const int k0 = 16 * (i >> 2) + 4 * kq + (i & 3), k1 = k0 + 64;
                    S[i] = (mono(ST[k0 * ST_LD + t]) & ~127) | (127 - k0); K2[i] = (mono(ST[k1 * ST_LD + t]) & ~127) | (127 - k1); }
                SORT16(S) SORT16(K2)
                MERGE16(S, K2);
            }
            QMERGE(S, DPP_XOR1) QMERGE(S, DPP_XOR2)
            if (kq == 0) {
#pragma unroll
                for (int j = 0; j < 16; ++j) LL[t * LL_LD + half * 16 + j] = S[j]; }
        }
        int S[16];
        {
#pragma unroll
            for (int c = 0; c < 13; ++c) { const int cd = max(code[c], 0); const float f1 = unmono(LL[t * LL_LD + (cd >> 4)] & ~127), f2 = unmono(LL[t * LL_LD + 16 + (cd & 15)] & ~127);
                S[c] = (code[c] >= 0) ? ((mono(f1 + f2) & ~255) | (255 - cd)) : (int)0x80000000; }
            S[13] = (int)0x80000000; S[14] = (int)0x80000000; S[15] = (int)0x80000000;
            SORT16(S)
        }
        QMERGE(S, DPP_XOR1) QMERGE(S, DPP_XOR2)
        {
            int my[4];
#pragma unroll
            for (int m = 0; m < 4; ++m) my[m] = (kq == 0) ? S[m] : (kq == 1) ? S[4 + m] : (kq == 2) ? S[8 + m] : S[12 + m];
            const float mx = unmono(S[0] & ~255);
            f32x4 ev; int idx[4]; float part = 0.f;
#pragma unroll
            for (int m = 0; m < 4; ++m) { const int cd = 255 - (my[m] & 255);
                const int e1 = 127 - (LL[t * LL_LD + (cd >> 4)] & 127), e2 = 127 - (LL[t * LL_LD + 16 + (cd & 15)] & 127);
                idx[m] = e1 * 128 + e2; ev[m] = __expf(unmono(my[m] & ~255) - mx); part += ev[m]; }
            part += dpp_f<DPP_XOR1>(part); part += dpp_f<DPP_XOR2>(part);
            const float inv = 1.0f / part;
            *(int4*)(TOPI + (size_t)(tok0 + t) * 128 + h * 16 + 4 * kq) = make_int4(idx[0], idx[1], idx[2], idx[3]);
            *(f32x4*)(TOPG + (size_t)(tok0 + t) * 128 + h * 16 + 4 * kq) = ev * inv;
        }
    }
}

constexpr size_t WS_PART = WS_PROJ;
constexpr size_t WS_DELTA = WS_HN;
__device__ __forceinline__ int pu_dot_ref(u32x4 qv, u32x4 hv) {
    float d = 0.f;
#pragma unroll
    for (int w = 0; w < 4; ++w)
#pragma unroll
        for (int k = 0; k < 4; ++k) d += sb(qv[w], k) * sb(hv[w], k);
    return (int)d;
}
__device__ __forceinline__ void peer_u_phase(const Params& p, int bid, int nblk) {
    int tid = threadIdx.x; asm volatile("" : "+v"(tid));
    const int lane = tid & 63, wave = __builtin_amdgcn_readfirstlane(tid >> 6), g = lane >> 3, jj = lane & 7;
    const int nx = (nblk % 8 == 0) ? 8 : 1, x = bid % nx, j = bid / nx, J = nblk / nx;
    const unsigned char* UB = p.ws + WS_UB;
    const unsigned char* HN8 = p.ws + WS_HN8; const float* HSC = (const float*)(p.ws + WS_HSC);
    const int* TOPI = (const int*)(p.ws + WS_TOPI); bf16_t* PART = (bf16_t*)(p.ws + WS_PART);
    const bool b2 = (jj & 4) != 0, b1 = (jj & 2) != 0, b0 = (jj & 1) != 0;
    const int tstep = J * 8;
#define PU_IDX(I, t_) { const int tt = min((t_), MLAT - 1); I = *(const int2*)(TOPI + (size_t)tt * 128 + 16 * g + 2 * jj); }
#define PU_Q(Q, H, E, I, t_, s_) { const int tt = min((t_), MLAT - 1); \
        _Pragma("unroll") for (int i = 0; i < 16; ++i) { const unsigned ixi = (unsigned)__shfl((i & 1) ? I.y : I.x, (lane & ~7) | (i >> 1)); Q[i] = *(const u32x4*)(UB + (((unsigned)(s_) * 16384u + ixi) * 128u + 16u * (unsigned)jj)); } \
        H##_d = *(const u32x2*)(HN8 + (size_t)tt * D + 128 * (s_) + 16 * jj + 8 * (g & 1)); H##_s = HSC[tt]; }
#if U_MODE == 1
#define PU_DOT(Qi, H) (__builtin_amdgcn_sdot4((int)Qi[3], (int)H[3], __builtin_amdgcn_sdot4((int)Qi[2], (int)H[2], __builtin_amdgcn_sdot4((int)Qi[1], (int)H[1], __builtin_amdgcn_sdot4((int)Qi[0], (int)H[0], 0, false), false), false), false))
#else
#define PU_DOT(Qi, H) pu_dot_ref(Qi, H)
#endif
#define PU_COMPUTE(Q, H, E, t_, s_) { \
        u32x4 H; { const unsigned ox = (unsigned)dpp_i<DPP_ROR8>((int)H##_d.x), oy = (unsigned)dpp_i<DPP_ROR8>((int)H##_d.y); const bool odd = (g & 1) != 0; \
            H[0] = odd ? ox : H##_d.x; H[1] = odd ? oy : H##_d.y; H[2] = odd ? H##_d.x : ox; H[3] = odd ? H##_d.y : oy; } \
        int acc[16]; \
        _Pragma("unroll") for (int i = 0; i < 16; ++i) acc[i] = PU_DOT(Q[i], H); \
        int r1[8], r2[4], r3[2]; \
        _Pragma("unroll") for (int k = 0; k < 8; ++k) { const int mine = b2 ? acc[8 + k] : acc[k], send = b2 ? acc[k] : acc[8 + k]; r1[k] = mine + dpp_i<DPP_HMIRROR>(send); }        \
        _Pragma("unroll") for (int k = 0; k < 4; ++k) { const int mine = b1 ? r1[4 + k] : r1[k], send = b1 ? r1[k] : r1[4 + k]; r2[k] = mine + dpp_i<DPP_XOR2>(send); } \
        _Pragma("unroll") for (int k = 0; k < 2; ++k) { const int mine = b0 ? r2[2 + k] : r2[k], send = b0 ? r2[k] : r2[2 + k]; r3[k] = mine + dpp_i<DPP_XOR1>(send); } \
        if ((t_) < MLAT) { const float hs = H##_s; const unsigned o = pk2((float)r3[0] * hs, (float)r3[1] * hs); __builtin_nontemporal_store(o, (unsigned*)(PART + ((size_t)(s_) * MLAT + (t_)) * 128 + 16 * g + 2 * jj)); } }
    for (int s = x; s < 16; s += nx) {
        int t0 = j * 8 + wave, t1 = t0 + tstep;
        int2 IA, IB; u32x4 QA[16], QB[16]; u32x2 HA_d, HB_d; float HA_s, HB_s; int2 EA, EB;
        PU_IDX(IA, t0) PU_IDX(IB, t1)
        __builtin_amdgcn_sched_barrier(0);
        PU_Q(QA, HA, EA, IA, t0, s)
        __builtin_amdgcn_sched_barrier(0);
        for (; t0 < MLAT; t0 += 2 * tstep, t1 += 2 * tstep) {
            PU_IDX(IA, t0 + 2 * tstep)
            __builtin_amdgcn_sched_barrier(0);
            PU_Q(QB, HB, EB, IB, t1, s)
            __builtin_amdgcn_sched_barrier(0);
            PU_COMPUTE(QA, HA, EA, t0, s)
            __builtin_amdgcn_sched_barrier(0);
            PU_IDX(IB, t1 + 2 * tstep)
            __builtin_amdgcn_sched_barrier(0);
            PU_Q(QA, HA, EA, IA, t0 + 2 * tstep, s)
            __builtin_amdgcn_sched_barrier(0);
            PU_COMPUTE(QB, HB, EB, t1, s)
            __builtin_amdgcn_sched_barrier(0);
        }
    }
#undef PU_IDX
#undef PU_Q
#undef PU_DOT
#undef PU_COMPUTE
}
__device__ __forceinline__ void peer_w_phase(const Params& p, int bid, int nblk) {
    int tid = threadIdx.x; asm volatile("" : "+v"(tid));
    const bf16_t* PART = (const bf16_t*)(p.ws + WS_PART); const float* TOPG = (const float*)(p.ws + WS_TOPG); const int* TOPI = (const int*)(p.ws + WS_TOPI); const float* USC = (const float*)(p.ws + WS_USC);
    signed char* WQ8 = (signed char*)(p.ws + WS_WQ8); float* SW = (float*)(p.ws + WS_SW);
    for (size_t e = (size_t)bid * 512 + tid; e < (size_t)MLAT * 128; e += (size_t)nblk * 512) {
        float d = 0.f;
#pragma unroll
        for (int s = 0; s < 16; ++s) d += bf1(__builtin_nontemporal_load(PART + (size_t)s * MLAT * 128 + e));
        const f32x2 sc = *(const f32x2*)(USC + 2 * TOPI[e]);
        const float wv = TOPG[e] * gelu_tanh(d * sc.x) * sc.y;
        float am = fabsf(wv);
#pragma unroll
        for (int o = 1; o < 16; o <<= 1) am = fmaxf(am, __shfl_xor(am, o));
        const float inv = (am > 1e-30f) ? 127.0f / am : 0.f;
        WQ8[e] = (signed char)max(-127, min(127, __float2int_rn(wv * inv)));
        if ((tid & 15) == 0) SW[e >> 4] = am * (1.0f / 127.0f);
    }
}
__device__ __forceinline__ void peer_v_phase(const Params& p, int bid, int nblk) {
    int tid = threadIdx.x; asm volatile("" : "+v"(tid));
    const int lane = tid & 63, wave = __builtin_amdgcn_readfirstlane(tid >> 6), g = lane >> 3, jj = lane & 7;
    const int nx = (nblk % 8 == 0) ? 8 : 1, x = bid % nx, j = bid / nx, J = nblk / nx;
    const unsigned char* VB = p.ws + WS_VB; const unsigned char* WQ8 = p.ws + WS_WQ8; const float* SW = (const float*)(p.ws + WS_SW); const int* TOPI = (const int*)(p.ws + WS_TOPI);
    const float* MOD = (const float*)(p.ws + WS_MOD); bf16_t* DELTA = (bf16_t*)(p.ws + WS_DELTA);
    const bool b5 = (g & 4) != 0, b4 = (g & 2) != 0, b3 = (g & 1) != 0;
    const int tl = 8 * jj + g;
    const int tstep = J * 8;
#define PV_IDX(I, t_) { const int tt = min((t_), MLAT - 1); I = *(const int2*)(TOPI + (size_t)tt * 128 + 16 * g + 2 * jj); }
#define PV_SB __builtin_amdgcn_sched_barrier(0);
#define PV_ROWS(Q, I, h_) { _Pragma("unroll") for (int i = 8 * (h_); i < 8 * (h_) + 8; ++i) { const unsigned ixi = (unsigned)__shfl((i & 1) ? I.y : I.x, (lane & ~7) | (i >> 1)); Q[i] = *(const u32x4*)(VB + (((unsigned)s * 16384u + ixi) * 128u + 16u * (unsigned)jj)); } }
#define PV_AUX(W, SWv, X, t_) { const int tt = min((t_), MLAT - 1); W##_d = *(const unsigned*)(WQ8 + (size_t)tt * 128 + 16 * g + 4 * (jj & 3)); SWv = SW[(size_t)tt * 8 + g]; }
#define PV_ACC(Q, W, acc, a0_) { _Pragma("unroll") for (int a4 = (a0_); a4 < (a0_) + 2; ++a4) _Pragma("unroll") for (int w = 0; w < 4; ++w) { \
            const unsigned x0 = Q[4 * a4][w], x1 = Q[4 * a4 + 1][w], x2 = Q[4 * a4 + 2][w], x3 = Q[4 * a4 + 3][w]; \
            const unsigned l01 = __builtin_amdgcn_perm(x1, x0, 0x05010400u), h01 = __builtin_amdgcn_perm(x1, x0, 0x07030602u), l23 = __builtin_amdgcn_perm(x3, x2, 0x05010400u), h23 = __builtin_amdgcn_perm(x3, x2, 0x07030602u); \
            acc[4 * w + 0] = __builtin_amdgcn_sdot4((int)__builtin_amdgcn_perm(l23, l01, 0x05040100u), (int)W[a4], acc[4 * w + 0], false); \
            acc[4 * w + 1] = __builtin_amdgcn_sdot4((int)__builtin_amdgcn_perm(l23, l01, 0x07060302u), (int)W[a4], acc[4 * w + 1], false); \
            acc[4 * w + 2] = __builtin_amdgcn_sdot4((int)__builtin_amdgcn_perm(h23, h01, 0x05040100u), (int)W[a4], acc[4 * w + 2], false); \
            acc[4 * w + 3] = __builtin_amdgcn_sdot4((int)__builtin_amdgcn_perm(h23, h01, 0x07060302u), (int)W[a4], acc[4 * w + 3], false); } }
#define PV_FIN(acc, SWv, X, t_) { \
        f32x2 a[8]; _Pragma("unroll") for (int k = 0; k < 8; ++k) a[k] = (f32x2){(float)acc[2 * k] * SWv, (float)acc[2 * k + 1] * SWv}; \
        f32x2 r1[4], r2[2], r3; \
        _Pragma("unroll") for (int k = 0; k < 4; ++k) { f32x2 lo = a[k], hi = a[4 + k]; swap32(lo, hi); r1[k] = lo + hi; }        \
        _Pragma("unroll") for (int k = 0; k < 2; ++k) { f32x2 lo = r1[k], hi = r1[2 + k]; swap16(lo, hi); r2[k] = lo + hi; }        \
        { const f32x2 mine = b3 ? r2[1] : r2[0], send = b3 ? r2[0] : r2[1]; r3 = (f32x2){mine.x + dpp_f<DPP_ROR8>(send.x), mine.y + dpp_f<DPP_ROR8>(send.y)}; } \
        const f32x2 gt = ((t_) < SEQ) ? gt0 : gt1; \
        const f32x2 r3t = (f32x2){__shfl(r3.x, tl), __shfl(r3.y, tl)};        \
        const f32x2 dl = gt * r3t; \
        if ((t_) < MLAT) __builtin_nontemporal_store(pk2(dl.x, dl.y), (unsigned*)(DELTA + (size_t)(t_) * D + col)); }
#define PV_STEP(Q, W, SWv, X, IX, IY, t_) { \
        PV_IDX(IY, (t_) + 3 * tstep) PV_SB \
        int acc[16]; _Pragma("unroll") for (int d = 0; d < 16; ++d) acc[d] = 0; \
        { u32x4 Wv; Wv[0] = (unsigned)dpp_i<0x00>((int)W##_d); Wv[1] = (unsigned)dpp_i<0x55>((int)W##_d); Wv[2] = 0u; Wv[3] = 0u; PV_ACC(Q, Wv, acc, 0) } PV_SB \
        PV_ROWS(Q, IX, 0) PV_SB \
        { u32x4 Wv; Wv[0] = 0u; Wv[1] = 0u; Wv[2] = (unsigned)dpp_i<0xAA>((int)W##_d); Wv[3] = (unsigned)dpp_i<0xFF>((int)W##_d); PV_ACC(Q, Wv, acc, 2) } \
        PV_FIN(acc, SWv, X, t_) PV_SB \
        PV_AUX(W, SWv, X, (t_) + 2 * tstep) PV_ROWS(Q, IX, 1) PV_SB }
    for (int s = x; s < 16; s += nx) {
        const int col = 128 * s + 2 * lane;
        const f32x2 gt0 = *(const f32x2*)(MOD + 5 * 2048 + col), gt1 = *(const f32x2*)(MOD + 12288 + 5 * 2048 + col);
        int t0 = j * 8 + wave, t1 = t0 + tstep;
        int2 IA, IB; u32x4 QA[16], QB[16]; unsigned WA_d, WB_d; float SA, SB;
        PV_IDX(IA, t0) PV_IDX(IB, t1) PV_SB
        PV_ROWS(QA, IA, 0) PV_AUX(WA, SA, XA, t0) PV_ROWS(QA, IA, 1) PV_SB
        PV_IDX(IA, t0 + 2 * tstep) PV_SB
        PV_ROWS(QB, IB, 0) PV_AUX(WB, SB, XB, t1) PV_ROWS(QB, IB, 1) PV_SB
        for (; t0 < MLAT; t0 += 2 * tstep, t1 += 2 * tstep) {
            PV_STEP(QA, WA, SA, XA, IA, IB, t0)
            PV_STEP(QB, WB, SB, XB, IB, IA, t1)
        }
    }
#undef PV_SB
#undef PV_ROWS
#undef PV_AUX
#undef PV_FIN
#undef PV_STEP
#undef PV_IDX
#undef PV_ACC
#undef PV_COMPUTE
}
__device__ __forceinline__ void final_norm_phase(const Params& p, int bid, int nblk) {
    int tid = threadIdx.x; asm volatile("" : "+v"(tid));
    const int lane = tid & 63, wave = __builtin_amdgcn_readfirstlane(tid >> 6);
    const bf16_t* XL = (const bf16_t*)(p.ws + WS_YL); const bf16_t* DELTA = (const bf16_t*)(p.ws + WS_DELTA);
    f32x4 fgv[8];
#pragma unroll
    for (int jx = 0; jx < 8; ++jx) fgv[jx] = *((const f32x4*)p.fg + lane + 64 * jx);
    for (int row = bid * 8 + wave; row < MLAT; row += nblk * 8) {
        u32x2 xa[8], da[8];
#pragma unroll
        for (int jx = 0; jx < 8; ++jx) { xa[jx] = __builtin_nontemporal_load((const u32x2*)(XL + (size_t)row * D) + lane + 64 * jx); da[jx] = __builtin_nontemporal_load((const u32x2*)(DELTA + (size_t)row * D) + lane + 64 * jx); }
        f32x4 v[8]; float ss = 0.f;
#pragma unroll
        for (int jx = 0; jx < 8; ++jx) { v[jx] = (f32x4){bflo(xa[jx].x) + bflo(da[jx].x), bfhi(xa[jx].x) + bfhi(da[jx].x), bflo(xa[jx].y) + bflo(da[jx].y), bfhi(xa[jx].y) + bfhi(da[jx].y)};
            ss += (v[jx][0] * v[jx][0] + v[jx][1] * v[jx][1]) + (v[jx][2] * v[jx][2] + v[jx][3] * v[jx][3]); }
        const float r2 = rsqrtf(wave_sum(ss) * (1.0f / 2048.0f) + EPS);
        f32x4* xr = (f32x4*)(p.out + (size_t)row * D);
#pragma unroll
        for (int jx = 0; jx < 8; ++jx) __builtin_nontemporal_store(v[jx] * r2 * fgv[jx], xr + lane + 64 * jx);
    }
}

#define XB_TMO      128
#define XB_XCNT(j)  (256  + 64 * (j))
#define XB_XSUB(j)  (1280 + 64 * (j))
#define XB_XGEN(j)  (2304 + 64 * (j))
#define XB_TOP      3328
#define XB_TOPGEN   3392
#define XCD_BAR_WORDS 3456
#define XB_SPIN_CAP (1u << 20)
__device__ __forceinline__ unsigned xb_ld(unsigned* p)              { return __hip_atomic_load(p, __ATOMIC_RELAXED, __HIP_MEMORY_SCOPE_AGENT); }
__device__ __forceinline__ unsigned xb_add(unsigned* p, unsigned v) { return __hip_atomic_fetch_add(p, v, __ATOMIC_RELAXED, __HIP_MEMORY_SCOPE_AGENT); }
__device__ __forceinline__ unsigned xb_xcc_id() { return (unsigned)__builtin_amdgcn_s_getreg((3 << 11) | 20) & 0xFu; }
#define XB_SPIN(cond, bar) do { unsigned _sp = 0; while (cond) { __builtin_amdgcn_s_sleep(1); \
    if ((++_sp & 255u) == 0u) { if (xb_ld(&(bar)[XB_TMO])) break; if (_sp > XB_SPIN_CAP) { atomicAdd(&(bar)[XB_TMO], 1u); break; } } } } while (0)
struct XcdBarrier { unsigned* bar; unsigned x; volatile LAS unsigned* st; };
__device__ __forceinline__ XcdBarrier xcd_barrier_post(unsigned* bar, volatile LAS unsigned* st) {
    XcdBarrier b; b.bar = bar; b.x = xb_xcc_id(); b.st = st;
    if (threadIdx.x == 0) (void)xb_add(&bar[XB_XCNT(b.x)], 1u);
    return b;
}
__device__ __forceinline__ void xcd_barrier_complete(unsigned* bar, unsigned x, unsigned& nloc, unsigned& nx) {
    const unsigned G = gridDim.x * gridDim.y * gridDim.z;
    unsigned sum, cnt, mine, sp = 0u;
    for (;;) {
        sum = 0u; cnt = 0u; mine = 0u;
#pragma unroll
        for (unsigned j = 0; j < 16; ++j) { const unsigned c = xb_ld(&bar[XB_XCNT(j)]); sum += c; cnt += (c > 0u) ? 1u : 0u; mine = (j == x) ? c : mine; }
        if (sum == G) break;
        __builtin_amdgcn_s_sleep(1);
        if ((++sp & 255u) == 0u) { if (xb_ld(&bar[XB_TMO])) break; if (sp > XB_SPIN_CAP) { atomicAdd(&bar[XB_TMO], 1u); break; } }
    }
    nloc = mine > 0u ? mine : 1u; nx = cnt > 0u ? cnt : 1u;
}
__device__ __forceinline__ void xcd_barrier(const XcdBarrier& b) {
    asm volatile("s_waitcnt vmcnt(0)" ::: "memory");
    __syncthreads();
    if (threadIdx.x == 0) {
        unsigned* bar = b.bar;
        __builtin_amdgcn_s_waitcnt(0);
        unsigned nloc = b.st[0], nx = b.st[1];
        if (nloc == 0u) { xcd_barrier_complete(bar, b.x, nloc, nx); b.st[0] = nloc; b.st[1] = nx; }
        const unsigned old = xb_add(&bar[XB_XSUB(b.x)], 1u);
        const unsigned gen = old / nloc;
        if (old + 1u == (gen + 1u) * nloc) {
            __builtin_amdgcn_fence(__ATOMIC_RELEASE, "agent");
            asm volatile("s_waitcnt vmcnt(0)" ::: "memory");
            const unsigned og = xb_add(&bar[XB_TOP], 1u);
            const unsigned tg = og / nx;
            if (og + 1u == (tg + 1u) * nx) xb_add(&bar[XB_TOPGEN], 1u);
            else XB_SPIN(xb_ld(&bar[XB_TOPGEN]) == tg, bar);
            __builtin_amdgcn_fence(__ATOMIC_ACQUIRE, "agent");
            xb_add(&bar[XB_XGEN(b.x)], 1u);
            asm volatile("s_waitcnt vmcnt(0)" ::: "memory");
        } else {
            XB_SPIN(xb_ld(&bar[XB_XGEN(b.x)]) == gen, bar);
            __builtin_amdgcn_fence(__ATOMIC_ACQUIRE, "agent");
            asm volatile("s_waitcnt vmcnt(0)" ::: "memory");
        }
    }
    __syncthreads();
}

__global__ void __launch_bounds__(512, 2) k_main(Params p, int ph_lo, int ph_hi) {
    extern __shared__ __attribute__((aligned(16))) unsigned char lds[];
    const int bid = blockIdx.x, nblk = gridDim.x;
#if FUSED
    cg::grid_group grid = cg::this_grid();
    volatile LAS unsigned* bst = (volatile LAS unsigned*)((LAS unsigned char*)lds + (LDS_BYTES - 64));
    if (threadIdx.x < 2) bst[threadIdx.x] = 0u;
    __syncthreads();
    const XcdBarrier xbar = xcd_barrier_post((unsigned*)(p.ws + WS_CTL), bst);
#define SYNC_AFTER(k) if ((k) + 1 < ph_hi) { if (ph_lo < 0) grid.sync(); else xcd_barrier(xbar); }
#else
#define SYNC_AFTER(k)
#endif
#define IN(k) (ph_lo <= (k) && (k) < ph_hi)
    if (IN(0)) { phase0(p, lds, bid, nblk); SYNC_AFTER(0) }
    if (IN(1)) { phase_norm1(p, lds, bid, nblk); SYNC_AFTER(1) }
#if !G1_I8
    if (IN(2)) { pg8::Gemm g{(const bf16_t*)(p.ws + WS_HN), (const bf16_t*)(p.ws + WS_WIN), MALL, INW, D, 1, 0, 0}; pg8::StaticOrder S; S.init(MALL, INW, nblk, bid);
                 pg8::EpiBf16 E{(bf16_t*)(p.ws + WS_PROJ), INW}; pg8::gemm_phase<pg8::EpiBf16>((LAS unsigned char*)lds, g, S, E); SYNC_AFTER(2) }
#else
    if (IN(2)) { pg8::Gemm g{(const bf16_t*)(p.ws + WS_HN), (const bf16_t*)(p.ws + WS_WIN3), MALL, INW, D / 2, 64, 2, (size_t)4096 * 2048}; pg8::StaticOrder S; S.init(CTX_SPLIT ? MLAT : MALL, INW, nblk, bid);
                 pg8::EpiI8BiasBf16 E{(bf16_t*)(p.ws + WS_PROJ), INW, (const float*)(p.ws + WS_RS1), (const float*)(p.ws + WS_CS1), (const float*)(p.ws + WS_BIAS1)}; pg8::gemm_phase<pg8::EpiI8BiasBf16>((LAS unsigned char*)lds, g, S, E); SYNC_AFTER(2) }
#endif
    if (IN(3)) {
#if G1_I8 && CTX_SPLIT
        if (bid < 8) { pg8::Gemm g{(const bf16_t*)(p.ws + WS_HN), (const bf16_t*)(p.ws + WS_WIN3), MALL, INW, D / 2, 64, 2, (size_t)4096 * 2048}; pg8::StaticOrder S; S.init(MALL, INW, nblk, bid); S.fpm = 128 + (bid >> 2); S.fpn = bid & 3;
            pg8::EpiI8BiasBf16 E{(bf16_t*)(p.ws + WS_PROJ), INW, (const float*)(p.ws + WS_RS1), (const float*)(p.ws + WS_CS1), (const float*)(p.ws + WS_BIAS1)}; pg8::gemm_phase<pg8::EpiI8BiasBf16>((LAS unsigned char*)lds, g, S, E);
            asm volatile("s_waitcnt vmcnt(0)" ::: "memory");
            __syncthreads();
            if (threadIdx.x == 0) { __builtin_amdgcn_fence(__ATOMIC_RELEASE, "agent"); asm volatile("s_waitcnt vmcnt(0)" ::: "memory"); (void)xb_add((unsigned*)(p.ws + WS_CTL + CTXDONE_OFS), 1u); }
            __syncthreads(); }
#endif
        lru_phase<false>(p, lds, bid, nblk); SYNC_AFTER(3) }
    if (IN(4)) { carry_phase(p, bid, nblk); sgu_phase(p, lds, bid, nblk); SYNC_AFTER(4) }
    if (IN(5)) { lru_phase<true>(p, lds, bid, nblk); SYNC_AFTER(5) }
    if (IN(6)) { pg8::Gemm g{(const bf16_t*)(p.ws + WS_HN), (const bf16_t*)(p.ws + WS_WOUT), MLAT, D, D, 1, 0, 0}; pg8::StaticOrder S; S.init(MLAT, D, nblk, bid);
                 pg8::EpiXlatBf16 E{(bf16_t*)(p.ws + WS_YL), D, (const float*)(p.ws + WS_MOD) + 2 * 2048, 12288, SEQ, p.x}; pg8::gemm_phase<pg8::EpiXlatBf16>((LAS unsigned char*)lds, g, S, E); SYNC_AFTER(6) }
    if (IN(7)) { phase_norm2(p, bid, nblk); SYNC_AFTER(7) }
#if G3_I8
    if (IN(8)) { pg8::Gemm g{(const bf16_t*)(p.ws + WS_HN8), (const bf16_t*)(p.ws + WS_WQ), MLAT, D, D / 2, 1, 0, 0}; pg8::StaticOrder S; S.init(MLAT, D, nblk, bid);
                 pg8::EpiI8Bf16 E{(bf16_t*)(p.ws + WS_PROJ), D, (const float*)(p.ws + WS_HSC), (const unsigned*)(p.ws + WS_COLMAX_Q)}; pg8::gemm_phase<pg8::EpiI8Bf16>((LAS unsigned char*)lds, g, S, E); SYNC_AFTER(8) }
#else
    if (IN(8)) { pg8::Gemm g{(const bf16_t*)(p.ws + WS_HN), (const bf16_t*)(p.ws + WS_WQ), MLAT, D, D, 1, 0, 0}; pg8::StaticOrder S; S.init(MLAT, D, nblk, bid);
                 pg8::EpiBf16 E{(bf16_t*)(p.ws + WS_PROJ), D}; pg8::gemm_phase<pg8::EpiBf16>((LAS unsigned char*)lds, g, S, E); SYNC_AFTER(8) }
#endif
    if (IN(9)) { topk_phase(p, lds, bid, nblk); SYNC_AFTER(9) }
    if (IN(10)) { peer_u_phase(p, bid, nblk); SYNC_AFTER(10) }
    if (IN(11)) { peer_w_phase(p, bid, nblk); SYNC_AFTER(11) }
    if (IN(12)) { peer_v_phase(p, bid, nblk); SYNC_AFTER(12) }
    if (IN(13)) { final_norm_phase(p, bid, nblk); }
#undef IN
}

extern "C" void kernel_launch(void* const* d_in, const int* in_sizes, int n_in, void* d_out, int out_size, void* d_ws, size_t ws_size, hipStream_t stream) {
    static int grid = 0;
    if (grid == 0) {
        if (n_in != 25 || out_size != MLAT * D || ws_size < WS_END) { fprintf(stderr, "kernel_launch: unexpected shapes (n_in %d out %d ws %zu)\n", n_in, out_size, ws_size); grid = -1; return; }
        int dev = 0, cus = 0, per_cu = 0;
        hipGetDevice(&dev); hipDeviceGetAttribute(&cus, hipDeviceAttributeMultiprocessorCount, dev);
        if (hipFuncSetAttribute((const void*)k_main, hipFuncAttributeMaxDynamicSharedMemorySize, LDS_BYTES) != hipSuccess) { fprintf(stderr, "kernel_launch: hipFuncSetAttribute failed\n"); grid = -1; return; }
        hipOccupancyMaxActiveBlocksPerMultiprocessor(&per_cu, (const void*)k_main, 512, LDS_BYTES);
        if (per_cu < 1) { fprintf(stderr, "kernel_launch: occupancy query says %d blocks per CU\n", per_cu); per_cu = 1; }
        (void)hipGetLastError();
        grid = cus * 1;
    }
    if (grid < 0) return;
    Params p{};
    const float** pp = (const float**)&p;
    for (int i = 0; i < 25; ++i) pp[i] = (const float*)d_in[i];
    p.out = (float*)d_out; p.ws = (unsigned char*)d_ws;
#if FUSED
    hipMemsetAsync((char*)d_ws + WS_CTL, 0, 131072, stream);
    int lo = 0, hi = NPHASES;
    void* args[] = {&p, &lo, &hi};
    hipError_t e = hipLaunchCooperativeKernel((const void*)k_main, dim3(grid), dim3(512), args, LDS_BYTES, stream);
    if (e != hipSuccess) fprintf(stderr, "cooperative launch failed: %s (grid %d)\n", hipGetErrorString(e), grid);
#else
    for (int ph = 0; ph < NPHASES; ++ph) hipLaunchKernelGGL(k_main, dim3(grid), dim3(512), LDS_BYTES, stream, p, ph, ph + 1);
#endif
}
```

```cpp
#include <hip/hip_runtime.h>
#include <hip/hip_cooperative_groups.h>
#include <cstdio>
#include <cstdint>

#ifndef G3_I8
#define G3_I8 1
#endif
#ifndef G1_I8
#define G1_I8 1
#endif
#ifndef U_MODE
#define U_MODE 1
#endif
#ifndef V_MODE
#define V_MODE 1
#endif
#ifndef FUSED
#define FUSED 1
#endif
#ifndef CTX_SPLIT
#define CTX_SPLIT 1
#endif
#define CTXDONE_OFS 45568

namespace cg = cooperative_groups;

typedef unsigned short bf16_t;
typedef short bf16x8 __attribute__((ext_vector_type(8)));
typedef float f32x4 __attribute__((ext_vector_type(4)));
typedef float f32x2 __attribute__((ext_vector_type(2)));
typedef unsigned u32x4 __attribute__((ext_vector_type(4)));
typedef unsigned u32x2 __attribute__((ext_vector_type(2)));
typedef int i32x4 __attribute__((ext_vector_type(4)));
typedef __bf16 bf16x2_t __attribute__((ext_vector_type(2)));
#define LAS __attribute__((address_space(3)))

constexpr int D = 2048, SEQ = 16384, CTXL = 256;
constexpr int MLAT = 2 * SEQ, MCTX = 2 * CTXL, MALL = MLAT + MCTX;
constexpr int INW = 4096;
constexpr int NSEG = 130;
constexpr float EPS = 1e-6f;

constexpr size_t MiB = 1u << 20;
constexpr size_t WS_CTL = 0;
constexpr size_t WS_MOD = 1 * MiB;
constexpr size_t WS_SP = 1 * MiB + 512 * 1024;
constexpr size_t WS_USC = 2 * MiB;
constexpr size_t WS_WIN = 4 * MiB;
constexpr size_t WS_WOUT = 20 * MiB;
constexpr size_t WS_WQ = 28 * MiB;
constexpr size_t WS_SGUW = 36 * MiB;
constexpr size_t WS_K1 = 36 * MiB + 256 * 1024;
constexpr size_t WS_K2 = 36 * MiB + 512 * 1024;
constexpr size_t WS_LRUW = 37 * MiB;
constexpr size_t WS_SUMS = 38 * MiB;
constexpr size_t WS_UB = 44 * MiB;
constexpr size_t WS_VB = 108 * MiB;
constexpr size_t WS_HN = 172 * MiB;
constexpr size_t WS_PROJ = 302 * MiB;
constexpr size_t WS_TOPI = 562 * MiB;
constexpr size_t WS_TOPG = 578 * MiB;
constexpr size_t WS_COLMAX_IN = 65536;
constexpr size_t WS_COLMAX_Q = 65536 + 16384;
constexpr size_t WS_RS1 = 600 * MiB + 262144;
constexpr size_t WS_HSC = 600 * MiB;
constexpr size_t WS_SW = 601 * MiB;
constexpr size_t WS_WQ8 = 602 * MiB;
constexpr size_t WS_HN8 = 608 * MiB;
constexpr size_t WS_WIN3 = 672 * MiB;
constexpr size_t WS_CS1 = 600 * MiB + 524288;
constexpr size_t WS_BIAS1 = 600 * MiB + 589824;
constexpr size_t WS_YL = 696 * MiB;
constexpr size_t WS_END = 824 * MiB;

constexpr int LDS_BYTES = 159744;
constexpr int NPHASES = 14;

struct Params {
    const float *x, *c, *ctx, *c_ctx, *w_mod, *b_mod, *g1, *g2, *w_in, *conv_w, *conv_b, *lru_wa, *lru_ba, *lru_wx, *lru_bx, *lru_lam,
        *sgu_w, *sgu_b, *w_out, *wq, *k1, *k2, *pu, *pv, *fg;
    float* out;
    unsigned char* ws;
};

__device__ __forceinline__ unsigned f2bf(float f) { unsigned u = __builtin_bit_cast(unsigned, f); return (u + 0x7fffu + ((u >> 16) & 1u)) >> 16; }
__device__ __forceinline__ unsigned pk2(float lo, float hi) { return f2bf(lo) | (f2bf(hi) << 16); }
__device__ __forceinline__ float bflo(unsigned u) { return __builtin_bit_cast(float, u << 16); }
__device__ __forceinline__ float bfhi(unsigned u) { return __builtin_bit_cast(float, u & 0xffff0000u); }
__device__ __forceinline__ float bf1(bf16_t u) { return __builtin_bit_cast(float, (unsigned)u << 16); }
__device__ __forceinline__ float sigmoidf_(float x) { return __builtin_amdgcn_rcpf(1.0f + __expf(-x)); }
__device__ __forceinline__ float gelu_tanh(float x) {
    const float t = x * x; const float q = x * fmaf(t, -0.1029432395800235f, -2.302208198144325f);
    return x * __builtin_amdgcn_rcpf(1.0f + __builtin_amdgcn_exp2f(q));
}
template <int CTRL> __device__ __forceinline__ int dpp_i(int v) { return __builtin_amdgcn_update_dpp(0, v, CTRL, 0xf, 0xf, true); }
template <int CTRL> __device__ __forceinline__ float dpp_f(float v) { return __builtin_bit_cast(float, __builtin_amdgcn_update_dpp(0, __builtin_bit_cast(int, v), CTRL, 0xf, 0xf, true)); }
constexpr int DPP_XOR1 = 0xB1, DPP_XOR2 = 0x4E, DPP_HMIRROR = 0x141, DPP_MIRROR = 0x140, DPP_ROR8 = 0x128;
__device__ __forceinline__ void swap16(float& a, float& b) { asm("s_nop 1\n\tv_permlane16_swap_b32 %0, %1" : "+v"(a), "+v"(b)); }
__device__ __forceinline__ void swap32(float& a, float& b) { asm("s_nop 1\n\tv_permlane32_swap_b32 %0, %1" : "+v"(a), "+v"(b)); }
__device__ __forceinline__ void swap16(f32x2& a, f32x2& b) { float ax = a.x, ay = a.y, bx = b.x, by = b.y; swap16(ax, bx); swap16(ay, by); a = (f32x2){ax, ay}; b = (f32x2){bx, by}; }
__device__ __forceinline__ void swap32(f32x2& a, f32x2& b) { float ax = a.x, ay = a.y, bx = b.x, by = b.y; swap32(ax, bx); swap32(ay, by); a = (f32x2){ax, ay}; b = (f32x2){bx, by}; }
__device__ __forceinline__ float wave_sum(float v) {
    v += dpp_f<DPP_XOR1>(v); v += dpp_f<DPP_XOR2>(v); v += dpp_f<DPP_HMIRROR>(v); v += dpp_f<DPP_MIRROR>(v);
    { float a = v, b = v; swap16(a, b); v = a + b; }
    { float a = v, b = v; swap32(a, b); v = a + b; }
    return v;
}
__device__ __forceinline__ unsigned q8pack(f32x4 x) {
    const int a = max(-127, min(127, __float2int_rn(x[0]))), b = max(-127, min(127, __float2int_rn(x[1]))), c = max(-127, min(127, __float2int_rn(x[2]))), d = max(-127, min(127, __float2int_rn(x[3])));
    return (unsigned)(a & 255) | ((unsigned)(b & 255) << 8) | ((unsigned)(c & 255) << 16) | ((unsigned)(d & 255) << 24);
}
__device__ __forceinline__ float sb(unsigned w, int k) { return (float)(signed char)((w >> (8 * k)) & 255u); }
__device__ __forceinline__ int mono(float v) { int b = __builtin_bit_cast(int, v); return b ^ ((b >> 31) & 0x7fffffff); }
__device__ __forceinline__ float unmono(int m) { int b = m ^ ((m >> 31) & 0x7fffffff); return __builtin_bit_cast(float, b); }

namespace pg8 {
constexpr int BM = 256, BK = 64, HALF = 128, HTB = HALF * BK * 2, STAGE_BYTES = 8 * HTB, NXCD = 8, WGM = 8;
__host__ __device__ __forceinline__ int lds_byte(int r, int c) { const int st = (r >> 4) * 2 + (c >> 5), rr = r & 15, cc = c & 31, ob = rr * 64 + cc * 2; return st * 1024 + (ob ^ (((ob >> 9) & 1) << 5)); }
__host__ __device__ __forceinline__ void stage_rc(int b, int& R, int& C) { const int st = b / 1024, sb = b % 1024, swz = sb ^ (((sb >> 9) & 1) << 5); R = (st >> 1) * 16 + swz / 64; C = (st & 1) * 32 + (swz % 64) / 2; }
__host__ __device__ __forceinline__ int perm32(int rho) { const int n = rho >> 4, i = rho & 15; return 8 * (i >> 2) + 4 * n + (i & 3); }
struct Unit { int pm, pn; };
struct Gemm { const bf16_t* A; const bf16_t* Bt; int M, N, K; int bt_tiles; int bt_max; size_t bt_stride;
    __device__ __forceinline__ size_t bsel(int pm) const { return bt_stride ? (size_t)((pm / bt_tiles) < bt_max ? (pm / bt_tiles) : bt_max) * bt_stride : (size_t)0; } };
struct StaticOrder {
    int nM, nN, nwg, G, c; int fpm = -1, fpn = 0;
    __host__ __device__ void init(int M, int N, int G_, int c_) { nM = M / BM; nN = N / BM; nwg = nM * nN; G = G_; c = c_; }
    __host__ __device__ bool next(int i, Unit& u) const {
        if (fpm >= 0) { if (i > 0) return false; u.pm = fpm; u.pn = fpn; return true; }
        const long L = (long)i * G + c; if (L >= nwg) return false;
        int wgid = (int)L; { const int q = nwg / NXCD, r = nwg % NXCD, xcd = wgid % NXCD, off = wgid / NXCD; wgid = (xcd < r ? xcd * (q + 1) : r * (q + 1) + (xcd - r) * q) + off; }
        const int nig = WGM * nN, gid = wgid / nig, fm = gid * WGM, gsz = (nM - fm) < WGM ? (nM - fm) : WGM;
        u.pm = fm + ((wgid % nig) % gsz); u.pn = (wgid % nig) / gsz; return true;
    }
};
__device__ __forceinline__ unsigned cvt_pk_bf16(float lo, float hi) { unsigned r; asm volatile("v_cvt_pk_bf16_f32 %0, %1, %2" : "=v"(r) : "v"(lo), "v"(hi)); return r; }

__device__ __forceinline__ u32x4 epi_tr(u32x4 w, int src4) { u32x4 r; r.x = (unsigned)__builtin_amdgcn_ds_bpermute(src4, (int)w.x); r.y = (unsigned)__builtin_amdgcn_ds_bpermute(src4, (int)w.y); r.z = (unsigned)__builtin_amdgcn_ds_bpermute(src4, (int)w.z); r.w = (unsigned)__builtin_amdgcn_ds_bpermute(src4, (int)w.w); return r; }
#define EPI_TR_SETUP const int lane_ = fq * 16 + fr, fr2 = lane_ >> 2, fq2 = lane_ & 3, src4 = 4 * (fq2 * 16 + fr2); const long trofs = (long)(fr2 - fr) * ldc + 8 * (fq2 - fq);
struct EpiI8Bf16 {
    static constexpr bool PERM = true, I8 = true; typedef i32x4 acc_t;
    bf16_t* O; int ldc; const float* rs; const unsigned* cmax;
    __device__ __forceinline__ void operator()(const i32x4 (&acc)[2][2][4][2], const Unit& u, int wr, int wc, int fr, int fq) const {
        const int row0 = u.pm * BM + wr * 64 + fr; const int col0 = u.pn * BM + wc * 32 + 8 * fq;
        EPI_TR_SETUP
        f32x4 cs[2][2];
#pragma unroll
        for (int bj = 0; bj < 2; ++bj)
#pragma unroll
            for (int n = 0; n < 2; ++n) { const u32x4 cm = *(const u32x4*)(cmax + col0 + bj * HALF + 4 * n);
                cs[bj][n] = (f32x4){__builtin_bit_cast(float, cm[0]), __builtin_bit_cast(float, cm[1]), __builtin_bit_cast(float, cm[2]), __builtin_bit_cast(float, cm[3])} * (1.0f / 127.0f); }
#pragma unroll
        for (int ai = 0; ai < 2; ++ai)
#pragma unroll
            for (int m = 0; m < 4; ++m) { const int row = row0 + ai * HALF + m * 16; const float rsv = rs[row]; bf16_t* rowp = O + (size_t)row * ldc + col0;
#pragma unroll
                for (int bj = 0; bj < 2; ++bj) { const i32x4 a0 = acc[ai][bj][m][0], a1 = acc[ai][bj][m][1];
                    const f32x4 v0 = (f32x4){(float)a0[0], (float)a0[1], (float)a0[2], (float)a0[3]} * cs[bj][0] * rsv, v1 = (f32x4){(float)a1[0], (float)a1[1], (float)a1[2], (float)a1[3]} * cs[bj][1] * rsv;
                    u32x4 w; w.x = cvt_pk_bf16(v0[0], v0[1]); w.y = cvt_pk_bf16(v0[2], v0[3]); w.z = cvt_pk_bf16(v1[0], v1[1]); w.w = cvt_pk_bf16(v1[2], v1[3]);
                    *(u32x4*)(rowp + trofs + bj * HALF) = epi_tr(w, src4); } }
    }
};
struct EpiI8BiasBf16 {
    static constexpr bool PERM = true, I8 = true; typedef i32x4 acc_t;
    bf16_t* O; int ldc; const float* rs; const float* cs; const float* bias;
    __device__ __forceinline__ void operator()(const i32x4 (&acc)[2][2][4][2], const Unit& u, int wr, int wc, int fr, int fq) const {
        const int row0 = u.pm * BM + wr * 64 + fr; const int col0 = u.pn * BM + wc * 32 + 8 * fq; const int v = (u.pm / 64) < 2 ? (u.pm / 64) : 2;
        EPI_TR_SETUP
        f32x4 csv[2][2], bv[2][2];
#pragma unroll
        for (int bj = 0; bj < 2; ++bj)
#pragma unroll
            for (int n = 0; n < 2; ++n) { csv[bj][n] = *(const f32x4*)(cs + v * 4096 + col0 + bj * HALF + 4 * n); bv[bj][n] = *(const f32x4*)(bias + v * 4096 + col0 + bj * HALF + 4 * n); }
#pragma unroll
        for (int ai = 0; ai < 2; ++ai)
#pragma unroll
            for (int m = 0; m < 4; ++m) { const int row = row0 + ai * HALF + m * 16; const float rsv = rs[row]; bf16_t* rowp = O + (size_t)row * ldc + col0;
#pragma unroll
                for (int bj = 0; bj < 2; ++bj) { const i32x4 a0 = acc[ai][bj][m][0], a1 = acc[ai][bj][m][1];
                    const f32x4 v0 = (f32x4){(float)a0[0], (float)a0[1], (float)a0[2], (float)a0[3]} * csv[bj][0] * rsv + bv[bj][0], v1 = (f32x4){(float)a1[0], (float)a1[1], (float)a1[2], (float)a1[3]} * csv[bj][1] * rsv + bv[bj][1];
                    u32x4 w; w.x = cvt_pk_bf16(v0[0], v0[1]); w.y = cvt_pk_bf16(v0[2], v0[3]); w.z = cvt_pk_bf16(v1[0], v1[1]); w.w = cvt_pk_bf16(v1[2], v1[3]);
                    *(u32x4*)(rowp + trofs + bj * HALF) = epi_tr(w, src4); } }
    }
};
struct EpiBf16 {
    static constexpr bool PERM = true, I8 = false; typedef f32x4 acc_t;
    bf16_t* O; int ldc;
    __device__ __forceinline__ void operator()(const f32x4 (&acc)[2][2][4][2], const Unit& u, int wr, int wc, int fr, int fq) const {
        const int row0 = u.pm * BM + wr * 64 + fr; const int col0 = u.pn * BM + wc * 32 + 8 * fq;
#pragma unroll
        for (int ai = 0; ai < 2; ++ai)
#pragma unroll
            for (int m = 0; m < 4; ++m) { bf16_t* rowp = O + (size_t)(row0 + ai * HALF + m * 16) * ldc + col0;
#pragma unroll
                for (int bj = 0; bj < 2; ++bj) { const f32x4 v0 = acc[ai][bj][m][0], v1 = acc[ai][bj][m][1];
                    u32x4 w; w.x = cvt_pk_bf16(v0[0], v0[1]); w.y = cvt_pk_bf16(v0[2], v0[3]); w.z = cvt_pk_bf16(v1[0], v1[1]); w.w = cvt_pk_bf16(v1[2], v1[3]);
                    *(u32x4*)(rowp + bj * HALF) = w; } }
    }
};
struct EpiGateBf16 {
    static constexpr bool PERM = true, I8 = false; typedef f32x4 acc_t;
    bf16_t* O; int ldc; const float* gate; int gate_stride; int rows_per_batch;
    __device__ __forceinline__ void operator()(const f32x4 (&acc)[2][2][4][2], const Unit& u, int wr, int wc, int fr, int fq) const {
        const int row0 = u.pm * BM + wr * 64 + fr; const int col0 = u.pn * BM + wc * 32 + 8 * fq;
        EPI_TR_SETUP
        const int bsel = (u.pm * BM) / rows_per_batch;
        f32x4 gv[2][2];
#pragma unroll
        for (int bj = 0; bj < 2; ++bj)
#pragma unroll
            for (int n = 0; n < 2; ++n) gv[bj][n] = *(const f32x4*)(gate + (size_t)bsel * gate_stride + col0 + bj * HALF + 4 * n);
#pragma unroll
        for (int ai = 0; ai < 2; ++ai)
#pragma unroll
            for (int m = 0; m < 4; ++m) { bf16_t* rowp = O + (size_t)(row0 + ai * HALF + m * 16) * ldc + col0;
#pragma unroll
                for (int bj = 0; bj < 2; ++bj) { const f32x4 v0 = acc[ai][bj][m][0] * gv[bj][0], v1 = acc[ai][bj][m][1] * gv[bj][1];
                    u32x4 w; w.x = cvt_pk_bf16(v0[0], v0[1]); w.y = cvt_pk_bf16(v0[2], v0[3]); w.z = cvt_pk_bf16(v1[0], v1[1]); w.w = cvt_pk_bf16(v1[2], v1[3]);
                    *(u32x4*)(rowp + trofs + bj * HALF) = epi_tr(w, src4); } }
    }
};
struct EpiXlatBf16 {
    static constexpr bool PERM = true, I8 = false; typedef f32x4 acc_t;
    bf16_t* O; int ldc; const float* gate; int gate_stride; int rows_per_batch; const float* base;
    __device__ __forceinline__ void operator()(const f32x4 (&acc)[2][2][4][2], const Unit& u, int wr, int wc, int fr, int fq) const {
        const int row0 = u.pm * BM + wr * 64 + fr; const int col0 = u.pn * BM + wc * 32 + 8 * fq;
        EPI_TR_SETUP
        const int bsel = (u.pm * BM) / rows_per_batch;
        f32x4 gv[2][2];
#pragma unroll
        for (int bj = 0; bj < 2; ++bj)
#pragma unroll
            for (int n = 0; n < 2; ++n) gv[bj][n] = *(const f32x4*)(gate + (size_t)bsel * gate_stride + col0 + bj * HALF + 4 * n);
#pragma unroll
        for (int ai = 0; ai < 2; ++ai)
#pragma unroll
            for (int m = 0; m < 4; ++m) { const size_t off = (size_t)(row0 + ai * HALF + m * 16) * ldc + col0 + trofs;
#pragma unroll
                for (int bj = 0; bj < 2; ++bj) { const f32x4 b0 = *(const f32x4*)(base + off + bj * HALF), b1 = *(const f32x4*)(base + off + bj * HALF + 4);
                    const f32x4 v0 = acc[ai][bj][m][0] * gv[bj][0], v1 = acc[ai][bj][m][1] * gv[bj][1];
                    u32x4 w; w.x = cvt_pk_bf16(v0[0], v0[1]); w.y = cvt_pk_bf16(v0[2], v0[3]); w.z = cvt_pk_bf16(v1[0], v1[1]); w.w = cvt_pk_bf16(v1[2], v1[3]);
                    const u32x4 t = epi_tr(w, src4);
                    u32x4 o; o.x = cvt_pk_bf16(b0[0] + bflo(t.x), b0[1] + bfhi(t.x)); o.y = cvt_pk_bf16(b0[2] + bflo(t.y), b0[3] + bfhi(t.y)); o.z = cvt_pk_bf16(b1[0] + bflo(t.z), b1[1] + bfhi(t.z)); o.w = cvt_pk_bf16(b1[2] + bflo(t.w), b1[3] + bfhi(t.w));
                    *(u32x4*)(O + off + bj * HALF) = o; } }
    }
};
struct EpiRes {
    static constexpr bool PERM = false, I8 = false; typedef f32x4 acc_t;
    const float* base; float* out; int ldc; const float* gate; int gate_stride; int rows_per_batch;
    __device__ __forceinline__ void operator()(const f32x4 (&acc)[2][2][4][2], const Unit& u, int wr, int wc, int fr, int fq) const {
        const int col0 = u.pn * BM + wc * 32 + 4 * fq;
        const int bsel = (u.pm * BM) / rows_per_batch;
        f32x4 gv[2][2];
#pragma unroll
        for (int bj = 0; bj < 2; ++bj)
#pragma unroll
            for (int n = 0; n < 2; ++n) gv[bj][n] = *(const f32x4*)(gate + (size_t)bsel * gate_stride + col0 + bj * HALF + n * 16);
#pragma unroll
        for (int ai = 0; ai < 2; ++ai)
#pragma unroll
            for (int m = 0; m < 4; ++m) { const size_t off = (size_t)(u.pm * BM + ai * HALF + wr * 64 + m * 16 + fr) * ldc + col0;
#pragma unroll
                for (int bj = 0; bj < 2; ++bj)
#pragma unroll
                    for (int n = 0; n < 2; ++n) { const f32x4 bs = *(const f32x4*)(base + off + bj * HALF + n * 16);
                        *(f32x4*)(out + off + bj * HALF + n * 16) = bs + gv[bj][n] * acc[ai][bj][m][n]; } }
    }
};

__device__ __forceinline__ f32x4 mma_any(bf16x8 b, bf16x8 a, f32x4 c) { return __builtin_amdgcn_mfma_f32_16x16x32_bf16(b, a, c, 0, 0, 0); }
__device__ __forceinline__ i32x4 mma_any(bf16x8 b, bf16x8 a, i32x4 c) { return __builtin_amdgcn_mfma_i32_16x16x64_i8(__builtin_bit_cast(i32x4, b), __builtin_bit_cast(i32x4, a), c, 0, 0, 0); }
template <class Epi>
__device__ __forceinline__ void gemm_phase(LAS unsigned char* lds, const Gemm g, const StaticOrder& S, const Epi& E) {
    int tid = threadIdx.x; asm volatile("" : "+v"(tid));
    const int wid = __builtin_amdgcn_readfirstlane(tid >> 6), lane = tid & 63, wr = wid >> 2, wc = wid & 3, fr = lane & 15, fq = lane >> 4;
    const int K = g.K, nt = K / BK;
    unsigned voffA[2], voffB[2];
#pragma unroll
    for (int i = 0; i < 2; ++i) { int R, C; stage_rc(tid * 16 + i * 8192, R, C); const int Rb = Epi::PERM ? ((R & ~31) + perm32(R & 31)) : R;
        voffA[i] = (unsigned)(R * K + C) * 2u; voffB[i] = (unsigned)(Rb * K + C) * 2u; }
    const size_t kstep = (size_t)(BK * 2);
    const size_t hstep = (size_t)HALF * K * 2;
    const size_t tstep = 2 * hstep;
    const unsigned ldsw = (unsigned)wid * 1024u;
    const int aoff = lds_byte(wr * 64 + fr, fq * 8), boff = lds_byte(wc * 32 + fr, fq * 8);
#define PG8_SA(b, h) (((b) * 2 + (h)) * HTB)
#define PG8_SB(b, h) ((4 + (b) * 2 + (h)) * HTB)
#define PG8_STAGE(bufoff, gbase, voff) do { _Pragma("unroll") for (int _i = 0; _i < 2; ++_i) \
        __builtin_amdgcn_global_load_lds((const unsigned*)((const char*)(gbase) + (voff)[_i]), (LAS unsigned*)(lds + (bufoff) + ldsw + _i * 8192), 16, 0, 0); } while (0)
#define PG8_LDA(dst, b, h) do { _Pragma("unroll") for (int m = 0; m < 4; ++m) _Pragma("unroll") for (int k = 0; k < 2; ++k) dst[m][k] = *(const LAS bf16x8*)(lds + PG8_SA(b, h) + aoff + m * 2048 + k * 1024); } while (0)
#define PG8_LDB(dst, b, h) do { _Pragma("unroll") for (int n = 0; n < 2; ++n) _Pragma("unroll") for (int k = 0; k < 2; ++k) dst[n][k] = *(const LAS bf16x8*)(lds + PG8_SB(b, h) + boff + n * 2048 + k * 1024); } while (0)
#define PG8_MMA(ai, bj, At, Bt) do { __builtin_amdgcn_s_setprio(1); _Pragma("unroll") for (int m = 0; m < 4; ++m) _Pragma("unroll") for (int n = 0; n < 2; ++n) _Pragma("unroll") for (int k = 0; k < 2; ++k) \
        acc[ai][bj][m][n] = mma_any(Bt[n][k], At[m][k], acc[ai][bj][m][n]); __builtin_amdgcn_s_setprio(0); } while (0)
#define PG8_WAIT_V(n) asm volatile("s_waitcnt vmcnt(" #n ")" ::: "memory")
#define PG8_WAIT_L(n) asm volatile("s_waitcnt lgkmcnt(" #n ")" ::: "memory")
#define PG8_BAR __builtin_amdgcn_s_barrier()
#define PG8_SCHED __builtin_amdgcn_sched_barrier(0)
    Unit cur, nxt; int ui = 0;
    if (!S.next(0, cur)) return;
    typedef typename Epi::acc_t acc_t;
    acc_t acc[2][2][4][2];
#pragma unroll
    for (int a = 0; a < 2; ++a)
#pragma unroll
        for (int b = 0; b < 2; ++b)
#pragma unroll
            for (int m = 0; m < 4; ++m)
#pragma unroll
                for (int n = 0; n < 2; ++n) acc[a][b][m][n] = (acc_t){0, 0, 0, 0};
    bf16x8 At[4][2], B0[2][2], B1[2][2];
    const char* cA = (const char*)g.A + (size_t)cur.pm * tstep; const char* cB = (const char*)g.Bt + g.bsel(cur.pm) + (size_t)cur.pn * tstep;
    PG8_STAGE(PG8_SB(0, 0), cB, voffB); PG8_STAGE(PG8_SB(0, 1), cB + hstep, voffB); PG8_STAGE(PG8_SA(0, 0), cA, voffA); PG8_STAGE(PG8_SA(0, 1), cA + hstep, voffA);
    if (wr == 1) PG8_BAR;
    PG8_WAIT_V(2); PG8_BAR;
    PG8_STAGE(PG8_SB(1, 0), cB + kstep, voffB); PG8_STAGE(PG8_SA(1, 0), cA + kstep, voffA); PG8_STAGE(PG8_SB(1, 1), cB + hstep + kstep, voffB);
    PG8_WAIT_V(6); PG8_BAR;
    for (;;) {
        const bool has_next = S.next(ui + 1, nxt);
        const char* nA = has_next ? (const char*)g.A + (size_t)nxt.pm * tstep : cA; const char* nB = has_next ? (const char*)g.Bt + g.bsel(nxt.pm) + (size_t)nxt.pn * tstep : cB;
        for (int t = 0; t < nt; t += 2) {
            const bool last = (t == nt - 2);
            const char* a1 = cA + (size_t)(t + 1) * kstep;
            const char* a2 = last ? nA : cA + (size_t)(t + 2) * kstep; const char* b2 = last ? nB : cB + (size_t)(t + 2) * kstep;
            const char* a3 = a2 + kstep; const char* b3 = b2 + kstep;
            PG8_LDB(B0, 0, 0); PG8_LDB(B1, 0, 1); PG8_SCHED; PG8_LDA(At, 0, 0); PG8_STAGE(PG8_SA(1, 1), a1 + hstep, voffA);
            PG8_WAIT_V(8); PG8_WAIT_L(0); PG8_BAR; PG8_MMA(0, 0, At, B0); PG8_MMA(0, 1, At, B1); PG8_BAR; PG8_SCHED;
            PG8_LDA(At, 0, 1); PG8_STAGE(PG8_SB(0, 0), b2, voffB); PG8_STAGE(PG8_SB(0, 1), b2 + hstep, voffB); PG8_STAGE(PG8_SA(0, 0), a2, voffA);
            PG8_WAIT_V(8); PG8_WAIT_L(0); PG8_BAR; PG8_MMA(1, 0, At, B0); PG8_MMA(1, 1, At, B1); PG8_BAR; PG8_SCHED;
            PG8_LDB(B0, 1, 0); PG8_LDB(B1, 1, 1); PG8_SCHED; PG8_LDA(At, 1, 0); PG8_STAGE(PG8_SA(0, 1), a2 + hstep, voffA);
            PG8_WAIT_V(8); PG8_WAIT_L(0); PG8_BAR; PG8_MMA(0, 0, At, B0); PG8_MMA(0, 1, At, B1); PG8_BAR; PG8_SCHED;
            PG8_LDA(At, 1, 1); PG8_STAGE(PG8_SB(1, 0), b3, voffB); PG8_STAGE(PG8_SB(1, 1), b3 + hstep, voffB); PG8_STAGE(PG8_SA(1, 0), a3, voffA);
            PG8_WAIT_V(8); PG8_WAIT_L(0); PG8_BAR; PG8_MMA(1, 0, At, B0); PG8_MMA(1, 1, At, B1); PG8_BAR; PG8_SCHED;
        }
        if (wr == 0) PG8_BAR;
        E(acc, cur, wr, wc, fr, fq);
        if (!has_next) break;
#pragma unroll
        for (int a = 0; a < 2; ++a)
#pragma unroll
            for (int b = 0; b < 2; ++b)
#pragma unroll
                for (int m = 0; m < 4; ++m)
#pragma unroll
                    for (int n = 0; n < 2; ++n) acc[a][b][m][n] = (acc_t){0, 0, 0, 0};
        cur = nxt; cA = nA; cB = nB; ++ui;
        if (wr == 1) PG8_BAR;
    }
    PG8_WAIT_V(0);
    PG8_BAR;
#undef PG8_SA
#undef PG8_SB
#undef PG8_STAGE
#undef PG8_LDA
#undef PG8_LDB
#undef PG8_MMA
#undef PG8_WAIT_V
#undef PG8_WAIT_L
#undef PG8_BAR
#undef PG8_SCHED
}
}

__device__ __forceinline__ void p0_transpose_item(const float* W, int K, int N, bf16_t* WT, float* scr, int item, int lane) {
    const int nblk = N / 32, kb = item / nblk, nb = item % nblk, k0 = 64 * kb, n0 = 32 * nb;
#pragma unroll 8
    for (int i = 0; i < 32; ++i) { const int kk = 2 * i + (lane >> 5); scr[kk * 33 + (lane & 31)] = W[(size_t)(k0 + kk) * N + n0 + (lane & 31)]; }
    asm volatile("s_waitcnt lgkmcnt(0)" ::: "memory");
    const int c = lane & 7;
#pragma unroll
    for (int j = 0; j < 4; ++j) { const int n = (lane >> 3) + 8 * j; const float* s = scr + (8 * c) * 33 + n;
        u32x4 o; o.x = pk2(s[0 * 33], s[1 * 33]); o.y = pk2(s[2 * 33], s[3 * 33]); o.z = pk2(s[4 * 33], s[5 * 33]); o.w = pk2(s[6 * 33], s[7 * 33]);
        *(u32x4*)(WT + (size_t)(n0 + n) * K + k0 + 8 * c) = o; }
    asm volatile("s_waitcnt lgkmcnt(0)" ::: "memory");
}
__device__ __forceinline__ void p0_colmax_item(const float* W, int N, unsigned* cmax, int item, int lane) {
    const int ngrp = N / 256, kb = item / ngrp, gb = item % ngrp; const float* src = W + (size_t)(64 * kb) * N + 256 * gb + 4 * lane;
    f32x4 m = {0.f, 0.f, 0.f, 0.f};
#pragma unroll 8
    for (int k = 0; k < 64; ++k) { const f32x4 v = *(const f32x4*)(src + (size_t)k * N); m = (f32x4){fmaxf(m[0], fabsf(v[0])), fmaxf(m[1], fabsf(v[1])), fmaxf(m[2], fabsf(v[2])), fmaxf(m[3], fabsf(v[3]))}; }
#pragma unroll
    for (int e = 0; e < 4; ++e) atomicMax(cmax + 256 * gb + 4 * lane + e, __builtin_bit_cast(unsigned, m[e]));
}
__device__ __forceinline__ void p1_qt_item(const float* W, int K, int N, const unsigned* cmax, unsigned char* WT8, float* scr, int item, int lane) {
    const int nblk = N / 32, kb = item / nblk, nb = item % nblk, k0 = 64 * kb, n0 = 32 * nb;
#pragma unroll 8
    for (int i = 0; i < 32; ++i) { const int kk = 2 * i + (lane >> 5); scr[kk * 33 + (lane & 31)] = W[(size_t)(k0 + kk) * N + n0 + (lane & 31)]; }
    asm volatile("s_waitcnt lgkmcnt(0)" ::: "memory");
    const int c = lane & 7;
#pragma unroll
    for (int j = 0; j < 4; ++j) { const int n = (lane >> 3) + 8 * j; const float* sp_ = scr + (8 * c) * 33 + n;
        const float cm = __builtin_bit_cast(float, cmax[n0 + n]); const float inv = (cm > 1e-30f) ? 127.0f / cm : 0.f;
        u32x2 o; o.x = q8pack((f32x4){sp_[0 * 33], sp_[1 * 33], sp_[2 * 33], sp_[3 * 33]} * inv); o.y = q8pack((f32x4){sp_[4 * 33], sp_[5 * 33], sp_[6 * 33], sp_[7 * 33]} * inv);
        *(u32x2*)(WT8 + (size_t)(n0 + n) * K + k0 + 8 * c) = o; }
    asm volatile("s_waitcnt lgkmcnt(0)" ::: "memory");
}
__device__ __forceinline__ void cvt_item(const float* src, bf16_t* dst, size_t item, int lane) {
    const f32x4* s = (const f32x4*)(src + item * 512) + lane * 2; const f32x4 a = s[0], b = s[1];
    u32x4 o; o.x = pk2(a[0], a[1]); o.y = pk2(a[2], a[3]); o.z = pk2(b[0], b[1]); o.w = pk2(b[2], b[3]);
    *((u32x4*)(dst + item * 512) + lane) = o;
}

__device__ __forceinline__ void phase0(const Params& p, unsigned char* lds, int bid, int nblk) {
    int tid = threadIdx.x; asm volatile("" : "+v"(tid));
    const int lane = tid & 63, wave = __builtin_amdgcn_readfirstlane(tid >> 6);
    float* s_lds = (float*)lds;
    float* red = (float*)(lds + 24576);
    float* scr = (float*)(lds + 49152 + wave * 8448);
    float* MOD = (float*)(p.ws + WS_MOD);
    for (int i = tid; i < 3 * 2048; i += 512) { const int v = i >> 11, k = i & 2047; const float cv = (v < 2) ? p.c[v * 2048 + k] : p.c_ctx[k]; s_lds[i] = cv * sigmoidf_(cv); }
    __syncthreads();
    for (int it = bid; it < 256; it += nblk) {
        const int col0 = it * 48; const int cgp = tid % 12, kl = tid / 12;
        f32x4 a0 = {0.f, 0.f, 0.f, 0.f}, a1 = a0, a2 = a0;
        if (tid < 504) {
            const float* wp = p.w_mod + col0 + 4 * cgp;
#pragma unroll 7
            for (int k = kl; k < 2048; k += 42) { const f32x4 w = *(const f32x4*)(wp + (size_t)k * 12288); a0 += w * s_lds[k]; a1 += w * s_lds[2048 + k]; a2 += w * s_lds[4096 + k]; }
            float* r = red + kl * 144 + cgp * 4;
            *(f32x4*)(r) = a0; *(f32x4*)(r + 48) = a1; *(f32x4*)(r + 96) = a2;
        }
        __syncthreads();
        if (tid < 144) { float s = 0.f; for (int k = 0; k < 42; ++k) s += red[k * 144 + tid]; const int v = tid / 48, col = col0 + tid % 48; MOD[v * 12288 + col] = s + p.b_mod[col]; }
        __syncthreads();
    }
    if (bid == 0) { float* SP = (float*)(p.ws + WS_SP); for (int i = tid; i < 2048; i += 512) SP[i] = log1pf(expf(-p.lru_lam[i])); }
    const int gw = bid * 8 + wave, NGW = nblk * 8;
    constexpr int I_IN = G1_I8 ? 0 : 32 * 128, I_OUT = 32 * 64, I_Q = G3_I8 ? 32 * 8 : 32 * 64, I_LRU = 32 * 8;
    for (int it = gw; it < I_IN + I_OUT + I_Q + I_LRU; it += NGW) {
        int r = it;
        if (r < I_LRU) { const int mat = r >> 3, d = mat >> 4, m = (mat >> 3) & 1, h = mat & 7;
            p0_transpose_item((m ? p.lru_wx : p.lru_wa) + (size_t)(d * 8 + h) * 16384, 128, 128, (bf16_t*)(p.ws + WS_LRUW) + (size_t)mat * 16384, scr, r & 7, lane); continue; } r -= I_LRU;
#if G1_I8
#else
        if (r < I_IN) { p0_transpose_item(p.w_in, 2048, 4096, (bf16_t*)(p.ws + WS_WIN), scr, r, lane); continue; } r -= I_IN;
#endif
        if (r < I_OUT) { p0_transpose_item(p.w_out, 2048, 2048, (bf16_t*)(p.ws + WS_WOUT), scr, r, lane); continue; } r -= I_OUT;
#if G3_I8
        p0_colmax_item(p.wq, 2048, (unsigned*)(p.ws + WS_COLMAX_Q), r, lane);
#else
        p0_transpose_item(p.wq, 2048, 2048, (bf16_t*)(p.ws + WS_WQ), scr, r, lane);
#endif
    }
    constexpr int C_SM = 256;
    for (int it = gw; it < 3 * C_SM; it += NGW) {
        int r = it;
        if (r < C_SM) { cvt_item(p.sgu_w, (bf16_t*)(p.ws + WS_SGUW), r, lane); continue; } r -= C_SM;
        if (r < C_SM) { cvt_item(p.k1, (bf16_t*)(p.ws + WS_K1), r, lane); continue; } r -= C_SM;
        cvt_item(p.k2, (bf16_t*)(p.ws + WS_K2), r, lane);
    }
    for (int it = gw; it < 2 * 16384; it += NGW) {
        const int tab = it >> 14, row = it & 16383;
        const float* src = (tab ? p.pv : p.pu) + (size_t)row * D + 16 * lane;
        f32x4 v[2][4]; float am = 0.f;
#pragma unroll
        for (int c = 0; c < 2; ++c)
#pragma unroll
            for (int e = 0; e < 4; ++e) { v[c][e] = *(const f32x4*)(src + 1024 * c + 4 * e); am = fmaxf(am, fmaxf(fmaxf(fabsf(v[c][e][0]), fabsf(v[c][e][1])), fmaxf(fabsf(v[c][e][2]), fabsf(v[c][e][3])))); }
#pragma unroll
        for (int o = 1; o < 64; o <<= 1) am = fmaxf(am, __shfl_xor(am, o));
        const float inv = (am > 1e-30f) ? 127.0f / am : 0.f;
        unsigned char* dst = p.ws + (tab ? WS_VB : WS_UB) + ((size_t)(lane >> 3) * 16384 + row) * 128 + 16 * (lane & 7);
#pragma unroll
        for (int c = 0; c < 2; ++c) { u32x4 o;
#pragma unroll
            for (int e = 0; e < 4; ++e) o[e] = q8pack(v[c][e] * inv);
            *(u32x4*)(dst + (size_t)c * 8 * 16384 * 128) = o; }
        if (lane == 0) ((float*)(p.ws + WS_USC))[2 * row + tab] = am * (1.0f / 127.0f);
    }
}

__device__ __forceinline__ void norm_row_bf16(const float* xrow, const float* g, const float* shift, const float* scale, bf16_t* orow, int lane) {
    f32x4 v[8]; float ss = 0.f;
#pragma unroll
    for (int j = 0; j < 8; ++j) { v[j] = *((const f32x4*)xrow + lane + 64 * j); ss += (v[j][0] * v[j][0] + v[j][1] * v[j][1]) + (v[j][2] * v[j][2] + v[j][3] * v[j][3]); }
    const float rstd = rsqrtf(wave_sum(ss) * (1.0f / 2048.0f) + EPS);
#pragma unroll
    for (int j = 0; j < 8; ++j) {
        const f32x4 gg = *((const f32x4*)g + lane + 64 * j), sh = *((const f32x4*)shift + lane + 64 * j), sc = *((const f32x4*)scale + lane + 64 * j);
        const f32x4 h = (v[j] * rstd) * gg * (sc + 1.0f) + sh;
        u32x2 o; o.x = pk2(h[0], h[1]); o.y = pk2(h[2], h[3]);
        *((u32x2*)orow + lane + 64 * j) = o;
    }
}
__device__ __forceinline__ void xhat_row_q8(const float* xrow, unsigned char* o8, float* osc, int lane) {
    f32x4 v[8]; float ss = 0.f, am = 0.f;
#pragma unroll
    for (int j = 0; j < 8; ++j) { v[j] = *((const f32x4*)xrow + lane + 64 * j); ss += (v[j][0] * v[j][0] + v[j][1] * v[j][1]) + (v[j][2] * v[j][2] + v[j][3] * v[j][3]);
        am = fmaxf(am, fmaxf(fmaxf(fabsf(v[j][0]), fabsf(v[j][1])), fmaxf(fabsf(v[j][2]), fabsf(v[j][3])))); }
    const float rstd = rsqrtf(wave_sum(ss) * (1.0f / 2048.0f) + EPS);
#pragma unroll
    for (int o = 1; o < 64; o <<= 1) am = fmaxf(am, __shfl_xor(am, o));
    const float inv = (am > 1e-30f) ? 127.0f / am : 0.f;
#pragma unroll
    for (int j = 0; j < 8; ++j) *((unsigned*)o8 + lane + 64 * j) = q8pack(v[j] * inv);
    if (lane == 0) *osc = am * rstd * (1.0f / 127.0f);
}
__device__ __forceinline__ void xrow_load(const float* xrow, int lane, f32x4 (&v)[8]) {
#pragma unroll
    for (int j = 0; j < 8; ++j) v[j] = *((const f32x4*)xrow + lane + 64 * j);
}
__device__ __forceinline__ void xhat_pack(const f32x4 (&v)[8], unsigned char* o8, float* osc, int lane) {
    float ss = 0.f, am = 0.f;
#pragma unroll
    for (int j = 0; j < 8; ++j) { ss += (v[j][0] * v[j][0] + v[j][1] * v[j][1]) + (v[j][2] * v[j][2] + v[j][3] * v[j][3]);
        am = fmaxf(am, fmaxf(fmaxf(fabsf(v[j][0]), fabsf(v[j][1])), fmaxf(fabsf(v[j][2]), fabsf(v[j][3])))); }
    const float rstd = rsqrtf(wave_sum(ss) * (1.0f / 2048.0f) + EPS);
    am = fmaxf(am, dpp_f<DPP_XOR1>(am)); am = fmaxf(am, dpp_f<DPP_XOR2>(am)); am = fmaxf(am, dpp_f<DPP_HMIRROR>(am)); am = fmaxf(am, dpp_f<DPP_MIRROR>(am));
    { float a = am, b = am; swap16(a, b); am = fmaxf(a, b); } { float a = am, b = am; swap32(a, b); am = fmaxf(a, b); }
    const float inv = (am > 1e-30f) ? 127.0f / am : 0.f;
#pragma unroll
    for (int j = 0; j < 8; ++j) *((unsigned*)o8 + lane + 64 * j) = q8pack(v[j] * inv);
    if (lane == 0) *osc = am * rstd * (1.0f / 127.0f);
}
__device__ __forceinline__ void p1_win3_item(const Params& p, int v, int nb, float* scr, int lane) {
    const float* MOD = (const float*)(p.ws + WS_MOD) + v * 12288;
    const int n0 = 16 * nb, cq = lane & 3, kq = lane >> 2;
    f32x4 mx = {0.f, 0.f, 0.f, 0.f}, bs = {0.f, 0.f, 0.f, 0.f};
#pragma unroll 8
    for (int i = 0; i < 128; ++i) { const int k = 16 * i + kq; const f32x4 w = *(const f32x4*)(p.w_in + (size_t)k * INW + n0 + 4 * cq);
        const float gsk = p.g1[k] * (1.0f + MOD[2048 + k]), shk = MOD[k];
        mx = (f32x4){fmaxf(mx[0], fabsf(w[0] * gsk)), fmaxf(mx[1], fabsf(w[1] * gsk)), fmaxf(mx[2], fabsf(w[2] * gsk)), fmaxf(mx[3], fabsf(w[3] * gsk))}; bs += w * shk; }
#pragma unroll
    for (int o = 4; o < 64; o <<= 1) { mx = (f32x4){fmaxf(mx[0], __shfl_xor(mx[0], o)), fmaxf(mx[1], __shfl_xor(mx[1], o)), fmaxf(mx[2], __shfl_xor(mx[2], o)), fmaxf(mx[3], __shfl_xor(mx[3], o))};
        bs = (f32x4){bs[0] + __shfl_xor(bs[0], o), bs[1] + __shfl_xor(bs[1], o), bs[2] + __shfl_xor(bs[2], o), bs[3] + __shfl_xor(bs[3], o)}; }
    float* CS = (float*)(p.ws + WS_CS1) + v * 4096; float* BI = (float*)(p.ws + WS_BIAS1) + v * 4096;
    if (kq == 0) { *(f32x4*)(CS + n0 + 4 * cq) = mx * (1.0f / 127.0f); *(f32x4*)(BI + n0 + 4 * cq) = bs; }
    const int n = lane >> 2, c = lane & 3;
    float cm;
    { const float c0 = __shfl(mx[0], n >> 2), c1 = __shfl(mx[1], n >> 2), c2 = __shfl(mx[2], n >> 2), c3 = __shfl(mx[3], n >> 2);
      cm = ((n & 3) == 0) ? c0 : ((n & 3) == 1) ? c1 : ((n & 3) == 2) ? c2 : c3; }
    const float inv = (cm > 1e-30f) ? 127.0f / cm : 0.f;
    unsigned char* WT8 = p.ws + WS_WIN3 + (size_t)v * 4096 * 2048;
    for (int kb = 0; kb < 32; ++kb) {
        const int k0 = 64 * kb;
#pragma unroll
        for (int r = 0; r < 4; ++r) { const int kk = kq + 16 * r, k = k0 + kk; const f32x4 w = *(const f32x4*)(p.w_in + (size_t)k * INW + n0 + 4 * cq) * (p.g1[k] * (1.0f + MOD[2048 + k]));
            float* d = scr + kk * 17 + 4 * cq; d[0] = w[0]; d[1] = w[1]; d[2] = w[2]; d[3] = w[3]; }
        asm volatile("s_waitcnt lgkmcnt(0)" ::: "memory");
        const float* sp_ = scr + (16 * c) * 17 + n;
        u32x4 o;
#pragma unroll
        for (int e = 0; e < 4; ++e) o[e] = q8pack((f32x4){sp_[(4 * e + 0) * 17], sp_[(4 * e + 1) * 17], sp_[(4 * e + 2) * 17], sp_[(4 * e + 3) * 17]} * inv);
        *(u32x4*)(WT8 + (size_t)(n0 + n) * 2048 + k0 + 16 * c) = o;
        asm volatile("s_waitcnt lgkmcnt(0)" ::: "memory");
    }
}
template <bool BF16COPY>
__device__ __forceinline__ void norm_row_q8(const float* xrow, const float* g, const float* shift, const float* scale, unsigned char* o8, float* osc, int lane, bf16_t* obf = nullptr, const bf16_t* addrow = nullptr, bf16_t* sumout = nullptr) {
    f32x4 v[8]; float ss = 0.f;
#pragma unroll
    for (int j = 0; j < 8; ++j) { v[j] = *((const f32x4*)xrow + lane + 64 * j);
        if (addrow) { const u32x2 a = *((const u32x2*)addrow + lane + 64 * j); v[j] += (f32x4){bflo(a.x), bfhi(a.x), bflo(a.y), bfhi(a.y)}; }
        if (sumout) { u32x2 o; o.x = pk2(v[j][0], v[j][1]); o.y = pk2(v[j][2], v[j][3]); *((u32x2*)sumout + lane + 64 * j) = o; }
        ss += (v[j][0] * v[j][0] + v[j][1] * v[j][1]) + (v[j][2] * v[j][2] + v[j][3] * v[j][3]); }
    const float rstd = rsqrtf(wave_sum(ss) * (1.0f / 2048.0f) + EPS);
    float am = 0.f;
#pragma unroll
    for (int j = 0; j < 8; ++j) {
        const f32x4 gg = *((const f32x4*)g + lane + 64 * j), sh = *((const f32x4*)shift + lane + 64 * j), sc = *((const f32x4*)scale + lane + 64 * j);
        const f32x4 h = (v[j] * rstd) * gg * (sc + 1.0f) + sh; v[j] = h;
        if (BF16COPY) { u32x2 o; o.x = pk2(h[0], h[1]); o.y = pk2(h[2], h[3]); *((u32x2*)obf + lane + 64 * j) = o; }
        am = fmaxf(am, fmaxf(fmaxf(fabsf(h[0]), fabsf(h[1])), fmaxf(fabsf(h[2]), fabsf(h[3]))));
    }
#pragma unroll
    for (int o = 1; o < 64; o <<= 1) am = fmaxf(am, __shfl_xor(am, o));
    const float inv = (am > 1e-30f) ? 127.0f / am : 0.f;
#pragma unroll
    for (int j = 0; j < 8; ++j) *((unsigned*)o8 + lane + 64 * j) = q8pack(v[j] * inv);
    if (lane == 0) *osc = am * (1.0f / 127.0f);
}
__device__ __forceinline__ void phase_norm1(const Params& p, unsigned char* lds, int bid, int nblk) {
    int tid = threadIdx.x; asm volatile("" : "+v"(tid));
    const int lane = tid & 63, wave = __builtin_amdgcn_readfirstlane(tid >> 6);
    const float* MOD = (const float*)(p.ws + WS_MOD); unsigned char* HN8 = p.ws + WS_HN; float* RS1 = (float*)(p.ws + WS_RS1);
    float* scr = (float*)(lds + wave * 8448);
    const int gw = bid * 8 + wave, NGW = nblk * 8;
    constexpr int I_IN = G1_I8 ? 3 * 256 : 0, I_Q = G3_I8 ? 32 * 64 : 0;
    for (int it = gw; it < I_IN + I_Q; it += NGW) {
        if (it < I_IN) p1_win3_item(p, it / 256, it % 256, scr, lane);
        else p1_qt_item(p.wq, 2048, 2048, (const unsigned*)(p.ws + WS_COLMAX_Q), p.ws + WS_WQ, scr, it - I_IN, lane);
    }
    unsigned* rowctr = (unsigned*)(p.ws + WS_CTL + 49152);
#if G1_I8
    {
#define P1_XPTR(r_) ((r_) >= MLAT ? p.ctx + (size_t)((r_) - MLAT) * D : p.x + (size_t)(r_) * D)
#define P1_NEXT(r_, out_) { if (((r_) & 7) != 7) out_ = (r_) + 1; else { const int c_ = __builtin_amdgcn_readfirstlane(nxt_v); out_ = (c_ < MALL) ? c_ : -1; if (lane == 0) nxt_v = (int)atomicAdd(rowctr, 8u); } }
        int cur_v = 0, nxt_v = 0;
        if (lane == 0) { cur_v = (int)atomicAdd(rowctr, 8u); nxt_v = (int)atomicAdd(rowctr, 8u); }
        int row = __builtin_amdgcn_readfirstlane(cur_v);
        f32x4 va[8], vb[8];
        if (row < MALL) {
            xrow_load(P1_XPTR(row), lane, va);
            for (;;) {
                int r1; P1_NEXT(row, r1)
                if (r1 >= 0) xrow_load(P1_XPTR(r1), lane, vb);
                xhat_pack(va, HN8 + (size_t)row * D, RS1 + row, lane);
                if (r1 < 0) break;
                int r2; P1_NEXT(r1, r2)
                if (r2 >= 0) xrow_load(P1_XPTR(r2), lane, va);
                xhat_pack(vb, HN8 + (size_t)r1 * D, RS1 + r1, lane);
                if (r2 < 0) break;
                row = r2;
            }
        }
#undef P1_XPTR
#undef P1_NEXT
        (void)MOD;
    }
#else
    for (;;) {
      int r0 = 0; if (lane == 0) r0 = (int)atomicAdd(rowctr, 4u); r0 = __builtin_amdgcn_readfirstlane(r0);
      if (r0 >= MALL) break;
      for (int row = r0; row < r0 + 4 && row < MALL; ++row) {
        const bool isctx = row >= MLAT; const int v = isctx ? 2 : (row >> 14);
        const float* xr = isctx ? p.ctx + (size_t)(row - MLAT) * D : p.x + (size_t)row * D;
        norm_row_bf16(xr, p.g1, MOD + v * 12288, MOD + v * 12288 + 2048, (bf16_t*)(p.ws + WS_HN) + (size_t)row * D, lane);
      }
    }
#endif
}
__device__ __forceinline__ void xl_row_q8(const bf16_t* xl, const float* g, const float* shift, const float* scale, unsigned char* o8, float* osc, int lane) {
    f32x4 v[8]; float ss = 0.f;
#pragma unroll
    for (int j = 0; j < 8; ++j) { const u32x2 a = *((const u32x2*)xl + lane + 64 * j); v[j] = (f32x4){bflo(a.x), bfhi(a.x), bflo(a.y), bfhi(a.y)};
        ss += (v[j][0] * v[j][0] + v[j][1] * v[j][1]) + (v[j][2] * v[j][2] + v[j][3] * v[j][3]); }
    const float rstd = rsqrtf(wave_sum(ss) * (1.0f / 2048.0f) + EPS);
    float am = 0.f;
#pragma unroll
    for (int j = 0; j < 8; ++j) {
        const f32x4 gg = *((const f32x4*)g + lane + 64 * j), sh = *((const f32x4*)shift + lane + 64 * j), sc = *((const f32x4*)scale + lane + 64 * j);
        const f32x4 h = (v[j] * rstd) * gg * (sc + 1.0f) + sh; v[j] = h;
        am = fmaxf(am, fmaxf(fmaxf(fabsf(h[0]), fabsf(h[1])), fmaxf(fabsf(h[2]), fabsf(h[3]))));
    }
#pragma unroll
    for (int o = 1; o < 64; o <<= 1) am = fmaxf(am, __shfl_xor(am, o));
    const float inv = (am > 1e-30f) ? 127.0f / am : 0.f;
#pragma unroll
    for (int j = 0; j < 8; ++j) *((unsigned*)o8 + lane + 64 * j) = q8pack(v[j] * inv);
    if (lane == 0) *osc = am * (1.0f / 127.0f);
}
__device__ __forceinline__ void phase_norm2(const Params& p, int bid, int nblk) {
    int tid = threadIdx.x; asm volatile("" : "+v"(tid));
    const int lane = tid & 63, wave = __builtin_amdgcn_readfirstlane(tid >> 6);
    const float* MOD = (const float*)(p.ws + WS_MOD);
    for (int row = bid * 8 + wave; row < MLAT; row += nblk * 8) {
        const int v = row >> 14;
        xl_row_q8((const bf16_t*)(p.ws + WS_YL) + (size_t)row * D, p.g2, MOD + v * 12288 + 3 * 2048, MOD + v * 12288 + 4 * 2048, p.ws + WS_HN8 + (size_t)row * D, (float*)(p.ws + WS_HSC) + row, lane);
    }
}

constexpr int XCB_LD = 136, XCF_LD = 132;
constexpr size_t WS_CARRY = 596 * MiB;

__device__ __forceinline__ void lru_ab(float ga, float gx, float ba, float bx, float sp, float xv, float& a, float& b) {
    const float rg = __builtin_amdgcn_rcpf(1.0f + __builtin_amdgcn_exp2f(fmaf(ga, -1.4426950408889634f, ba)));
    const float ig = __builtin_amdgcn_rcpf(1.0f + __builtin_amdgcn_exp2f(fmaf(gx, -1.4426950408889634f, bx)));
    a = __builtin_amdgcn_exp2f(rg * sp);
    const float em = fmaf(-a, a, 1.0f);
    b = __builtin_amdgcn_sqrtf(em) * ig * xv;
}
__device__ __forceinline__ void lru_gates1(const bf16_t* xcb, const float* xcf, int mt, int cc, int q4, int chl, const bf16x8 (&Bwa)[4], const bf16x8 (&Bwx)[4],
                                           float ba, float bx, float sp, float (&a)[4], float (&b)[4]) {
    f32x4 ga = {0.f, 0.f, 0.f, 0.f}, gx = {0.f, 0.f, 0.f, 0.f};
#pragma unroll
    for (int ks = 0; ks < 4; ++ks) {
        const bf16x8 A = *(const bf16x8*)(xcb + (16 * mt + cc) * XCB_LD + 32 * ks + 8 * q4);
        ga = __builtin_amdgcn_mfma_f32_16x16x32_bf16(A, Bwa[ks], ga, 0, 0, 0);
        gx = __builtin_amdgcn_mfma_f32_16x16x32_bf16(A, Bwx[ks], gx, 0, 0, 0);
    }
#pragma unroll
    for (int r = 0; r < 4; ++r) lru_ab(ga[r], gx[r], ba, bx, sp, xcf[(16 * mt + 4 * q4 + r) * XCF_LD + chl], a[r], b[r]);
}

__device__ __forceinline__ void carry_phase(const Params& p, int bid, int nblk) {
    int tid = threadIdx.x; asm volatile("" : "+v"(tid));
    const float* SUMS = (const float*)(p.ws + WS_SUMS); float* CARRY = (float*)(p.ws + WS_CARRY);
    for (int gid = bid * 512 + tid; gid < 4096; gid += nblk * 512) {
        const int b = gid >> 11, d = (gid >> 10) & 1, ch = gid & 1023;
        const float* sb = SUMS + (size_t)b * NSEG * 4096 + d * 2048 + ch;
        float* cb = CARRY + (size_t)b * 128 * 2048 + d * 1024 + ch;
        if (d == 0) {
            float h = sb[1024]; h = sb[4096] * h + sb[4096 + 1024];
#pragma unroll 8
            for (int c = 0; c < 128; ++c) { cb[(size_t)c * 2048] = h; h = sb[(size_t)(c + 2) * 4096] * h + sb[(size_t)(c + 2) * 4096 + 1024]; }
        } else {
            float h = sb[4096 + 1024]; h = sb[0] * h + sb[1024];
#pragma unroll 8
            for (int c = 127; c >= 0; --c) { cb[(size_t)c * 2048] = h; h = sb[(size_t)(c + 2) * 4096] * h + sb[(size_t)(c + 2) * 4096 + 1024]; }
        }
    }
}

__device__ __forceinline__ void wait_count(unsigned* ctr, unsigned target) {
    unsigned sp = 0u;
    while (__hip_atomic_load(ctr, __ATOMIC_RELAXED, __HIP_MEMORY_SCOPE_AGENT) < target) { __builtin_amdgcn_s_sleep(2); if (++sp > (1u << 22)) break; }
    __builtin_amdgcn_fence(__ATOMIC_ACQUIRE, "agent");
    asm volatile("s_waitcnt vmcnt(0)" ::: "memory");
}
template <bool APPLY>
__device__ __forceinline__ void lru_phase(const Params& p, unsigned char* lds, int bid, int nblk) {
    int tid = threadIdx.x; asm volatile("" : "+v"(tid));
    const int lane = tid & 63, w = __builtin_amdgcn_readfirstlane(tid >> 6), cc = lane & 15, q4 = lane >> 4;
    const int pg = tid >> 4, c8 = tid & 15;
    bf16_t* xcb = (bf16_t*)lds;
    float* xcf = (float*)(lds + 34816);
    float* cw = (float*)(lds + 102400);
    const bf16_t* PROJ = (const bf16_t*)(p.ws + WS_PROJ);
    float* SUMS = (float*)(p.ws + WS_SUMS);
    const float* SP = (const float*)(p.ws + WS_SP);
    const float* CARRY = (const float*)(p.ws + WS_CARRY);
    bf16_t* Y = (bf16_t*)(p.ws + WS_HN);
    const bf16_t* LRUW = (const bf16_t*)(p.ws + WS_LRUW);
    constexpr int NS = APPLY ? 128 : NSEG;
    const int nitems = 2 * NS * 8;
    int cur_h = -1;
    const int chl = 16 * w + cc;
    bf16x8 Bw[2][2][4];
    float ba[2], bx[2], sp[2];
#pragma unroll
    for (int d = 0; d < 2; ++d) { ba[d] = 0.f; bx[d] = 0.f; sp[d] = 0.f;
#pragma unroll
        for (int m = 0; m < 2; ++m)
#pragma unroll
            for (int ks = 0; ks < 4; ++ks) Bw[d][m][ks] = (bf16x8){0, 0, 0, 0, 0, 0, 0, 0}; }
#define LRU_DECODE(it_) const int h = (it_) & 7, bs = (it_) >> 3, b = APPLY ? bs / NS : (bs < 256 ? bs >> 7 : (bs - 256) >> 1), sg = APPLY ? bs % NS : (bs < 256 ? 2 + (bs & 127) : (bs - 256) & 1); const int seg = APPLY ? sg + 2 : sg; const bool isctx = seg < 2;        \
        const int L = isctx ? CTXL : SEQ; const int p0 = isctx ? seg * 128 : (seg - 2) * 128; const size_t rowbase = isctx ? (size_t)(MLAT + b * CTXL) : (size_t)b * SEQ;
#define LRU_LOADRAW(dst) { _Pragma("unroll") for (int i = 0; i < 7; ++i) { const int r = p0 + 4 * pg - 2 + i; const bool ok = (r >= 0) && (r < L); \
            dst[i] = ok ? *(const u32x4*)(PROJ + (rowbase + (size_t)(ok ? r : 0)) * INW + h * 128 + 8 * c8) : (u32x4){0u, 0u, 0u, 0u}; } }
    bool ctx_ready = !(G1_I8 && CTX_SPLIT) || APPLY;
#define LRU_CTXWAIT(it_) if (!ctx_ready && ((it_) >> 3) >= 256) { if (tid == 0) wait_count((unsigned*)(p.ws + WS_CTL + CTXDONE_OFS), 8u); __syncthreads(); ctx_ready = true; }
    u32x4 rw[7];
    unsigned* lctr = (unsigned*)(p.ws + WS_CTL + 45120) + (bid & 7);
    volatile int* nxl = (volatile int*)(lds + 105216);
    int it = bid, itn = bid + nblk, itnn = 0;
    if (!APPLY) {
        if (tid == 0) { nxl[0] = (int)atomicAdd(lctr, 1u) * 8 + (bid & 7); nxl[1] = (int)atomicAdd(lctr, 1u) * 8 + (bid & 7); }
        __syncthreads();
        it = nxl[0]; itn = nxl[1];
        __syncthreads();
        if (it < nitems) { LRU_CTXWAIT(it) LRU_DECODE(it) LRU_LOADRAW(rw) }
    }
    for (; it < nitems; it = itn, itn = APPLY ? itn + nblk : itnn) {
        LRU_DECODE(it)
        if (!APPLY) { if (tid == 0) nxl[0] = (int)atomicAdd(lctr, 1u) * 8 + (bid & 7); }
        if (APPLY) { LRU_LOADRAW(rw) }
#define LRU_LOADW2(d_, W0, W1) { const bf16_t* wa_ = LRUW + ((size_t)(((d_) * 2 + 0) * 8 + h) * 128 + chl) * 128 + 8 * q4; const bf16_t* wx_ = LRUW + ((size_t)(((d_) * 2 + 1) * 8 + h) * 128 + chl) * 128 + 8 * q4; \
            _Pragma("unroll") for (int ks = 0; ks < 4; ++ks) { W0[ks] = *(const bf16x8*)(wa_ + 32 * ks); W1[ks] = *(const bf16x8*)(wx_ + 32 * ks); } }
        if (h != cur_h) {
            cur_h = h;
#pragma unroll
            for (int d = 0; d < 2; ++d) {
                if (APPLY) { ba[d] = -1.4426950408889634f * p.lru_ba[d * 1024 + h * 128 + chl]; bx[d] = -1.4426950408889634f * p.lru_bx[d * 1024 + h * 128 + chl]; sp[d] = -8.0f * 1.4426950408889634f * SP[d * 1024 + h * 128 + chl]; continue; }
                const bf16_t* wa_ = LRUW + ((size_t)((d * 2 + 0) * 8 + h) * 128 + chl) * 128 + 8 * q4; const bf16_t* wx_ = LRUW + ((size_t)((d * 2 + 1) * 8 + h) * 128 + chl) * 128 + 8 * q4;
#pragma unroll
                for (int ks = 0; ks < 4; ++ks) { Bw[d][0][ks] = *(const bf16x8*)(wa_ + 32 * ks); Bw[d][1][ks] = *(const bf16x8*)(wx_ + 32 * ks); }
                ba[d] = -1.4426950408889634f * p.lru_ba[d * 1024 + h * 128 + chl]; bx[d] = -1.4426950408889634f * p.lru_bx[d * 1024 + h * 128 + chl]; sp[d] = -8.0f * 1.4426950408889634f * SP[d * 1024 + h * 128 + chl];
            }
            for (int i = tid; i < 640; i += 512) { const int k = i >> 7, ch = i & 127; cw[i] = (k < 4) ? p.conv_w[k * 1024 + h * 128 + ch] : p.conv_b[h * 128 + ch]; }
            __syncthreads();
        }
        {
            f32x4 wk[5][2];
#pragma unroll
            for (int k = 0; k < 5; ++k) { wk[k][0] = *(const f32x4*)(cw + k * 128 + 8 * c8); wk[k][1] = *(const f32x4*)(cw + k * 128 + 8 * c8 + 4); }
#pragma unroll
            for (int j = 0; j < 4; ++j) {
                f32x4 x0 = wk[4][0], x1 = wk[4][1];
#pragma unroll
                for (int k = 0; k < 4; ++k) { const u32x4 r = rw[j + k];
                    x0 += wk[k][0] * (f32x4){bflo(r[0]), bfhi(r[0]), bflo(r[1]), bfhi(r[1])};
                    x1 += wk[k][1] * (f32x4){bflo(r[2]), bfhi(r[2]), bflo(r[3]), bfhi(r[3])}; }
                const int pos = 4 * pg + j;
                *(f32x4*)(xcf + pos * XCF_LD + 8 * c8) = x0; *(f32x4*)(xcf + pos * XCF_LD + 8 * c8 + 4) = x1;
                u32x4 o; o.x = pk2(x0[0], x0[1]); o.y = pk2(x0[2], x0[3]); o.z = pk2(x1[0], x1[1]); o.w = pk2(x1[2], x1[3]);
                *(u32x4*)(xcb + pos * XCB_LD + 8 * c8) = o;
            }
        }
        u32x4 gt[4]; float cf = 0.f, cbw = 0.f;
        if (APPLY) {
            const float* cp = CARRY + ((size_t)(b * 128 + sg) * 2) * 1024 + h * 128 + chl; cf = cp[0]; cbw = cp[1024];
        }
        if (!APPLY) { if (itn < nitems) { LRU_CTXWAIT(itn) LRU_DECODE(itn) LRU_LOADRAW(rw) } }
        __syncthreads();
        if (!APPLY) itnn = nxl[0];
        if (APPLY) {
            float y[8][4];
#pragma unroll
            for (int mt = 0; mt < 8; ++mt)
#pragma unroll
                for (int r = 0; r < 4; ++r) y[mt][r] = 0.f;
            float stf = cf, stb = cbw;
            bf16x8 Wf0[4], Wf1[4];
            LRU_LOADW2(0, Wf0, Wf1)
#pragma unroll
            for (int i = 0; i < 8; ++i) {
                const int mt = i; float a[4], bb[4];
                lru_gates1(xcb, xcf, mt, cc, q4, chl, Wf0, Wf1, ba[0], bx[0], sp[0], a, bb);
                float A4 = a[0], B4 = bb[0];
#pragma unroll
                for (int r = 1; r < 4; ++r) { B4 = a[r] * B4 + bb[r]; A4 *= a[r]; }
                const float A0 = __shfl(A4, cc), A1 = __shfl(A4, cc + 16), A2 = __shfl(A4, cc + 32), A3 = __shfl(A4, cc + 48);
                const float B0 = __shfl(B4, cc), B1 = __shfl(B4, cc + 16), B2 = __shfl(B4, cc + 32), B3 = __shfl(B4, cc + 48);
                const float s0 = stf, s1 = A0 * s0 + B0, s2 = A1 * s1 + B1, s3 = A2 * s2 + B2, s4 = A3 * s3 + B3;
                float hh = (q4 == 0) ? s0 : (q4 == 1) ? s1 : (q4 == 2) ? s2 : s3;
#pragma unroll
                for (int r = 0; r < 4; ++r) { hh = a[r] * hh + bb[r]; y[mt][r] += hh; }
                stf = s4;
                if (i & 1) __builtin_amdgcn_sched_barrier(0);
            }
            bf16x8 Wb0[4], Wb1[4];
            LRU_LOADW2(1, Wb0, Wb1)
#pragma unroll
            for (int i = 0; i < 8; ++i) {
                const int mt = 7 - i; float a[4], bb[4];
                lru_gates1(xcb, xcf, mt, cc, q4, chl, Wb0, Wb1, ba[1], bx[1], sp[1], a, bb);
                float A4 = a[3], B4 = bb[3];
#pragma unroll
                for (int r = 2; r >= 0; --r) { B4 = a[r] * B4 + bb[r]; A4 *= a[r]; }
                const float A0 = __shfl(A4, cc), A1 = __shfl(A4, cc + 16), A2 = __shfl(A4, cc + 32), A3 = __shfl(A4, cc + 48);
                const float B0 = __shfl(B4, cc), B1 = __shfl(B4, cc + 16), B2 = __shfl(B4, cc + 32), B3 = __shfl(B4, cc + 48);
                const float s0 = stb, s1 = A3 * s0 + B3, s2 = A2 * s1 + B2, s3 = A1 * s2 + B1, s4 = A0 * s3 + B0;
                float hh = (q4 == 3) ? s0 : (q4 == 2) ? s1 : (q4 == 1) ? s2 : s3;
#pragma unroll
                for (int r = 3; r >= 0; --r) { hh = a[r] * hh + bb[r]; y[mt][r] += hh; }
                stb = s4;
                if (i & 1) __builtin_amdgcn_sched_barrier(0);
            }
#pragma unroll
            for (int j = 0; j < 4; ++j) gt[j] = *(const u32x4*)(PROJ + (rowbase + p0 + 4 * pg + j) * INW + 1024 + h * 128 + 8 * c8);
            __syncthreads();
#pragma unroll
            for (int mt = 0; mt < 8; ++mt)
#pragma unroll
                for (int r = 0; r < 4; ++r) xcf[(16 * mt + 4 * q4 + r) * XCF_LD + chl] = y[mt][r];
            __syncthreads();
#pragma unroll
            for (int j = 0; j < 4; ++j) {
                const int pos = 4 * pg + j;
                const f32x4 y0 = *(const f32x4*)(xcf + pos * XCF_LD + 8 * c8), y1 = *(const f32x4*)(xcf + pos * XCF_LD + 8 * c8 + 4);
                const u32x4 g = gt[j];
                u32x4 o;
                o.x = pk2(gelu_tanh(bflo(g[0])) * y0[0], gelu_tanh(bfhi(g[0])) * y0[1]); o.y = pk2(gelu_tanh(bflo(g[1])) * y0[2], gelu_tanh(bfhi(g[1])) * y0[3]);
                o.z = pk2(gelu_tanh(bflo(g[2])) * y1[0], gelu_tanh(bfhi(g[2])) * y1[1]); o.w = pk2(gelu_tanh(bflo(g[3])) * y1[2], gelu_tanh(bfhi(g[3])) * y1[3]);
                *(u32x4*)(Y + (rowbase + p0 + pos) * D + h * 128 + 8 * c8) = o;
            }
        } else {
            float TA[2] = {1.f, 1.f}, TB[2] = {0.f, 0.f};
#pragma unroll 2
            for (int mt = 0; mt < 8; ++mt) {
                f32x4 gaf = {0.f, 0.f, 0.f, 0.f}, gxf = gaf, gab = gaf, gxb = gaf;
#pragma unroll
                for (int ks = 0; ks < 4; ++ks) {
                    const bf16x8 A = *(const bf16x8*)(xcb + (16 * mt + cc) * XCB_LD + 32 * ks + 8 * q4);
                    gaf = __builtin_amdgcn_mfma_f32_16x16x32_bf16(A, Bw[0][0][ks], gaf, 0, 0, 0);
                    gxf = __builtin_amdgcn_mfma_f32_16x16x32_bf16(A, Bw[0][1][ks], gxf, 0, 0, 0);
                    gab = __builtin_amdgcn_mfma_f32_16x16x32_bf16(A, Bw[1][0][ks], gab, 0, 0, 0);
                    gxb = __builtin_amdgcn_mfma_f32_16x16x32_bf16(A, Bw[1][1][ks], gxb, 0, 0, 0);
                }
                float af[4], bf[4], ab[4], bbk[4];
#pragma unroll
                for (int r = 0; r < 4; ++r) { const float xv = xcf[(16 * mt + 4 * q4 + r) * XCF_LD + chl];
                    lru_ab(gaf[r], gxf[r], ba[0], bx[0], sp[0], xv, af[r], bf[r]); lru_ab(gab[r], gxb[r], ba[1], bx[1], sp[1], xv, ab[r], bbk[r]); }
                float FA = af[0], FB = bf[0], RA = ab[3], RB = bbk[3];
#pragma unroll
                for (int r = 1; r < 4; ++r) { FB = af[r] * FB + bf[r]; FA *= af[r]; }
#pragma unroll
                for (int r = 2; r >= 0; --r) { RB = ab[r] * RB + bbk[r]; RA *= ab[r]; }
                {   const float A0 = __shfl(FA, cc), A1 = __shfl(FA, cc + 16), A2 = __shfl(FA, cc + 32), A3 = __shfl(FA, cc + 48);
                    const float B0 = __shfl(FB, cc), B1 = __shfl(FB, cc + 16), B2 = __shfl(FB, cc + 32), B3 = __shfl(FB, cc + 48);
                    const float At = A0 * A1 * A2 * A3, Bt = ((B0 * A1 + B1) * A2 + B2) * A3 + B3;
                    TB[0] = At * TB[0] + Bt; TA[0] = TA[0] * At; }
                {   const float A0 = __shfl(RA, cc), A1 = __shfl(RA, cc + 16), A2 = __shfl(RA, cc + 32), A3 = __shfl(RA, cc + 48);
                    const float B0 = __shfl(RB, cc), B1 = __shfl(RB, cc + 16), B2 = __shfl(RB, cc + 32), B3 = __shfl(RB, cc + 48);
                    const float At = A0 * A1 * A2 * A3, Bt = ((B3 * A2 + B2) * A1 + B1) * A0 + B0;
                    TB[1] = TA[1] * Bt + TB[1]; TA[1] = At * TA[1]; }
            }
            if (q4 == 0) {
#pragma unroll
                for (int d = 0; d < 2; ++d) { float* sb = SUMS + ((size_t)(b * NSEG + seg) * 2 + d) * 2048 + h * 128 + chl; sb[0] = TA[d]; sb[1024] = TB[d]; }
            }
        }
        __syncthreads();
    }
#undef LRU_DECODE
#undef LRU_LOADRAW
#undef LRU_LOADW2
#undef LRU_CTXWAIT
}

__device__ __forceinline__ void sgu_phase(const Params& p, unsigned char* lds, int bid, int nblk) {
    int tid = threadIdx.x; asm volatile("" : "+v"(tid));
    const int lane = tid & 63, w = __builtin_amdgcn_readfirstlane(tid >> 6), cc = lane & 15, q4 = lane >> 4;
    bf16_t* vgT = (bf16_t*)lds;
    float* part = (float*)(lds + 34816);
    bf16_t* Wl = (bf16_t*)(lds + 38912);
    const bf16_t* PROJ = (const bf16_t*)(p.ws + WS_PROJ);
    const bf16_t* WS_ = (const bf16_t*)(p.ws + WS_SGUW);
    bf16_t* Y = (bf16_t*)(p.ws + WS_HN);
    const int pp1 = tid & 127, cg4 = tid >> 7;
    const int c0 = 16 * w + 4 * q4;
    const int g = bid & 7;
    unsigned* ctr = (unsigned*)(p.ws + WS_CTL + 45056) + g;
    volatile int* nxtw = (volatile int*)(lds + 73728);
    if (tid == 0) nxtw[0] = (int)atomicAdd(ctr, 1u);
#pragma unroll
    for (int e = 0; e < 4; ++e) { const int i = tid + 512 * e; const int r = i >> 4, c16 = i & 15; *(u32x4*)(Wl + r * XCB_LD + 8 * c16) = *(const u32x4*)(WS_ + ((size_t)g * 128 + r) * 128 + 8 * c16); }
    __syncthreads();
    int jt = nxtw[0];
    float bsr[8];
#pragma unroll
    for (int nt = 0; nt < 8; ++nt) bsr[nt] = p.sgu_b[g * 128 + 16 * nt + cc];
    u32x4 vr[4];
    if (jt < 256) { const u32x4* src = (const u32x4*)(PROJ + ((size_t)(jt >> 7) * SEQ + (size_t)(jt & 127) * 128 + pp1) * INW + 3072 + g * 128 + 32 * cg4);
#pragma unroll
        for (int e = 0; e < 4; ++e) vr[e] = src[e]; }
    while (jt < 256) {
        const int n = jt & 127, b = jt >> 7;
        const size_t rowbase = (size_t)b * SEQ + (size_t)n * 128;
        if (tid == 0) nxtw[1] = (int)atomicAdd(ctr, 1u);
        u32x2 ur[8];
#pragma unroll
        for (int nt = 0; nt < 8; ++nt) ur[nt] = *(const u32x2*)(PROJ + (rowbase + 16 * nt + cc) * INW + 2048 + g * 128 + c0);
        {
            float gv[32]; float s1 = 0.f, s2 = 0.f;
#pragma unroll
            for (int e = 0; e < 4; ++e) { const u32x4 r = vr[e];
#pragma unroll
                for (int j = 0; j < 4; ++j) { const float lo = gelu_tanh(bflo(r[j])), hi = gelu_tanh(bfhi(r[j])); gv[8 * e + 2 * j] = lo; gv[8 * e + 2 * j + 1] = hi; s1 += lo + hi; s2 += lo * lo + hi * hi; } }
            part[(cg4 * 128 + pp1) * 2] = s1; part[(cg4 * 128 + pp1) * 2 + 1] = s2;
            __syncthreads();
            jt = nxtw[1];
            if (jt < 256) { const u32x4* src = (const u32x4*)(PROJ + ((size_t)(jt >> 7) * SEQ + (size_t)(jt & 127) * 128 + pp1) * INW + 3072 + g * 128 + 32 * cg4);
#pragma unroll
                for (int e = 0; e < 4; ++e) vr[e] = src[e]; }
            float ts = 0.f, ts2 = 0.f;
#pragma unroll
            for (int k = 0; k < 4; ++k) { ts += part[(k * 128 + pp1) * 2]; ts2 += part[(k * 128 + pp1) * 2 + 1]; }
            const float mu = ts * (1.0f / 128.0f); const float var = fmaxf(ts2 * (1.0f / 128.0f) - mu * mu, 0.f); const float rstd = rsqrtf(var + EPS);
#pragma unroll
            for (int j = 0; j < 32; ++j) vgT[(32 * cg4 + j) * XCB_LD + pp1] = (bf16_t)f2bf((gv[j] - mu) * rstd);
        }
        __syncthreads();
        {
            bf16x8 Af[4];
#pragma unroll
            for (int ks = 0; ks < 4; ++ks) Af[ks] = *(const bf16x8*)(vgT + (16 * w + cc) * XCB_LD + 32 * ks + 8 * q4);
#pragma unroll
            for (int nt = 0; nt < 8; ++nt) {
                const int pp = 16 * nt + cc;
                f32x4 acc = {0.f, 0.f, 0.f, 0.f};
#pragma unroll
                for (int ks = 0; ks < 4; ++ks) { const bf16x8 Bf = *(const bf16x8*)(Wl + pp * XCB_LD + 32 * ks + 8 * q4); acc = __builtin_amdgcn_mfma_f32_16x16x32_bf16(Af[ks], Bf, acc, 0, 0, 0); }
                const float bsv = bsr[nt];
                const u32x2 uu = ur[nt];
                const float y0 = gelu_tanh(bflo(uu.x)) * (acc[0] + bsv), y1 = gelu_tanh(bfhi(uu.x)) * (acc[1] + bsv), y2 = gelu_tanh(bflo(uu.y)) * (acc[2] + bsv), y3 = gelu_tanh(bfhi(uu.y)) * (acc[3] + bsv);
                u32x2 o; o.x = pk2(y0, y1); o.y = pk2(y2, y3);
                *(u32x2*)(Y + (rowbase + pp) * D + 1024 + g * 128 + c0) = o;
            }
        }
        __syncthreads();
    }
}

#define INS16(S, x) do { int _x = (x); _Pragma("unroll") for (int _j = 0; _j < 16; ++_j) { const int _hi = max(S[_j], _x); _x = min(S[_j], _x); S[_j] = _hi; } } while (0)
#define MERGE16(A, B) do { _Pragma("unroll") for (int _i = 0; _i < 16; ++_i) A[_i] = max(A[_i], B[15 - _i]); \
    _Pragma("unroll") for (int _st = 8; _st >= 1; _st >>= 1) { _Pragma("unroll") for (int _i = 0; _i < 16; ++_i) if ((_i & _st) == 0) { const int _hi = max(A[_i], A[_i + _st]), _lo = min(A[_i], A[_i + _st]); A[_i] = _hi; A[_i + _st] = _lo; } } } while (0)
#define SORT16(S) { _Pragma("unroll") for (int kk = 2; kk <= 16; kk <<= 1) _Pragma("unroll") for (int jj2 = kk >> 1; jj2 > 0; jj2 >>= 1) _Pragma("unroll") for (int i = 0; i < 16; ++i) { const int l = i ^ jj2; \
        if (l > i) { const int hi = max(S[i], S[l]), lo = min(S[i], S[l]); const bool desc = ((i & kk) == 0); S[i] = desc ? hi : lo; S[l] = desc ? lo : hi; } } }
#define QMERGE(S, CTRL) { int T_[16]; _Pragma("unroll") for (int i_ = 0; i_ < 16; ++i_) T_[i_] = max(S[i_], dpp_i<CTRL>(S[15 - i_])); \
        _Pragma("unroll") for (int st_ = 8; st_ >= 1; st_ >>= 1) { _Pragma("unroll") for (int i_ = 0; i_ < 16; ++i_) if ((i_ & st_) == 0) { const int hi_ = max(T_[i_], T_[i_ + st_]), lo_ = min(T_[i_], T_[i_ + st_]); T_[i_] = hi_; T_[i_ + st_] = lo_; } } \
        _Pragma("unroll") for (int i_ = 0; i_ < 16; ++i_) S[i_] = T_[i_]; }
__device__ __forceinline__ void topk_phase(const Params& p, unsigned char* lds, int bid, int nblk) {
    int tid = threadIdx.x; asm volatile("" : "+v"(tid));
    const int lane = tid & 63, w = __builtin_amdgcn_readfirstlane(tid >> 6), cc = lane & 15, q4 = lane >> 4;
    constexpr int QT_LD = 264;
    bf16_t* qt = (bf16_t*)lds;
    constexpr int ST_LD = 132;
    float* ST = (float*)(lds + 67584);
    constexpr int LL_LD = 33;
    int* LL = (int*)(lds + 135168);
    const bf16_t* Q = (const bf16_t*)(p.ws + WS_PROJ);
    int* TOPI = (int*)(p.ws + WS_TOPI); float* TOPG = (float*)(p.ws + WS_TOPG);
    const int srow = 16 * w + (lane >> 5), scol = 8 * (lane & 31);
    const int t = tid >> 2, kq = tid & 3;
    int code[13];
    {   int cnt = 0;
#pragma unroll
        for (int c = 0; c < 13; ++c) code[c] = -1;
#pragma unroll
        for (int i = 0; i < 16; ++i)
#pragma unroll
            for (int j = 0; j < 16; ++j)
                if ((i + 1) * (j + 1) <= 16) { code[cnt >> 2] = ((cnt & 3) == kq) ? (i * 16 + j) : code[cnt >> 2]; ++cnt; } }
    int cur_h = -1;
    bf16x8 Ak[2][4];
#pragma unroll
    for (int hf = 0; hf < 2; ++hf)
#pragma unroll
        for (int ks = 0; ks < 4; ++ks) Ak[hf][ks] = (bf16x8){0, 0, 0, 0, 0, 0, 0, 0};
    u32x4 qr[8];
    if (bid < 2048) { const int h0 = bid & 7, t0 = (bid >> 3) * 128; const bf16_t* src = Q + (size_t)(t0 + srow) * D + h0 * 256 + scol;
#pragma unroll
        for (int e = 0; e < 8; ++e) qr[e] = *(const u32x4*)(src + (size_t)(2 * e) * D); }
    for (int it = bid; it < 2048; it += nblk) {
        const int h = it & 7, tok0 = (it >> 3) * 128;
        if (h != cur_h) { cur_h = h;
#pragma unroll
            for (int hf = 0; hf < 2; ++hf) { const bf16_t* kb = (const bf16_t*)(p.ws + (hf ? WS_K2 : WS_K1)) + ((size_t)h * 128 + 16 * w + cc) * 128 + 8 * q4;
#pragma unroll
                for (int ks = 0; ks < 4; ++ks) Ak[hf][ks] = *(const bf16x8*)(kb + 32 * ks); } }
#pragma unroll
        for (int e = 0; e < 8; ++e) *(u32x4*)(qt + (srow + 2 * e) * QT_LD + scol) = qr[e];
        if (it + nblk < 2048) { const int h1 = (it + nblk) & 7, t1 = ((it + nblk) >> 3) * 128; const bf16_t* src = Q + (size_t)(t1 + srow) * D + h1 * 256 + scol;
#pragma unroll
            for (int e = 0; e < 8; ++e) qr[e] = *(const u32x4*)(src + (size_t)(2 * e) * D); }
        __syncthreads();
#pragma unroll
        for (int half = 0; half < 2; ++half) {
            if (half == 1) __syncthreads();
#pragma unroll 2
            for (int n = 0; n < 8; ++n) {
                f32x4 acc = {0.f, 0.f, 0.f, 0.f};
#pragma unroll
                for (int ks = 0; ks < 4; ++ks) { const bf16x8 Bf = *(const bf16x8*)(qt + (16 * n + cc) * QT_LD + half * 128 + 32 * ks + 8 * q4); acc = __builtin_amdgcn_mfma_f32_16x16x32_bf16(Ak[half][ks], Bf, acc, 0, 0, 0); }
#pragma unroll
                for (int r = 0; r < 4; ++r) ST[(16 * w + 4 * q4 + r) * ST_LD + 16 * n + cc] = acc[r];
            }
            __syncthreads();
            int S[16];
            {
                int K2[16];
#pragma unroll
                for (int i = 0; i < 16; ++i) { const int k0 = 16 * (i >> 2) + 4 * kq + (i & 3), k1 = k0 + 64;
                    S[i] = (mono(ST[k0 * ST_LD + t]) & ~127) | (127 - k0); K2[i] = (mono(ST[k1 * ST_LD + t]) & ~127) | (127 - k1); }
                SORT16(S) SORT16(K2)
                MERGE16(S, K2);
            }
            QMERGE(S, DPP_XOR1) QMERGE(S, DPP_XOR2)
            if (kq == 0) {
#pragma unroll
                for (int j = 0; j < 16; ++j) LL[t * LL_LD + half * 16 + j] = S[j]; }
        }
        int S[16];
        {
#pragma unroll
            for (int c = 0; c < 13; ++c) { const int cd = max(code[c], 0); const float f1 = unmono(LL[t * LL_LD + (cd >> 4)] & ~127), f2 = unmono(LL[t * LL_LD + 16 + (cd & 15)] & ~127);
                S[c] = (code[c] >= 0) ? ((mono(f1 + f2) & ~255) | (255 - cd)) : (int)0x80000000; }
            S[13] = (int)0x80000000; S[14] = (int)0x80000000; S[15] = (int)0x80000000;
            SORT16(S)
        }
        QMERGE(S, DPP_XOR1) QMERGE(S, DPP_XOR2)
        {
            int my[4];
#pragma unroll
            for (int m = 0; m < 4; ++m) my[m] = (kq == 0) ? S[m] : (kq == 1) ? S[4 + m] : (kq == 2) ? S[8 + m] : S[12 + m];
            const float mx = unmono(S[0] & ~255);
            f32x4 ev; int idx[4]; float part = 0.f;
#pragma unroll
            for (int m = 0; m < 4; ++m) { const int cd = 255 - (my[m] & 255);
                const int e1 = 127 - (LL[t * LL_LD + (cd >> 4)] & 127), e2 = 127 - (LL[t * LL_LD + 16 + (cd & 15)] & 127);
                idx[m] = e1 * 128 + e2; ev[m] = __expf(unmono(my[m] & ~255) - mx); part += ev[m]; }
            part += dpp_f<DPP_XOR1>(part); part += dpp_f<DPP_XOR2>(part);
            const float inv = 1.0f / part;
            *(int4*)(TOPI + (size_t)(tok0 + t) * 128 + h * 16 + 4 * kq) = make_int4(idx[0], idx[1], idx[2], idx[3]);
            *(f32x4*)(TOPG + (size_t)(tok0 + t) * 128 + h * 16 + 4 * kq) = ev * inv;
        }
    }
}

constexpr size_t WS_PART = WS_PROJ;
constexpr size_t WS_DELTA = WS_HN;
__device__ __forceinline__ int pu_dot_ref(u32x4 qv, u32x4 hv) {
    float d = 0.f;
#pragma unroll
    for (int w = 0; w < 4; ++w)
#pragma unroll
        for (int k = 0; k < 4; ++k) d += sb(qv[w], k) * sb(hv[w], k);
    return (int)d;
}
__device__ __forceinline__ void peer_u_phase(const Params& p, int bid, int nblk) {
    int tid = threadIdx.x; asm volatile("" : "+v"(tid));
    const int lane = tid & 63, wave = __builtin_amdgcn_readfirstlane(tid >> 6), g = lane >> 3, jj = lane & 7;
    const int nx = (nblk % 8 == 0) ? 8 : 1, x = bid % nx, j = bid / nx, J = nblk / nx;
    const unsigned char* UB = p.ws + WS_UB;
    const unsigned char* HN8 = p.ws + WS_HN8; const float* HSC = (const float*)(p.ws + WS_HSC);
    const int* TOPI = (const int*)(p.ws + WS_TOPI); bf16_t* PART = (bf16_t*)(p.ws + WS_PART);
    const bool b2 = (jj & 4) != 0, b1 = (jj & 2) != 0, b0 = (jj & 1) != 0;
    const int tstep = J * 8;
#define PU_IDX(I, t_) { const int tt = min((t_), MLAT - 1); I = *(const int2*)(TOPI + (size_t)tt * 128 + 16 * g + 2 * jj); }
#define PU_Q(Q, H, E, I, t_, s_) { const int tt = min((t_), MLAT - 1); \
        _Pragma("unroll") for (int i = 0; i < 16; ++i) { const unsigned ixi = (unsigned)__shfl((i & 1) ? I.y : I.x, (lane & ~7) | (i >> 1)); Q[i] = *(const u32x4*)(UB + (((unsigned)(s_) * 16384u + ixi) * 128u + 16u * (unsigned)jj)); } \
        H##_d = *(const u32x2*)(HN8 + (size_t)tt * D + 128 * (s_) + 16 * jj + 8 * (g & 1)); H##_s = HSC[tt]; }
#if U_MODE == 1
#define PU_DOT(Qi, H) (__builtin_amdgcn_sdot4((int)Qi[3], (int)H[3], __builtin_amdgcn_sdot4((int)Qi[2], (int)H[2], __builtin_amdgcn_sdot4((int)Qi[1], (int)H[1], __builtin_amdgcn_sdot4((int)Qi[0], (int)H[0], 0, false), false), false), false))
#else
#define PU_DOT(Qi, H) pu_dot_ref(Qi, H)
#endif
#define PU_COMPUTE(Q, H, E, t_, s_) { \
        u32x4 H; { const unsigned ox = (unsigned)dpp_i<DPP_ROR8>((int)H##_d.x), oy = (unsigned)dpp_i<DPP_ROR8>((int)H##_d.y); const bool odd = (g & 1) != 0; \
            H[0] = odd ? ox : H##_d.x; H[1] = odd ? oy : H##_d.y; H[2] = odd ? H##_d.x : ox; H[3] = odd ? H##_d.y : oy; } \
        int acc[16]; \
        _Pragma("unroll") for (int i = 0; i < 16; ++i) acc[i] = PU_DOT(Q[i], H); \
        int r1[8], r2[4], r3[2]; \
        _Pragma("unroll") for (int k = 0; k < 8; ++k) { const int mine = b2 ? acc[8 + k] : acc[k], send = b2 ? acc[k] : acc[8 + k]; r1[k] = mine + dpp_i<DPP_HMIRROR>(send); }        \
        _Pragma("unroll") for (int k = 0; k < 4; ++k) { const int mine = b1 ? r1[4 + k] : r1[k], send = b1 ? r1[k] : r1[4 + k]; r2[k] = mine + dpp_i<DPP_XOR2>(send); } \
        _Pragma("unroll") for (int k = 0; k < 2; ++k) { const int mine = b0 ? r2[2 + k] : r2[k], send = b0 ? r2[k] : r2[2 + k]; r3[k] = mine + dpp_i<DPP_XOR1>(send); } \
        if ((t_) < MLAT) { const float hs = H##_s; const unsigned o = pk2((float)r3[0] * hs, (float)r3[1] * hs); __builtin_nontemporal_store(o, (unsigned*)(PART + ((size_t)(s_) * MLAT + (t_)) * 128 + 16 * g + 2 * jj)); } }
    for (int s = x; s < 16; s += nx) {
        int t0 = j * 8 + wave, t1 = t0 + tstep;
        int2 IA, IB; u32x4 QA[16], QB[16]; u32x2 HA_d, HB_d; float HA_s, HB_s; int2 EA, EB;
        PU_IDX(IA, t0) PU_IDX(IB, t1)
        __builtin_amdgcn_sched_barrier(0);
        PU_Q(QA, HA, EA, IA, t0, s)
        __builtin_amdgcn_sched_barrier(0);
        for (; t0 < MLAT; t0 += 2 * tstep, t1 += 2 * tstep) {
            PU_IDX(IA, t0 + 2 * tstep)
            __builtin_amdgcn_sched_barrier(0);
            PU_Q(QB, HB, EB, IB, t1, s)
            __builtin_amdgcn_sched_barrier(0);
            PU_COMPUTE(QA, HA, EA, t0, s)
            __builtin_amdgcn_sched_barrier(0);
            PU_IDX(IB, t1 + 2 * tstep)
            __builtin_amdgcn_sched_barrier(0);
            PU_Q(QA, HA, EA, IA, t0 + 2 * tstep, s)
            __builtin_amdgcn_sched_barrier(0);
            PU_COMPUTE(QB, HB, EB, t1, s)
            __builtin_amdgcn_sched_barrier(0);
        }
    }
#undef PU_IDX
#undef PU_Q
#undef PU_DOT
#undef PU_COMPUTE
}
__device__ __forceinline__ void peer_w_phase(const Params& p, int bid, int nblk) {
    int tid = threadIdx.x; asm volatile("" : "+v"(tid));
    const bf16_t* PART = (const bf16_t*)(p.ws + WS_PART); const float* TOPG = (const float*)(p.ws + WS_TOPG); const int* TOPI = (const int*)(p.ws + WS_TOPI); const float* USC = (const float*)(p.ws + WS_USC);
    signed char* WQ8 = (signed char*)(p.ws + WS_WQ8); float* SW = (float*)(p.ws + WS_SW);
    for (size_t e = (size_t)bid * 512 + tid; e < (size_t)MLAT * 128; e += (size_t)nblk * 512) {
        float d = 0.f;
#pragma unroll
        for (int s = 0; s < 16; ++s) d += bf1(__builtin_nontemporal_load(PART + (size_t)s * MLAT * 128 + e));
        const f32x2 sc = *(const f32x2*)(USC + 2 * TOPI[e]);
        const float wv = TOPG[e] * gelu_tanh(d * sc.x) * sc.y;
        float am = fabsf(wv);
#pragma unroll
        for (int o = 1; o < 16; o <<= 1) am = fmaxf(am, __shfl_xor(am, o));
        const float inv = (am > 1e-30f) ? 127.0f / am : 0.f;
        WQ8[e] = (signed char)max(-127, min(127, __float2int_rn(wv * inv)));
        if ((tid & 15) == 0) SW[e >> 4] = am * (1.0f / 127.0f);
    }
}
__device__ __forceinline__ void peer_v_phase(const Params& p, int bid, int nblk) {
    int tid = threadIdx.x; asm volatile("" : "+v"(tid));
    const int lane = tid & 63, wave = __builtin_amdgcn_readfirstlane(tid >> 6), g = lane >> 3, jj = lane & 7;
    const int nx = (nblk % 8 == 0) ? 8 : 1, x = bid % nx, j = bid / nx, J = nblk / nx;
    const unsigned char* VB = p.ws + WS_VB; const unsigned char* WQ8 = p.ws + WS_WQ8; const float* SW = (const float*)(p.ws + WS_SW); const int* TOPI = (const int*)(p.ws + WS_TOPI);
    const float* MOD = (const float*)(p.ws + WS_MOD); bf16_t* DELTA = (bf16_t*)(p.ws + WS_DELTA);
    const bool b5 = (g & 4) != 0, b4 = (g & 2) != 0, b3 = (g & 1) != 0;
    const int tl = 8 * jj + g;
    const int tstep = J * 8;
#define PV_IDX(I, t_) { const int tt = min((t_), MLAT - 1); I = *(const int2*)(TOPI + (size_t)tt * 128 + 16 * g + 2 * jj); }
#define PV_SB __builtin_amdgcn_sched_barrier(0);
#define PV_ROWS(Q, I, h_) { _Pragma("unroll") for (int i = 8 * (h_); i < 8 * (h_) + 8; ++i) { const unsigned ixi = (unsigned)__shfl((i & 1) ? I.y : I.x, (lane & ~7) | (i >> 1)); Q[i] = *(const u32x4*)(VB + (((unsigned)s * 16384u + ixi) * 128u + 16u * (unsigned)jj)); } }
#define PV_AUX(W, SWv, X, t_) { const int tt = min((t_), MLAT - 1); W##_d = *(const unsigned*)(WQ8 + (size_t)tt * 128 + 16 * g + 4 * (jj & 3)); SWv = SW[(size_t)tt * 8 + g]; }
#define PV_ACC(Q, W, acc, a0_) { _Pragma("unroll") for (int a4 = (a0_); a4 < (a0_) + 2; ++a4) _Pragma("unroll") for (int w = 0; w < 4; ++w) { \
            const unsigned x0 = Q[4 * a4][w], x1 = Q[4 * a4 + 1][w], x2 = Q[4 * a4 + 2][w], x3 = Q[4 * a4 + 3][w]; \
            const unsigned l01 = __builtin_amdgcn_perm(x1, x0, 0x05010400u), h01 = __builtin_amdgcn_perm(x1, x0, 0x07030602u), l23 = __builtin_amdgcn_perm(x3, x2, 0x05010400u), h23 = __builtin_amdgcn_perm(x3, x2, 0x07030602u); \
            acc[4 * w + 0] = __builtin_amdgcn_sdot4((int)__builtin_amdgcn_perm(l23, l01, 0x05040100u), (int)W[a4], acc[4 * w + 0], false); \
            acc[4 * w + 1] = __builtin_amdgcn_sdot4((int)__builtin_amdgcn_perm(l23, l01, 0x07060302u), (int)W[a4], acc[4 * w + 1], false); \
            acc[4 * w + 2] = __builtin_amdgcn_sdot4((int)__builtin_amdgcn_perm(h23, h01, 0x05040100u), (int)W[a4], acc[4 * w + 2], false); \
            acc[4 * w + 3] = __builtin_amdgcn_sdot4((int)__builtin_amdgcn_perm(h23, h01, 0x07060302u), (int)W[a4], acc[4 * w + 3], false); } }
#define PV_FIN(acc, SWv, X, t_) { \
        f32x2 a[8]; _Pragma("unroll") for (int k = 0; k < 8; ++k) a[k] = (f32x2){(float)acc[2 * k] * SWv, (float)acc[2 * k + 1] * SWv}; \
        f32x2 r1[4], r2[2], r3; \
        _Pragma("unroll") for (int k = 0; k < 4; ++k) { f32x2 lo = a[k], hi = a[4 + k]; swap32(lo, hi); r1[k] = lo + hi; }        \
        _Pragma("unroll") for (int k = 0; k < 2; ++k) { f32x2 lo = r1[k], hi = r1[2 + k]; swap16(lo, hi); r2[k] = lo + hi; }        \
        { const f32x2 mine = b3 ? r2[1] : r2[0], send = b3 ? r2[0] : r2[1]; r3 = (f32x2){mine.x + dpp_f<DPP_ROR8>(send.x), mine.y + dpp_f<DPP_ROR8>(send.y)}; } \
        const f32x2 gt = ((t_) < SEQ) ? gt0 : gt1; \
        const f32x2 r3t = (f32x2){__shfl(r3.x, tl), __shfl(r3.y, tl)};        \
        const f32x2 dl = gt * r3t; \
        if ((t_) < MLAT) __builtin_nontemporal_store(pk2(dl.x, dl.y), (unsigned*)(DELTA + (size_t)(t_) * D + col)); }
#define PV_STEP(Q, W, SWv, X, IX, IY, t_) { \
        PV_IDX(IY, (t_) + 3 * tstep) PV_SB \
        int acc[16]; _Pragma("unroll") for (int d = 0; d < 16; ++d) acc[d] = 0; \
        { u32x4 Wv; Wv[0] = (unsigned)dpp_i<0x00>((int)W##_d); Wv[1] = (unsigned)dpp_i<0x55>((int)W##_d); Wv[2] = 0u; Wv[3] = 0u; PV_ACC(Q, Wv, acc, 0) } PV_SB \
        PV_ROWS(Q, IX, 0) PV_SB \
        { u32x4 Wv; Wv[0] = 0u; Wv[1] = 0u; Wv[2] = (unsigned)dpp_i<0xAA>((int)W##_d); Wv[3] = (unsigned)dpp_i<0xFF>((int)W##_d); PV_ACC(Q, Wv, acc, 2) } \
        PV_FIN(acc, SWv, X, t_) PV_SB \
        PV_AUX(W, SWv, X, (t_) + 2 * tstep) PV_ROWS(Q, IX, 1) PV_SB }
    for (int s = x; s < 16; s += nx) {
        const int col = 128 * s + 2 * lane;
        const f32x2 gt0 = *(const f32x2*)(MOD + 5 * 2048 + col), gt1 = *(const f32x2*)(MOD + 12288 + 5 * 2048 + col);
        int t0 = j * 8 + wave, t1 = t0 + tstep;
        int2 IA, IB; u32x4 QA[16], QB[16]; unsigned WA_d, WB_d; float SA, SB;
        PV_IDX(IA, t0) PV_IDX(IB, t1) PV_SB
        PV_ROWS(QA, IA, 0) PV_AUX(WA, SA, XA, t0) PV_ROWS(QA, IA, 1) PV_SB
        PV_IDX(IA, t0 + 2 * tstep) PV_SB
        PV_ROWS(QB, IB, 0) PV_AUX(WB, SB, XB, t1) PV_ROWS(QB, IB, 1) PV_SB
        for (; t0 < MLAT; t0 += 2 * tstep, t1 += 2 * tstep) {
            PV_STEP(QA, WA, SA, XA, IA, IB, t0)
            PV_STEP(QB, WB, SB, XB, IB, IA, t1)
        }
    }
#undef PV_SB
#undef PV_ROWS
#undef PV_AUX
#undef PV_FIN
#undef PV_STEP
#undef PV_IDX
#undef PV_ACC
#undef PV_COMPUTE
}
__device__ __forceinline__ void final_norm_phase(const Params& p, int bid, int nblk) {
    int tid = threadIdx.x; asm volatile("" : "+v"(tid));
    const int lane = tid & 63, wave = __builtin_amdgcn_readfirstlane(tid >> 6);
    const bf16_t* XL = (const bf16_t*)(p.ws + WS_YL); const bf16_t* DELTA = (const bf16_t*)(p.ws + WS_DELTA);
    f32x4 fgv[8];
#pragma unroll
    for (int jx = 0; jx < 8; ++jx) fgv[jx] = *((const f32x4*)p.fg + lane + 64 * jx);
    for (int row = bid * 8 + wave; row < MLAT; row += nblk * 8) {
        u32x2 xa[8], da[8];
#pragma unroll
        for (int jx = 0; jx < 8; ++jx) { xa[jx] = __builtin_nontemporal_load((const u32x2*)(XL + (size_t)row * D) + lane + 64 * jx); da[jx] = __builtin_nontemporal_load((const u32x2*)(DELTA + (size_t)row * D) + lane + 64 * jx); }
        f32x4 v[8]; float ss = 0.f;
#pragma unroll
        for (int jx = 0; jx < 8; ++jx) { v[jx] = (f32x4){bflo(xa[jx].x) + bflo(da[jx].x), bfhi(xa[jx].x) + bfhi(da[jx].x), bflo(xa[jx].y) + bflo(da[jx].y), bfhi(xa[jx].y) + bfhi(da[jx].y)};
            ss += (v[jx][0] * v[jx][0] + v[jx][1] * v[jx][1]) + (v[jx][2] * v[jx][2] + v[jx][3] * v[jx][3]); }
        const float r2 = rsqrtf(wave_sum(ss) * (1.0f / 2048.0f) + EPS);
        f32x4* xr = (f32x4*)(p.out + (size_t)row * D);
#pragma unroll
        for (int jx = 0; jx < 8; ++jx) __builtin_nontemporal_store(v[jx] * r2 * fgv[jx], xr + lane + 64 * jx);
    }
}

#define XB_TMO      128
#define XB_XCNT(j)  (256  + 64 * (j))
#define XB_XSUB(j)  (1280 + 64 * (j))
#define XB_XGEN(j)  (2304 + 64 * (j))
#define XB_TOP      3328
#define XB_TOPGEN   3392
#define XCD_BAR_WORDS 3456
#define XB_SPIN_CAP (1u << 20)
__device__ __forceinline__ unsigned xb_ld(unsigned* p)              { return __hip_atomic_load(p, __ATOMIC_RELAXED, __HIP_MEMORY_SCOPE_AGENT); }
__device__ __forceinline__ unsigned xb_add(unsigned* p, unsigned v) { return __hip_atomic_fetch_add(p, v, __ATOMIC_RELAXED, __HIP_MEMORY_SCOPE_AGENT); }
__device__ __forceinline__ unsigned xb_xcc_id() { return (unsigned)__builtin_amdgcn_s_getreg((3 << 11) | 20) & 0xFu; }
#define XB_SPIN(cond, bar) do { unsigned _sp = 0; while (cond) { __builtin_amdgcn_s_sleep(1); \
    if ((++_sp & 255u) == 0u) { if (xb_ld(&(bar)[XB_TMO])) break; if (_sp > XB_SPIN_CAP) { atomicAdd(&(bar)[XB_TMO], 1u); break; } } } } while (0)
struct XcdBarrier { unsigned* bar; unsigned x; volatile LAS unsigned* st; };
__device__ __forceinline__ XcdBarrier xcd_barrier_post(unsigned* bar, volatile LAS unsigned* st) {
    XcdBarrier b; b.bar = bar; b.x = xb_xcc_id(); b.st = st;
    if (threadIdx.x == 0) (void)xb_add(&bar[XB_XCNT(b.x)], 1u);
    return b;
}
__device__ __forceinline__ void xcd_barrier_complete(unsigned* bar, unsigned x, unsigned& nloc, unsigned& nx) {
    const unsigned G = gridDim.x * gridDim.y * gridDim.z;
    unsigned sum, cnt, mine, sp = 0u;
    for (;;) {
        sum = 0u; cnt = 0u; mine = 0u;
#pragma unroll
        for (unsigned j = 0; j < 16; ++j) { const unsigned c = xb_ld(&bar[XB_XCNT(j)]); sum += c; cnt += (c > 0u) ? 1u : 0u; mine = (j == x) ? c : mine; }
        if (sum == G) break;
        __builtin_amdgcn_s_sleep(1);
        if ((++sp & 255u) == 0u) { if (xb_ld(&bar[XB_TMO])) break; if (sp > XB_SPIN_CAP) { atomicAdd(&bar[XB_TMO], 1u); break; } }
    }
    nloc = mine > 0u ? mine : 1u; nx = cnt > 0u ? cnt : 1u;
}
__device__ __forceinline__ void xcd_barrier(const XcdBarrier& b) {
    asm volatile("s_waitcnt vmcnt(0)" ::: "memory");
    __syncthreads();
    if (threadIdx.x == 0) {
        unsigned* bar = b.bar;
        __builtin_amdgcn_s_waitcnt(0);
        unsigned nloc = b.st[0], nx = b.st[1];
        if (nloc == 0u) { xcd_barrier_complete(bar, b.x, nloc, nx); b.st[0] = nloc; b.st[1] = nx; }
        const unsigned old = xb_add(&bar[XB_XSUB(b.x)], 1u);
        const unsigned gen = old / nloc;
        if (old + 1u == (gen + 1u) * nloc) {
            __builtin_amdgcn_fence(__ATOMIC_RELEASE, "agent");
            asm volatile("s_waitcnt vmcnt(0)" ::: "memory");
            const unsigned og = xb_add(&bar[XB_TOP], 1u);
            const unsigned tg = og / nx;
            if (og + 1u == (tg + 1u) * nx) xb_add(&bar[XB_TOPGEN], 1u);
            else XB_SPIN(xb_ld(&bar[XB_TOPGEN]) == tg, bar);
            __builtin_amdgcn_fence(__ATOMIC_ACQUIRE, "agent");
            xb_add(&bar[XB_XGEN(b.x)], 1u);
            asm volatile("s_waitcnt vmcnt(0)" ::: "memory");
        } else {
            XB_SPIN(xb_ld(&bar[XB_XGEN(b.x)]) == gen, bar);
            __builtin_amdgcn_fence(__ATOMIC_ACQUIRE, "agent");
            asm volatile("s_waitcnt vmcnt(0)" ::: "memory");
        }
    }
    __syncthreads();
}

__global__ void __launch_bounds__(512, 2) k_main(Params p, int ph_lo, int ph_hi) {
    extern __shared__ __attribute__((aligned(16))) unsigned char lds[];
    const int bid = blockIdx.x, nblk = gridDim.x;
#if FUSED
    cg::grid_group grid = cg::this_grid();
    volatile LAS unsigned* bst = (volatile LAS unsigned*)((LAS unsigned char*)lds + (LDS_BYTES - 64));
    if (threadIdx.x < 2) bst[threadIdx.x] = 0u;
    __syncthreads();
    const XcdBarrier xbar = xcd_barrier_post((unsigned*)(p.ws + WS_CTL), bst);
#define SYNC_AFTER(k) if ((k) + 1 < ph_hi) { if (ph_lo < 0) grid.sync(); else xcd_barrier(xbar); }
#else
#define SYNC_AFTER(k)
#endif
#define IN(k) (ph_lo <= (k) && (k) < ph_hi)
    if (IN(0)) { phase0(p, lds, bid, nblk); SYNC_AFTER(0) }
    if (IN(1)) { phase_norm1(p, lds, bid, nblk); SYNC_AFTER(1) }
#if !G1_I8
    if (IN(2)) { pg8::Gemm g{(const bf16_t*)(p.ws + WS_HN), (const bf16_t*)(p.ws + WS_WIN), MALL, INW, D, 1, 0, 0}; pg8::StaticOrder S; S.init(MALL, INW, nblk, bid);
                 pg8::EpiBf16 E{(bf16_t*)(p.ws + WS_PROJ), INW}; pg8::gemm_phase<pg8::EpiBf16>((LAS unsigned char*)lds, g, S, E); SYNC_AFTER(2) }
#else
    if (IN(2)) { pg8::Gemm g{(const bf16_t*)(p.ws + WS_HN), (const bf16_t*)(p.ws + WS_WIN3), MALL, INW, D / 2, 64, 2, (size_t)4096 * 2048}; pg8::StaticOrder S; S.init(CTX_SPLIT ? MLAT : MALL, INW, nblk, bid);
                 pg8::EpiI8BiasBf16 E{(bf16_t*)(p.ws + WS_PROJ), INW, (const float*)(p.ws + WS_RS1), (const float*)(p.ws + WS_CS1), (const float*)(p.ws + WS_BIAS1)}; pg8::gemm_phase<pg8::EpiI8BiasBf16>((LAS unsigned char*)lds, g, S, E); SYNC_AFTER(2) }
#endif
    if (IN(3)) {
#if G1_I8 && CTX_SPLIT
        if (bid < 8) { pg8::Gemm g{(const bf16_t*)(p.ws + WS_HN), (const bf16_t*)(p.ws + WS_WIN3), MALL, INW, D / 2, 64, 2, (size_t)4096 * 2048}; pg8::StaticOrder S; S.init(MALL, INW, nblk, bid); S.fpm = 128 + (bid >> 2); S.fpn = bid & 3;
            pg8::EpiI8BiasBf16 E{(bf16_t*)(p.ws + WS_PROJ), INW, (const float*)(p.ws + WS_RS1), (const float*)(p.ws + WS_CS1), (const float*)(p.ws + WS_BIAS1)}; pg8::gemm_phase<pg8::EpiI8BiasBf16>((LAS unsigned char*)lds, g, S, E);
            asm volatile("s_waitcnt vmcnt(0)" ::: "memory");
            __syncthreads();
            if (threadIdx.x == 0) { __builtin_amdgcn_fence(__ATOMIC_RELEASE, "agent"); asm volatile("s_waitcnt vmcnt(0)" ::: "memory"); (void)xb_add((unsigned*)(p.ws + WS_CTL + CTXDONE_OFS), 1u); }
            __syncthreads(); }
#endif
        lru_phase<false>(p, lds, bid, nblk); SYNC_AFTER(3) }
    if (IN(4)) { carry_phase(p, bid, nblk); sgu_phase(p, lds, bid, nblk); SYNC_AFTER(4) }
    if (IN(5)) { lru_phase<true>(p, lds, bid, nblk); SYNC_AFTER(5) }
    if (IN(6)) { pg8::Gemm g{(const bf16_t*)(p.ws + WS_HN), (const bf16_t*)(p.ws + WS_WOUT), MLAT, D, D, 1, 0, 0}; pg8::StaticOrder S; S.init(MLAT, D, nblk, bid);
                 pg8::EpiXlatBf16 E{(bf16_t*)(p.ws + WS_YL), D, (const float*)(p.ws + WS_MOD) + 2 * 2048, 12288, SEQ, p.x}; pg8::gemm_phase<pg8::EpiXlatBf16>((LAS unsigned char*)lds, g, S, E); SYNC_AFTER(6) }
    if (IN(7)) { phase_norm2(p, bid, nblk); SYNC_AFTER(7) }
#if G3_I8
    if (IN(8)) { pg8::Gemm g{(const bf16_t*)(p.ws + WS_HN8), (const bf16_t*)(p.ws + WS_WQ), MLAT, D, D / 2, 1, 0, 0}; pg8::StaticOrder S; S.init(MLAT, D, nblk, bid);
                 pg8::EpiI8Bf16 E{(bf16_t*)(p.ws + WS_PROJ), D, (const float*)(p.ws + WS_HSC), (const unsigned*)(p.ws + WS_COLMAX_Q)}; pg8::gemm_phase<pg8::EpiI8Bf16>((LAS unsigned char*)lds, g, S, E); SYNC_AFTER(8) }
#else
    if (IN(8)) { pg8::Gemm g{(const bf16_t*)(p.ws + WS_HN), (const bf16_t*)(p.ws + WS_WQ), MLAT, D, D, 1, 0, 0}; pg8::StaticOrder S; S.init(MLAT, D, nblk, bid);
                 pg8::EpiBf16 E{(bf16_t*)(p.ws + WS_PROJ), D}; pg8::gemm_phase<pg8::EpiBf16>((LAS unsigned char*)lds, g, S, E); SYNC_AFTER(8) }
#endif
    if (IN(9)) { topk_phase(p, lds, bid, nblk); SYNC_AFTER(9) }
    if (IN(10)) { peer_u_phase(p, bid, nblk); SYNC_AFTER(10) }
    if (IN(11)) { peer_w_phase(p, bid, nblk); SYNC_AFTER(11) }
    if (IN(12)) { peer_v_phase(p, bid, nblk); SYNC_AFTER(12) }
    if (IN(13)) { final_norm_phase(p, bid, nblk); }
#undef IN
}

extern "C" void kernel_launch(void* const* d_in, const int* in_sizes, int n_in, void* d_out, int out_size, void* d_ws, size_t ws_size, hipStream_t stream) {
    static int grid = 0;
    if (grid == 0) {
        if (n_in != 25 || out_size != MLAT * D || ws_size < WS_END) { fprintf(stderr, "kernel_launch: unexpected shapes (n_in %d out %d ws %zu)\n", n_in, out_size, ws_size); grid = -1; return; }
        int dev = 0, cus = 0, per_cu = 0;
        hipGetDevice(&dev); hipDeviceGetAttribute(&cus, hipDeviceAttributeMultiprocessorCount, dev);
        if (hipFuncSetAttribute((const void*)k_main, hipFuncAttributeMaxDynamicSharedMemorySize, LDS_BYTES) != hipSuccess) { fprintf(stderr, "kernel_launch: hipFuncSetAttribute failed\n"); grid = -1; return; }
        hipOccupancyMaxActiveBlocksPerMultiprocessor(&per_cu, (const void*)k_main, 512, LDS_BYTES);
        if (per_cu < 1) { fprintf(stderr, "kernel_launch: occupancy query says %d blocks per CU\n", per_cu); per_cu = 1; }
        (void)hipGetLastError();
        grid = cus * 1;
    }
    if (grid < 0) return;
    Params p{};
    const float** pp = (const float**)&p;
    for (int i = 0; i < 25; ++i) pp[i] = (const float*)d_in[i];
    p.out = (float*)d_out; p.ws = (unsigned char*)d_ws;
#if FUSED
    hipMemsetAsync((char*)d_ws + WS_CTL, 0, 131072, stream);
    int lo = 0, hi = NPHASES;
    void* args[] = {&p, &lo, &hi};
    hipError_t e = hipLaunchCooperativeKernel((const void*)k_main, dim3(grid), dim3(512), args, LDS_BYTES, stream);
    if (e != hipSuccess) fprintf(stderr, "cooperative launch failed: %s (grid %d)\n", hipGetErrorString(e), grid);
#else
    for (int ph = 0; ph < NPHASES; ++ph) hipLaunchKernelGGL(k_main, dim3(grid), dim3(512), LDS_BYTES, stream, p, ph, ph + 1);
#endif
}
```

```cpp
#include <hip/hip_runtime.h>
#include <hip/hip_cooperative_groups.h>
#include <cstdio>
#include <cstdint>

#ifndef G3_I8
#define G3_I8 1
#endif
#ifndef G1_I8
#define G1_I8 1
#endif
#ifndef U_MODE
#define U_MODE 1
#endif
#ifndef V_MODE
#define V_MODE 1
#endif
#ifndef FUSED
#define FUSED 1
#endif
#ifndef CTX_SPLIT
#define CTX_SPLIT 1
#endif
#ifndef GATE_STORE
#define GATE_STORE 1
#endif
#ifndef MERGE45
#define MERGE45 1
#endif
#define CARRYDONE_OFS 45696
#define CTXDONE_OFS 45568

namespace cg = cooperative_groups;

typedef unsigned short bf16_t;
typedef short bf16x8 __attribute__((ext_vector_type(8)));
typedef float f32x4 __attribute__((ext_vector_type(4)));
typedef float f32x2 __attribute__((ext_vector_type(2)));
typedef unsigned u32x4 __attribute__((ext_vector_type(4)));
typedef unsigned u32x2 __attribute__((ext_vector_type(2)));
typedef int i32x4 __attribute__((ext_vector_type(4)));
typedef __bf16 bf16x2_t __attribute__((ext_vector_type(2)));
#define LAS __attribute__((address_space(3)))

constexpr int D = 2048, SEQ = 16384, CTXL = 256;
constexpr int MLAT = 2 * SEQ, MCTX = 2 * CTXL, MALL = MLAT + MCTX;
constexpr int INW = 4096;
constexpr int NSEG = 130;
constexpr float EPS = 1e-6f;

constexpr size_t MiB = 1u << 20;
constexpr size_t WS_CTL = 0;
constexpr size_t WS_MOD = 1 * MiB;
constexpr size_t WS_SP = 1 * MiB + 512 * 1024;
constexpr size_t WS_USC = 2 * MiB;
constexpr size_t WS_WIN = 4 * MiB;
constexpr size_t WS_WOUT = 20 * MiB;
constexpr size_t WS_WQ = 28 * MiB;
constexpr size_t WS_SGUW = 36 * MiB;
constexpr size_t WS_K1 = 36 * MiB + 256 * 1024;
constexpr size_t WS_K2 = 36 * MiB + 512 * 1024;
constexpr size_t WS_LRUW = 37 * MiB;
constexpr size_t WS_SUMS = 38 * MiB;
constexpr size_t WS_UB = 44 * MiB;
constexpr size_t WS_VB = 108 * MiB;
constexpr size_t WS_HN = 172 * MiB;
constexpr size_t WS_PROJ = 302 * MiB;
constexpr size_t WS_TOPI = 562 * MiB;
constexpr size_t WS_TOPG = 578 * MiB;
constexpr size_t WS_COLMAX_IN = 65536;
constexpr size_t WS_COLMAX_Q = 65536 + 16384;
constexpr size_t WS_RS1 = 600 * MiB + 262144;
constexpr size_t WS_HSC = 600 * MiB;
constexpr size_t WS_SW = 601 * MiB;
constexpr size_t WS_WQ8 = 602 * MiB;
constexpr size_t WS_HN8 = 608 * MiB;
constexpr size_t WS_WIN3 = 672 * MiB;
constexpr size_t WS_CS1 = 600 * MiB + 524288;
constexpr size_t WS_BIAS1 = 600 * MiB + 589824;
constexpr size_t WS_YL = 696 * MiB;
constexpr size_t WS_END = 824 * MiB;

constexpr int LDS_BYTES = 159744;
constexpr int NPHASES = 14;

struct Params {
    const float *x, *c, *ctx, *c_ctx, *w_mod, *b_mod, *g1, *g2, *w_in, *conv_w, *conv_b, *lru_wa, *lru_ba, *lru_wx, *lru_bx, *lru_lam,
        *sgu_w, *sgu_b, *w_out, *wq, *k1, *k2, *pu, *pv, *fg;
    float* out;
    unsigned char* ws;
    int gate_store;
};

__device__ __forceinline__ unsigned f2bf(float f) { unsigned u = __builtin_bit_cast(unsigned, f); return (u + 0x7fffu + ((u >> 16) & 1u)) >> 16; }
__device__ __forceinline__ unsigned pk2(float lo, float hi) { return f2bf(lo) | (f2bf(hi) << 16); }
__device__ __forceinline__ float bflo(unsigned u) { return __builtin_bit_cast(float, u << 16); }
__device__ __forceinline__ float bfhi(unsigned u) { return __builtin_bit_cast(float, u & 0xffff0000u); }
__device__ __forceinline__ float bf1(bf16_t u) { return __builtin_bit_cast(float, (unsigned)u << 16); }
__device__ __forceinline__ float sigmoidf_(float x) { return __builtin_amdgcn_rcpf(1.0f + __expf(-x)); }
__device__ __forceinline__ float gelu_tanh(float x) {
    const float t = x * x; const float q = x * fmaf(t, -0.1029432395800235f, -2.302208198144325f);
    return x * __builtin_amdgcn_rcpf(1.0f + __builtin_amdgcn_exp2f(q));
}
template <int CTRL> __device__ __forceinline__ int dpp_i(int v) { return __builtin_amdgcn_update_dpp(0, v, CTRL, 0xf, 0xf, true); }
__device__ __forceinline__ int dot4_first(unsigned a, unsigned b) { int r; asm("v_dot4_i32_i8 %0, %1, %2, 0" : "=v"(r) : "v"(a), "v"(b)); return r; }
template <int CTRL, int BANK> __device__ __forceinline__ int dpp_bank(int v) { return __builtin_amdgcn_update_dpp(v, v, CTRL, 0xf, BANK, false); }
#define GROUP_HALF(I, h_, hx, hy) const int hx = (h_) ? dpp_bank<0x104, 0x5>(I.x << 7) : dpp_bank<0x114, 0xA>(I.x << 7), hy = (h_) ? dpp_bank<0x104, 0x5>(I.y << 7) : dpp_bank<0x114, 0xA>(I.y << 7);
template <int CTRL> __device__ __forceinline__ float dpp_f(float v) { return __builtin_bit_cast(float, __builtin_amdgcn_update_dpp(0, __builtin_bit_cast(int, v), CTRL, 0xf, 0xf, true)); }
constexpr int DPP_XOR1 = 0xB1, DPP_XOR2 = 0x4E, DPP_HMIRROR = 0x141, DPP_MIRROR = 0x140, DPP_ROR8 = 0x128;
__device__ __forceinline__ void swap16(float& a, float& b) { asm("s_nop 1\n\tv_permlane16_swap_b32 %0, %1" : "+v"(a), "+v"(b)); }
__device__ __forceinline__ void swap32(float& a, float& b) { asm("s_nop 1\n\tv_permlane32_swap_b32 %0, %1" : "+v"(a), "+v"(b)); }
__device__ __forceinline__ void swap16(int& a, int& b) { asm("s_nop 1\n\tv_permlane16_swap_b32 %0, %1" : "+v"(a), "+v"(b)); }
__device__ __forceinline__ void swap32(int& a, int& b) { asm("s_nop 1\n\tv_permlane32_swap_b32 %0, %1" : "+v"(a), "+v"(b)); }
__device__ __forceinline__ void swap16(f32x2& a, f32x2& b) { float ax = a.x, ay = a.y, bx = b.x, by = b.y; swap16(ax, bx); swap16(ay, by); a = (f32x2){ax, ay}; b = (f32x2){bx, by}; }
__device__ __forceinline__ void swap32(f32x2& a, f32x2& b) { float ax = a.x, ay = a.y, bx = b.x, by = b.y; swap32(ax, bx); swap32(ay, by); a = (f32x2){ax, ay}; b = (f32x2){bx, by}; }
__device__ __forceinline__ float wave_sum(float v) {
    v += dpp_f<DPP_XOR1>(v); v += dpp_f<DPP_XOR2>(v); v += dpp_f<DPP_HMIRROR>(v); v += dpp_f<DPP_MIRROR>(v);
    { float a = v, b = v; swap16(a, b); v = a + b; }
    { float a = v, b = v; swap32(a, b); v = a + b; }
    return v;
}
__device__ __forceinline__ void row_bcast4(float v, float& r0, float& r1, float& r2, float& r3) {
    float a = v, b = v; swap16(a, b);
    float a2 = a, b2 = b;
    swap32(a, a2); swap32(b, b2);
    r0 = a; r1 = b; r2 = a2; r3 = b2;
}
__device__ __forceinline__ unsigned q8pack(f32x4 x) {
    const int a = max(-127, min(127, __float2int_rn(x[0]))), b = max(-127, min(127, __float2int_rn(x[1]))), c = max(-127, min(127, __float2int_rn(x[2]))), d = max(-127, min(127, __float2int_rn(x[3])));
    return (unsigned)(a & 255) | ((unsigned)(b & 255) << 8) | ((unsigned)(c & 255) << 16) | ((unsigned)(d & 255) << 24);
}
__device__ __forceinline__ float sb(unsigned w, int k) { return (float)(signed char)((w >> (8 * k)) & 255u); }
__device__ __forceinline__ int mono(float v) { int b = __builtin_bit_cast(int, v); return b ^ ((b >> 31) & 0x7fffffff); }
__device__ __forceinline__ float unmono(int m) { int b = m ^ ((m >> 31) & 0x7fffffff); return __builtin_bit_cast(float, b); }

namespace pg8 {
constexpr int BM = 256, BK = 64, HALF = 128, HTB = HALF * BK * 2, STAGE_BYTES = 8 * HTB, NXCD = 8, WGM = 8;
__host__ __device__ __forceinline__ int lds_byte(int r, int c) { const int st = (r >> 4) * 2 + (c >> 5), rr = r & 15, cc = c & 31, ob = rr * 64 + cc * 2; return st * 1024 + (ob ^ (((ob >> 9) & 1) << 5)); }
__host__ __device__ __forceinline__ void stage_rc(int b, int& R, int& C) { const int st = b / 1024, sb = b % 1024, swz = sb ^ (((sb >> 9) & 1) << 5); R = (st >> 1) * 16 + swz / 64; C = (st & 1) * 32 + (swz % 64) / 2; }
__host__ __device__ __forceinline__ int perm32(int rho) { const int n = rho >> 4, i = rho & 15; return 8 * (i >> 2) + 4 * n + (i & 3); }
struct Unit { int pm, pn; };
struct Gemm { const bf16_t* A; const bf16_t* Bt; int M, N, K; int bt_tiles; int bt_max; size_t bt_stride;
    __device__ __forceinline__ size_t bsel(int pm) const { return bt_stride ? (size_t)((pm / bt_tiles) < bt_max ? (pm / bt_tiles) : bt_max) * bt_stride : (size_t)0; } };
struct StaticOrder {
    int nM, nN, nwg, G, c; int fpm = -1, fpn = 0;
    __host__ __device__ void init(int M, int N, int G_, int c_) { nM = M / BM; nN = N / BM; nwg = nM * nN; G = G_; c = c_; }
    __host__ __device__ bool next(int i, Unit& u) const {
        if (fpm >= 0) { if (i > 0) return false; u.pm = fpm; u.pn = fpn; return true; }
        const long L = (long)i * G + c; if (L >= nwg) return false;
        int wgid = (int)L; { const int q = nwg / NXCD, r = nwg % NXCD, xcd = wgid % NXCD, off = wgid / NXCD; wgid = (xcd < r ? xcd * (q + 1) : r * (q + 1) + (xcd - r) * q) + off; }
        const int nig = WGM * nN, gid = wgid / nig, fm = gid * WGM, gsz = (nM - fm) < WGM ? (nM - fm) : WGM;
        u.pm = fm + ((wgid % nig) % gsz); u.pn = (wgid % nig) / gsz; return true;
    }
};
__device__ __forceinline__ unsigned cvt_pk_bf16(float lo, float hi) { unsigned r; asm volatile("v_cvt_pk_bf16_f32 %0, %1, %2" : "=v"(r) : "v"(lo), "v"(hi)); return r; }

__device__ __forceinline__ u32x4 epi_tr(u32x4 w, int src4) { u32x4 r; r.x = (unsigned)__builtin_amdgcn_ds_bpermute(src4, (int)w.x); r.y = (unsigned)__builtin_amdgcn_ds_bpermute(src4, (int)w.y); r.z = (unsigned)__builtin_amdgcn_ds_bpermute(src4, (int)w.z); r.w = (unsigned)__builtin_amdgcn_ds_bpermute(src4, (int)w.w); return r; }
#define EPI_TR_SETUP const int lane_ = fq * 16 + fr, fr2 = lane_ >> 2, fq2 = lane_ & 3, src4 = 4 * (fq2 * 16 + fr2); const long trofs = (long)(fr2 - fr) * ldc + 8 * (fq2 - fq);
struct EpiI8Bf16 {
    static constexpr bool PERM = true, I8 = true; typedef i32x4 acc_t;
    bf16_t* O; int ldc; const float* rs; const unsigned* cmax;
    __device__ __forceinline__ void operator()(const i32x4 (&acc)[2][2][4][2], const Unit& u, int wr, int wc, int fr, int fq) const {
        const int row0 = u.pm * BM + wr * 64 + fr; const int col0 = u.pn * BM + wc * 64 + 8 * fq;
        EPI_TR_SETUP
        f32x4 cs[2][2];
#pragma unroll
        for (int bj = 0; bj < 2; ++bj)
#pragma unroll
            for (int n = 0; n < 2; ++n) { const u32x4 cm = *(const u32x4*)(cmax + col0 + bj * 32 + 4 * n);
                cs[bj][n] = (f32x4){__builtin_bit_cast(float, cm[0]), __builtin_bit_cast(float, cm[1]), __builtin_bit_cast(float, cm[2]), __builtin_bit_cast(float, cm[3])} * (1.0f / 127.0f); }
        float rsa[2][4];
#pragma unroll
        for (int ai = 0; ai < 2; ++ai)
#pragma unroll
            for (int m = 0; m < 4; ++m) rsa[ai][m] = rs[row0 + ai * HALF + m * 16];
        __builtin_amdgcn_sched_barrier(0);
        u32x4 tq = {0u, 0u, 0u, 0u}; bf16_t* pq = nullptr; bool pend = false;
#pragma unroll
        for (int ai = 0; ai < 2; ++ai)
#pragma unroll
            for (int m = 0; m < 4; ++m) { const int row = row0 + ai * HALF + m * 16; const float rsv = rsa[ai][m]; bf16_t* rowp = O + (size_t)row * ldc + col0;
#pragma unroll
                for (int bj = 0; bj < 2; ++bj) { const i32x4 a0 = acc[ai][bj][m][0], a1 = acc[ai][bj][m][1];
                    const f32x4 v0 = (f32x4){(float)a0[0], (float)a0[1], (float)a0[2], (float)a0[3]} * cs[bj][0] * rsv, v1 = (f32x4){(float)a1[0], (float)a1[1], (float)a1[2], (float)a1[3]} * cs[bj][1] * rsv;
                    u32x4 w; w.x = cvt_pk_bf16(v0[0], v0[1]); w.y = cvt_pk_bf16(v0[2], v0[3]); w.z = cvt_pk_bf16(v1[0], v1[1]); w.w = cvt_pk_bf16(v1[2], v1[3]);
                    const u32x4 t = epi_tr(w, src4);
                    if (pend) *(u32x4*)pq = tq;
                    tq = t; pq = rowp + trofs + bj * 32; pend = true; } }
        *(u32x4*)pq = tq;
    }
};
struct EpiI8BiasBf16 {
    static constexpr bool PERM = true, I8 = true; typedef i32x4 acc_t;
    bf16_t* O; int ldc; const float* rs; const float* cs; const float* bias;
    __device__ __forceinline__ void operator()(const i32x4 (&acc)[2][2][4][2], const Unit& u, int wr, int wc, int fr, int fq) const {
        const int row0 = u.pm * BM + wr * 64 + fr; const int col0 = u.pn * BM + wc * 64 + 8 * fq;        const int v = (u.pm / 64) < 2 ? (u.pm / 64) : 2;
        EPI_TR_SETUP
        f32x4 csv[2][2], bv[2][2];
#pragma unroll
        for (int bj = 0; bj < 2; ++bj)
#pragma unroll
            for (int n = 0; n < 2; ++n) { csv[bj][n] = *(const f32x4*)(cs + v * 4096 + col0 + bj * 32 + 4 * n); bv[bj][n] = *(const f32x4*)(bias + v * 4096 + col0 + bj * 32 + 4 * n); }
        float rsa[2][4];
#pragma unroll
        for (int ai = 0; ai < 2; ++ai)
#pragma unroll
            for (int m = 0; m < 4; ++m) rsa[ai][m] = rs[row0 + ai * HALF + m * 16];
        __builtin_amdgcn_sched_barrier(0);
        u32x4 tq = {0u, 0u, 0u, 0u}; bf16_t* pq = nullptr; bool pend = false;
#pragma unroll
        for (int ai = 0; ai < 2; ++ai)
#pragma unroll
            for (int m = 0; m < 4; ++m) { const int row = row0 + ai * HALF + m * 16; const float rsv = rsa[ai][m]; bf16_t* rowp = O + (size_t)row * ldc + col0;
#pragma unroll
                for (int bj = 0; bj < 2; ++bj) { const i32x4 a0 = acc[ai][bj][m][0], a1 = acc[ai][bj][m][1];
                    const f32x4 v0 = (f32x4){(float)a0[0], (float)a0[1], (float)a0[2], (float)a0[3]} * csv[bj][0] * rsv + bv[bj][0], v1 = (f32x4){(float)a1[0], (float)a1[1], (float)a1[2], (float)a1[3]} * csv[bj][1] * rsv + bv[bj][1];
                    u32x4 w; w.x = cvt_pk_bf16(v0[0], v0[1]); w.y = cvt_pk_bf16(v0[2], v0[3]); w.z = cvt_pk_bf16(v1[0], v1[1]); w.w = cvt_pk_bf16(v1[2], v1[3]);
                    const u32x4 t = epi_tr(w, src4);
                    if (pend) *(u32x4*)pq = tq;
                    tq = t; pq = rowp + trofs + bj * 32; pend = true; } }
        *(u32x4*)pq = tq;
    }
};
struct EpiBf16 {
    static constexpr bool PERM = true, I8 = false; typedef f32x4 acc_t;
    bf16_t* O; int ldc;
    __device__ __forceinline__ void operator()(const f32x4 (&acc)[2][2][4][2], const Unit& u, int wr, int wc, int fr, int fq) const {
        const int row0 = u.pm * BM + wr * 64 + fr; const int col0 = u.pn * BM + wc * 64 + 8 * fq;
#pragma unroll
        for (int ai = 0; ai < 2; ++ai)
#pragma unroll
            for (int m = 0; m < 4; ++m) { bf16_t* rowp = O + (size_t)(row0 + ai * HALF + m * 16) * ldc + col0;
#pragma unroll
                for (int bj = 0; bj < 2; ++bj) { const f32x4 v0 = acc[ai][bj][m][0], v1 = acc[ai][bj][m][1];
                    u32x4 w; w.x = cvt_pk_bf16(v0[0], v0[1]); w.y = cvt_pk_bf16(v0[2], v0[3]); w.z = cvt_pk_bf16(v1[0], v1[1]); w.w = cvt_pk_bf16(v1[2], v1[3]);
                    *(u32x4*)(rowp + bj * 32) = w; } }
    }
};
struct EpiGateBf16 {
    static constexpr bool PERM = true, I8 = false; typedef f32x4 acc_t;
    bf16_t* O; int ldc; const float* gate; int gate_stride; int rows_per_batch;
    __device__ __forceinline__ void operator()(const f32x4 (&acc)[2][2][4][2], const Unit& u, int wr, int wc, int fr, int fq) const {
        const int row0 = u.pm * BM + wr * 64 + fr; const int col0 = u.pn * BM + wc * 64 + 8 * fq;
        EPI_TR_SETUP
        const int bsel = (u.pm * BM) / rows_per_batch;
        f32x4 gv[2][2];
#pragma unroll
        for (int bj = 0; bj < 2; ++bj)
#pragma unroll
            for (int n = 0; n < 2; ++n) gv[bj][n] = *(const f32x4*)(gate + (size_t)bsel * gate_stride + col0 + bj * 32 + 4 * n);
        u32x4 tq = {0u, 0u, 0u, 0u}; bf16_t* pq = nullptr; bool pend = false;
#pragma unroll
        for (int ai = 0; ai < 2; ++ai)
#pragma unroll
            for (int m = 0; m < 4; ++m) { bf16_t* rowp = O + (size_t)(row0 + ai * HALF + m * 16) * ldc + col0;
#pragma unroll
                for (int bj = 0; bj < 2; ++bj) { const f32x4 v0 = acc[ai][bj][m][0] * gv[bj][0], v1 = acc[ai][bj][m][1] * gv[bj][1];
                    u32x4 w; w.x = cvt_pk_bf16(v0[0], v0[1]); w.y = cvt_pk_bf16(v0[2], v0[3]); w.z = cvt_pk_bf16(v1[0], v1[1]); w.w = cvt_pk_bf16(v1[2], v1[3]);
                    const u32x4 t = epi_tr(w, src4);
                    if (pend) *(u32x4*)pq = tq;
                    tq = t; pq = rowp + trofs + bj * 32; pend = true; } }
        *(u32x4*)pq = tq;
    }
};
struct EpiXlatBf16 {
    static constexpr bool PERM = true, I8 = false; typedef f32x4 acc_t;
    bf16_t* O; int ldc; const float* gate; int gate_stride; int rows_per_batch; const float* base;
    __device__ __forceinline__ void operator()(const f32x4 (&acc)[2][2][4][2], const Unit& u, int wr, int wc, int fr, int fq) const {
        const int row0 = u.pm * BM + wr * 64 + fr; const int col0 = u.pn * BM + wc * 64 + 8 * fq;
        EPI_TR_SETUP
        const int bsel = (u.pm * BM) / rows_per_batch;
        f32x4 gv[2][2];
#pragma unroll
        for (int bj = 0; bj < 2; ++bj)
#pragma unroll
            for (int n = 0; n < 2; ++n) gv[bj][n] = *(const f32x4*)(gate + (size_t)bsel * gate_stride + col0 + bj * 32 + 4 * n);
#pragma unroll
        for (int ai = 0; ai < 2; ++ai) {
            f32x4 xb[4][2][2];
#pragma unroll
            for (int m = 0; m < 4; ++m)
#pragma unroll
                for (int bj = 0; bj < 2; ++bj) { const size_t off = (size_t)(row0 + ai * HALF + m * 16) * ldc + col0 + trofs; xb[m][bj][0] = *(const f32x4*)(base + off + bj * 32); xb[m][bj][1] = *(const f32x4*)(base + off + bj * 32 + 4); }
            __builtin_amdgcn_sched_barrier(0);
            u32x4 tq = {0u, 0u, 0u, 0u}; f32x4 pb0 = {0.f, 0.f, 0.f, 0.f}, pb1 = pb0; bf16_t* pq = nullptr; bool pend = false;
#pragma unroll
            for (int m = 0; m < 4; ++m) { const size_t off = (size_t)(row0 + ai * HALF + m * 16) * ldc + col0 + trofs;
#pragma unroll
                for (int bj = 0; bj < 2; ++bj) { const f32x4 b0 = xb[m][bj][0], b1 = xb[m][bj][1];
                    const f32x4 v0 = acc[ai][bj][m][0] * gv[bj][0], v1 = acc[ai][bj][m][1] * gv[bj][1];
                    u32x4 w; w.x = cvt_pk_bf16(v0[0], v0[1]); w.y = cvt_pk_bf16(v0[2], v0[3]); w.z = cvt_pk_bf16(v1[0], v1[1]); w.w = cvt_pk_bf16(v1[2], v1[3]);
                    const u32x4 t = epi_tr(w, src4);
                    if (pend) { u32x4 o; o.x = cvt_pk_bf16(pb0[0] + bflo(tq.x), pb0[1] + bfhi(tq.x)); o.y = cvt_pk_bf16(pb0[2] + bflo(tq.y), pb0[3] + bfhi(tq.y)); o.z = cvt_pk_bf16(pb1[0] + bflo(tq.z), pb1[1] + bfhi(tq.z)); o.w = cvt_pk_bf16(pb1[2] + bflo(tq.w), pb1[3] + bfhi(tq.w));
                        *(u32x4*)pq = o; }
                    tq = t; pb0 = b0; pb1 = b1; pq = O + off + bj * 32; pend = true; } }
            { u32x4 o; o.x = cvt_pk_bf16(pb0[0] + bflo(tq.x), pb0[1] + bfhi(tq.x)); o.y = cvt_pk_bf16(pb0[2] + bflo(tq.y), pb0[3] + bfhi(tq.y)); o.z = cvt_pk_bf16(pb1[0] + bflo(tq.z), pb1[1] + bfhi(tq.z)); o.w = cvt_pk_bf16(pb1[2] + bflo(tq.w), pb1[3] + bfhi(tq.w));
              *(u32x4*)pq = o; }
        }
    }
};
struct EpiRes {
    static constexpr bool PERM = false, I8 = false; typedef f32x4 acc_t;
    const float* base; float* out; int ldc; const float* gate; int gate_stride; int rows_per_batch;
    __device__ __forceinline__ void operator()(const f32x4 (&acc)[2][2][4][2], const Unit& u, int wr, int wc, int fr, int fq) const {
        const int col0 = u.pn * BM + wc * 32 + 4 * fq;
        const int bsel = (u.pm * BM) / rows_per_batch;
        f32x4 gv[2][2];
#pragma unroll
        for (int bj = 0; bj < 2; ++bj)
#pragma unroll
            for (int n = 0; n < 2; ++n) gv[bj][n] = *(const f32x4*)(gate + (size_t)bsel * gate_stride + col0 + bj * HALF + n * 16);
#pragma unroll
        for (int ai = 0; ai < 2; ++ai)
#pragma unroll
            for (int m = 0; m < 4; ++m) { const size_t off = (size_t)(u.pm * BM + ai * HALF + wr * 64 + m * 16 + fr) * ldc + col0;
#pragma unroll
                for (int bj = 0; bj < 2; ++bj)
#pragma unroll
                    for (int n = 0; n < 2; ++n) { const f32x4 bs = *(const f32x4*)(base + off + bj * HALF + n * 16);
                        *(f32x4*)(out + off + bj * HALF + n * 16) = bs + gv[bj][n] * acc[ai][bj][m][n]; } }
    }
};

__device__ __forceinline__ f32x4 mma_any(bf16x8 b, bf16x8 a, f32x4 c) { return __builtin_amdgcn_mfma_f32_16x16x32_bf16(b, a, c, 0, 0, 0); }
__device__ __forceinline__ i32x4 mma_any(bf16x8 b, bf16x8 a, i32x4 c) { return __builtin_amdgcn_mfma_i32_16x16x64_i8(__builtin_bit_cast(i32x4, b), __builtin_bit_cast(i32x4, a), c, 0, 0, 0); }
template <class Epi>
__device__ __forceinline__ void gemm_phase(LAS unsigned char* lds, const Gemm g, const StaticOrder& S, const Epi& E) {
    int tid = threadIdx.x; asm volatile("" : "+v"(tid));
    const int wid = __builtin_amdgcn_readfirstlane(tid >> 6), lane = tid & 63, wr = wid >> 2, wc = wid & 3, fr = lane & 15, fq = lane >> 4;
    const int K = g.K, nt = K / BK;
    unsigned voffA[2], voffB[2];
#pragma unroll
    for (int i = 0; i < 2; ++i) { int R, C; stage_rc(tid * 16 + i * 8192, R, C); const int Rb = Epi::PERM ? ((R >> 5) * 64 + perm32(R & 31)) : R;
        voffA[i] = (unsigned)(R * K + C) * 2u; voffB[i] = (unsigned)(Rb * K + C) * 2u; }
    const size_t kstep = (size_t)(BK * 2);
    const size_t hstep = (size_t)HALF * K * 2;
    const size_t hstepB = Epi::PERM ? (size_t)32 * K * 2 : hstep;
    const size_t tstep = 2 * hstep;
    const unsigned ldsw = (unsigned)wid * 1024u;
    const int aoff = lds_byte(wr * 64 + fr, fq * 8), boff = lds_byte(wc * 32 + fr, fq * 8);
#define PG8_SA(b, h) (((b) * 2 + (h)) * HTB)
#define PG8_SB(b, h) ((4 + (b) * 2 + (h)) * HTB)
#define PG8_STAGE(bufoff, gbase, voff) do { _Pragma("unroll") for (int _i = 0; _i < 2; ++_i) \
        __builtin_amdgcn_global_load_lds((const unsigned*)((const char*)(gbase) + (voff)[_i]), (LAS unsigned*)(lds + (bufoff) + ldsw + _i * 8192), 16, 0, 0); } while (0)
#define PG8_LDA(dst, b, h) do { _Pragma("unroll") for (int m = 0; m < 4; ++m) _Pragma("unroll") for (int k = 0; k < 2; ++k) dst[m][k] = *(const LAS bf16x8*)(lds + PG8_SA(b, h) + aoff + m * 2048 + k * 1024); } while (0)
#define PG8_LDB(dst, b, h) do { _Pragma("unroll") for (int n = 0; n < 2; ++n) _Pragma("unroll") for (int k = 0; k < 2; ++k) dst[n][k] = *(const LAS bf16x8*)(lds + PG8_SB(b, h) + boff + n * 2048 + k * 1024); } while (0)
#define PG8_MMA(ai, bj, At, Bt) do { __builtin_amdgcn_s_setprio(1); _Pragma("unroll") for (int m = 0; m < 4; ++m) _Pragma("unroll") for (int n = 0; n < 2; ++n) _Pragma("unroll") for (int k = 0; k < 2; ++k) \
        acc[ai][bj][m][n] = mma_any(Bt[n][k], At[m][k], acc[ai][bj][m][n]); __builtin_amdgcn_s_setprio(0); } while (0)
#define PG8_WAIT_V(n) asm volatile("s_waitcnt vmcnt(" #n ")" ::: "memory")
#define PG8_WAIT_L(n) asm volatile("s_waitcnt lgkmcnt(" #n ")" ::: "memory")
#define PG8_BAR __builtin_amdgcn_s_barrier()
#define PG8_SCHED __builtin_amdgcn_sched_barrier(0)
    Unit cur, nxt; int ui = 0;
    if (!S.next(0, cur)) return;
    typedef typename Epi::acc_t acc_t;
    acc_t acc[2][2][4][2];
#pragma unroll
    for (int a = 0; a < 2; ++a)
#pragma unroll
        for (int b = 0; b < 2; ++b)
#pragma unroll
            for (int m = 0; m < 4; ++m)
#pragma unroll
                for (int n = 0; n < 2; ++n) acc[a][b][m][n] = (acc_t){0, 0, 0, 0};
    bf16x8 At[4][2], B0[2][2], B1[2][2];
    const char* cA = (const char*)g.A + (size_t)cur.pm * tstep; const char* cB = (const char*)g.Bt + g.bsel(cur.pm) + (size_t)cur.pn * tstep;
    PG8_STAGE(PG8_SB(0, 0), cB, voffB); PG8_STAGE(PG8_SB(0, 1), cB + hstepB, voffB); PG8_STAGE(PG8_SA(0, 0), cA, voffA); PG8_STAGE(PG8_SA(0, 1), cA + hstep, voffA);
    if (wr == 1) PG8_BAR;
    PG8_WAIT_V(2); PG8_BAR;
    PG8_STAGE(PG8_SB(1, 0), cB + kstep, voffB); PG8_STAGE(PG8_SA(1, 0), cA + kstep, voffA); PG8_STAGE(PG8_SB(1, 1), cB + hstepB + kstep, voffB);
    PG8_WAIT_V(6); PG8_BAR;
    for (;;) {
        const bool has_next = S.next(ui + 1, nxt);
        const char* nA = has_next ? (const char*)g.A + (size_t)nxt.pm * tstep : cA; const char* nB = has_next ? (const char*)g.Bt + g.bsel(nxt.pm) + (size_t)nxt.pn * tstep : cB;
        for (int t = 0; t < nt; t += 2) {
            const bool last = (t == nt - 2);
            const char* a1 = cA + (size_t)(t + 1) * kstep;
            const char* a2 = last ? nA : cA + (size_t)(t + 2) * kstep; const char* b2 = last ? nB : cB + (size_t)(t + 2) * kstep;
            const char* a3 = a2 + kstep; const char* b3 = b2 + kstep;
            PG8_LDB(B0, 0, 0); PG8_LDB(B1, 0, 1); PG8_SCHED; PG8_LDA(At, 0, 0); PG8_STAGE(PG8_SA(1, 1), a1 + hstep, voffA);
            PG8_WAIT_V(8); PG8_WAIT_L(0); PG8_BAR; PG8_MMA(0, 0, At, B0); PG8_MMA(0, 1, At, B1); PG8_BAR; PG8_SCHED;
            PG8_LDA(At, 0, 1); PG8_STAGE(PG8_SB(0, 0), b2, voffB); PG8_STAGE(PG8_SB(0, 1), b2 + hstepB, voffB); PG8_STAGE(PG8_SA(0, 0), a2, voffA);
            PG8_WAIT_V(8); PG8_WAIT_L(0); PG8_BAR; PG8_MMA(1, 0, At, B0); PG8_MMA(1, 1, At, B1); PG8_BAR; PG8_SCHED;
            PG8_LDB(B0, 1, 0); PG8_LDB(B1, 1, 1); PG8_SCHED; PG8_LDA(At, 1, 0); PG8_STAGE(PG8_SA(0, 1), a2 + hstep, voffA);
            PG8_WAIT_V(8); PG8_WAIT_L(0); PG8_BAR; PG8_MMA(0, 0, At, B0); PG8_MMA(0, 1, At, B1); PG8_BAR; PG8_SCHED;
            PG8_LDA(At, 1, 1); PG8_STAGE(PG8_SB(1, 0), b3, voffB); PG8_STAGE(PG8_SB(1, 1), b3 + hstepB, voffB); PG8_STAGE(PG8_SA(1, 0), a3, voffA);
            PG8_WAIT_V(8); PG8_WAIT_L(0); PG8_BAR; PG8_MMA(1, 0, At, B0); PG8_MMA(1, 1, At, B1); PG8_BAR; PG8_SCHED;
        }
        if (wr == 0) PG8_BAR;
        E(acc, cur, wr, wc, fr, fq);
        if (!has_next) break;
#pragma unroll
        for (int a = 0; a < 2; ++a)
#pragma unroll
            for (int b = 0; b < 2; ++b)
#pragma unroll
                for (int m = 0; m < 4; ++m)
#pragma unroll
                    for (int n = 0; n < 2; ++n) acc[a][b][m][n] = (acc_t){0, 0, 0, 0};
        cur = nxt; cA = nA; cB = nB; ++ui;
        if (wr == 1) PG8_BAR;
    }
    PG8_WAIT_V(0);
    PG8_BAR;
#undef PG8_SA
#undef PG8_SB
#undef PG8_STAGE
#undef PG8_LDA
#undef PG8_LDB
#undef PG8_MMA
#undef PG8_WAIT_V
#undef PG8_WAIT_L
#undef PG8_BAR
#undef PG8_SCHED
}
}

__device__ __forceinline__ void p0_transpose_item(const float* W, int K, int N, bf16_t* WT, float* scr, int item, int lane) {
    const int nblk = N / 32, kb = item / nblk, nb = item % nblk, k0 = 64 * kb, n0 = 32 * nb;
#pragma unroll 8
    for (int i = 0; i < 32; ++i) { const int kk = 2 * i + (lane >> 5); scr[kk * 33 + (lane & 31)] = W[(size_t)(k0 + kk) * N + n0 + (lane & 31)]; }
    asm volatile("s_waitcnt lgkmcnt(0)" ::: "memory");
    const int c = lane & 7;
#pragma unroll
    for (int j = 0; j < 4; ++j) { const int n = (lane >> 3) + 8 * j; const float* s = scr + (8 * c) * 33 + n;
        u32x4 o; o.x = pk2(s[0 * 33], s[1 * 33]); o.y = pk2(s[2 * 33], s[3 * 33]); o.z = pk2(s[4 * 33], s[5 * 33]); o.w = pk2(s[6 * 33], s[7 * 33]);
        *(u32x4*)(WT + (size_t)(n0 + n) * K + k0 + 8 * c) = o; }
    asm volatile("s_waitcnt lgkmcnt(0)" ::: "memory");
}
__device__ __forceinline__ void p0_colmax_item(const float* W, int N, unsigned* cmax, int item, int lane) {
    const int ngrp = N / 256, kb = item / ngrp, gb = item % ngrp; const float* src = W + (size_t)(64 * kb) * N + 256 * gb + 4 * lane;
    f32x4 m = {0.f, 0.f, 0.f, 0.f};
#pragma unroll 8
    for (int k = 0; k < 64; ++k) { const f32x4 v = *(const f32x4*)(src + (size_t)k * N); m = (f32x4){fmaxf(m[0], fabsf(v[0])), fmaxf(m[1], fabsf(v[1])), fmaxf(m[2], fabsf(v[2])), fmaxf(m[3], fabsf(v[3]))}; }
#pragma unroll
    for (int e = 0; e < 4; ++e) atomicMax(cmax + 256 * gb + 4 * lane + e, __builtin_bit_cast(unsigned, m[e]));
}
__device__ __forceinline__ void p1_qt_item(const float* W, int K, int N, const unsigned* cmax, unsigned char* WT8, float* scr, int item, int lane) {
    const int nblk = N / 32, kb = item / nblk, nb = item % nblk, k0 = 64 * kb, n0 = 32 * nb;
#pragma unroll 8
    for (int i = 0; i < 32; ++i) { const int kk = 2 * i + (lane >> 5); scr[kk * 33 + (lane & 31)] = W[(size_t)(k0 + kk) * N + n0 + (lane & 31)]; }
    asm volatile("s_waitcnt lgkmcnt(0)" ::: "memory");
    const int c = lane & 7;
#pragma unroll
    for (int j = 0; j < 4; ++j) { const int n = (lane >> 3) + 8 * j; const float* sp_ = scr + (8 * c) * 33 + n;
        const float cm = __builtin_bit_cast(float, cmax[n0 + n]); const float inv = (cm > 1e-30f) ? 127.0f / cm : 0.f;
        u32x2 o; o.x = q8pack((f32x4){sp_[0 * 33], sp_[1 * 33], sp_[2 * 33], sp_[3 * 33]} * inv); o.y = q8pack((f32x4){sp_[4 * 33], sp_[5 * 33], sp_[6 * 33], sp_[7 * 33]} * inv);
        *(u32x2*)(WT8 + (size_t)(n0 + n) * K + k0 + 8 * c) = o; }
    asm volatile("s_waitcnt lgkmcnt(0)" ::: "memory");
}
__device__ __forceinline__ void cvt_item(const float* src, bf16_t* dst, size_t item, int lane) {
    const f32x4* s = (const f32x4*)(src + item * 512) + lane * 2; const f32x4 a = s[0], b = s[1];
    u32x4 o; o.x = pk2(a[0], a[1]); o.y = pk2(a[2], a[3]); o.z = pk2(b[0], b[1]); o.w = pk2(b[2], b[3]);
    *((u32x4*)(dst + item * 512) + lane) = o;
}

__device__ __forceinline__ void phase0(const Params& p, unsigned char* lds, int bid, int nblk) {
    int tid = threadIdx.x; asm volatile("" : "+v"(tid));
    const int lane = tid & 63, wave = __builtin_amdgcn_readfirstlane(tid >> 6);
    float* s_lds = (float*)lds;
    float* red = (float*)(lds + 24576);
    float* scr = (float*)(lds + 49152 + wave * 8448);
    float* MOD = (float*)(p.ws + WS_MOD);
    for (int i = tid; i < 3 * 2048; i += 512) { const int v = i >> 11, k = i & 2047; const float cv = (v < 2) ? p.c[v * 2048 + k] : p.c_ctx[k]; s_lds[i] = cv * sigmoidf_(cv); }
    __syncthreads();
    for (int it = bid; it < 256; it += nblk) {
        const int col0 = it * 48; const int cgp = tid % 12, kl = tid / 12;
        f32x4 a0 = {0.f, 0.f, 0.f, 0.f}, a1 = a0, a2 = a0;
        if (tid < 504) {
            const float* wp = p.w_mod + col0 + 4 * cgp;
#pragma unroll 7
            for (int k = kl; k < 2048; k += 42) { const f32x4 w = *(const f32x4*)(wp + (size_t)k * 12288); a0 += w * s_lds[k]; a1 += w * s_lds[2048 + k]; a2 += w * s_lds[4096 + k]; }
            float* r = red + kl * 144 + cgp * 4;
            *(f32x4*)(r) = a0; *(f32x4*)(r + 48) = a1; *(f32x4*)(r + 96) = a2;
        }
        __syncthreads();
        if (tid < 144) { float s = 0.f; for (int k = 0; k < 42; ++k) s += red[k * 144 + tid]; const int v = tid / 48, col = col0 + tid % 48; MOD[v * 12288 + col] = s + p.b_mod[col]; }
        __syncthreads();
    }
    if (bid == 0) { float* SP = (float*)(p.ws + WS_SP); for (int i = tid; i < 2048; i += 512) SP[i] = log1pf(expf(-p.lru_lam[i])); }
    const int gw = bid * 8 + wave, NGW = nblk * 8;
    constexpr int I_IN = G1_I8 ? 0 : 32 * 128, I_OUT = 32 * 64, I_Q = G3_I8 ? 32 * 8 : 32 * 64, I_LRU = 32 * 8;
    for (int it = gw; it < I_IN + I_OUT + I_Q + I_LRU; it += NGW) {
        int r = it;
        if (r < I_LRU) { const int mat = r >> 3, d = mat >> 4, m = (mat >> 3) & 1, h = mat & 7;
            p0_transpose_item((m ? p.lru_wx : p.lru_wa) + (size_t)(d * 8 + h) * 16384, 128, 128, (bf16_t*)(p.ws + WS_LRUW) + (size_t)mat * 16384, scr, r & 7, lane); continue; } r -= I_LRU;
#if G1_I8
#else
        if (r < I_IN) { p0_transpose_item(p.w_in, 2048, 4096, (bf16_t*)(p.ws + WS_WIN), scr, r, lane); continue; } r -= I_IN;
#endif
        if (r < I_OUT) { p0_transpose_item(p.w_out, 2048, 2048, (bf16_t*)(p.ws + WS_WOUT), scr, r, lane); continue; } r -= I_OUT;
#if G3_I8
        p0_colmax_item(p.wq, 2048, (unsigned*)(p.ws + WS_COLMAX_Q), r, lane);
#else
        p0_transpose_item(p.wq, 2048, 2048, (bf16_t*)(p.ws + WS_WQ), scr, r, lane);
#endif
    }
    constexpr int C_SM = 256;
    for (int it = gw; it < 3 * C_SM; it += NGW) {
        int r = it;
        if (r < C_SM) { cvt_item(p.sgu_w, (bf16_t*)(p.ws + WS_SGUW), r, lane); continue; } r -= C_SM;
        if (r < C_SM) { cvt_item(p.k1, (bf16_t*)(p.ws + WS_K1), r, lane); continue; } r -= C_SM;
        cvt_item(p.k2, (bf16_t*)(p.ws + WS_K2), r, lane);
    }
    for (int it = gw; it < 2 * 16384; it += NGW) {
        const int tab = it >> 14, row = it & 16383;
        const float* src = (tab ? p.pv : p.pu) + (size_t)row * D + 16 * lane;
        f32x4 v[2][4]; float am = 0.f;
#pragma unroll
        for (int c = 0; c < 2; ++c)
#pragma unroll
            for (int e = 0; e < 4; ++e) { v[c][e] = *(const f32x4*)(src + 1024 * c + 4 * e); am = fmaxf(am, fmaxf(fmaxf(fabsf(v[c][e][0]), fabsf(v[c][e][1])), fmaxf(fabsf(v[c][e][2]), fabsf(v[c][e][3])))); }
#pragma unroll
        for (int o = 1; o < 64; o <<= 1) am = fmaxf(am, __shfl_xor(am, o));
        const float inv = (am > 1e-30f) ? 127.0f / am : 0.f;
        unsigned char* dst = p.ws + (tab ? WS_VB : WS_UB) + ((size_t)(lane >> 3) * 16384 + row) * 128 + 16 * (lane & 7);
#pragma unroll
        for (int c = 0; c < 2; ++c) { u32x4 o;
#pragma unroll
            for (int e = 0; e < 4; ++e) o[e] = q8pack(v[c][e] * inv);
            *(u32x4*)(dst + (size_t)c * 8 * 16384 * 128) = o; }
        if (lane == 0) ((float*)(p.ws + WS_USC))[2 * row + tab] = am * (1.0f / 127.0f);
    }
}

__device__ __forceinline__ void norm_row_bf16(const float* xrow, const float* g, const float* shift, const float* scale, bf16_t* orow, int lane) {
    f32x4 v[8]; float ss = 0.f;
#pragma unroll
    for (int j = 0; j < 8; ++j) { v[j] = *((const f32x4*)xrow + lane + 64 * j); ss += (v[j][0] * v[j][0] + v[j][1] * v[j][1]) + (v[j][2] * v[j][2] + v[j][3] * v[j][3]); }
    const float rstd = rsqrtf(wave_sum(ss) * (1.0f / 2048.0f) + EPS);
#pragma unroll
    for (int j = 0; j < 8; ++j) {
        const f32x4 gg = *((const f32x4*)g + lane + 64 * j), sh = *((const f32x4*)shift + lane + 64 * j), sc = *((const f32x4*)scale + lane + 64 * j);
        const f32x4 h = (v[j] * rstd) * gg * (sc + 1.0f) + sh;
        u32x2 o; o.x = pk2(h[0], h[1]); o.y = pk2(h[2], h[3]);
        *((u32x2*)orow + lane + 64 * j) = o;
    }
}
__device__ __forceinline__ void xhat_row_q8(const float* xrow, unsigned char* o8, float* osc, int lane) {
    f32x4 v[8]; float ss = 0.f, am = 0.f;
#pragma unroll
    for (int j = 0; j < 8; ++j) { v[j] = *((const f32x4*)xrow + lane + 64 * j); ss += (v[j][0] * v[j][0] + v[j][1] * v[j][1]) + (v[j][2] * v[j][2] + v[j][3] * v[j][3]);
        am = fmaxf(am, fmaxf(fmaxf(fabsf(v[j][0]), fabsf(v[j][1])), fmaxf(fabsf(v[j][2]), fabsf(v[j][3])))); }
    const float rstd = rsqrtf(wave_sum(ss) * (1.0f / 2048.0f) + EPS);
#pragma unroll
    for (int o = 1; o < 64; o <<= 1) am = fmaxf(am, __shfl_xor(am, o));
    const float inv = (am > 1e-30f) ? 127.0f / am : 0.f;
#pragma unroll
    for (int j = 0; j < 8; ++j) *((unsigned*)o8 + lane + 64 * j) = q8pack(v[j] * inv);
    if (lane == 0) *osc = am * rstd * (1.0f / 127.0f);
}
__device__ __forceinline__ void xrow_load(const float* xrow, int lane, f32x4 (&v)[8]) {
#pragma unroll
    for (int j = 0; j < 8; ++j) v[j] = *((const f32x4*)xrow + lane + 64 * j);
}
__device__ __forceinline__ void xhat_pack(const f32x4 (&v)[8], unsigned char* o8, float* osc, int lane) {
    float ss = 0.f, am = 0.f;
#pragma unroll
    for (int j = 0; j < 8; ++j) { ss += (v[j][0] * v[j][0] + v[j][1] * v[j][1]) + (v[j][2] * v[j][2] + v[j][3] * v[j][3]);
        am = fmaxf(am, fmaxf(fmaxf(fabsf(v[j][0]), fabsf(v[j][1])), fmaxf(fabsf(v[j][2]), fabsf(v[j][3])))); }
    const float rstd = rsqrtf(wave_sum(ss) * (1.0f / 2048.0f) + EPS);
    am = fmaxf(am, dpp_f<DPP_XOR1>(am)); am = fmaxf(am, dpp_f<DPP_XOR2>(am)); am = fmaxf(am, dpp_f<DPP_HMIRROR>(am)); am = fmaxf(am, dpp_f<DPP_MIRROR>(am));
    { float a = am, b = am; swap16(a, b); am = fmaxf(a, b); } { float a = am, b = am; swap32(a, b); am = fmaxf(a, b); }
    const float inv = (am > 1e-30f) ? 127.0f / am : 0.f;
#pragma unroll
    for (int j = 0; j < 8; ++j) *((unsigned*)o8 + lane + 64 * j) = q8pack(v[j] * inv);
    if (lane == 0) *osc = am * rstd * (1.0f / 127.0f);
}
__device__ __forceinline__ void p1_win3_item(const Params& p, int v, int nb, float* scr, int lane) {
    const float* MOD = (const float*)(p.ws + WS_MOD) + v * 12288;
    const int n0 = 16 * nb, cq = lane & 3, kq = lane >> 2;
    f32x4 mx = {0.f, 0.f, 0.f, 0.f}, bs = {0.f, 0.f, 0.f, 0.f};
#pragma unroll 8
    for (int i = 0; i < 128; ++i) { const int k = 16 * i + kq; const f32x4 w = *(const f32x4*)(p.w_in + (size_t)k * INW + n0 + 4 * cq);
        const float gsk = p.g1[k] * (1.0f + MOD[2048 + k]), shk = MOD[k];
        mx = (f32x4){fmaxf(mx[0], fabsf(w[0] * gsk)), fmaxf(mx[1], fabsf(w[1] * gsk)), fmaxf(mx[2], fabsf(w[2] * gsk)), fmaxf(mx[3], fabsf(w[3] * gsk))}; bs += w * shk; }
#pragma unroll
    for (int o = 4; o < 64; o <<= 1) { mx = (f32x4){fmaxf(mx[0], __shfl_xor(mx[0], o)), fmaxf(mx[1], __shfl_xor(mx[1], o)), fmaxf(mx[2], __shfl_xor(mx[2], o)), fmaxf(mx[3], __shfl_xor(mx[3], o))};
        bs = (f32x4){bs[0] + __shfl_xor(bs[0], o), bs[1] + __shfl_xor(bs[1], o), bs[2] + __shfl_xor(bs[2], o), bs[3] + __shfl_xor(bs[3], o)}; }
    float* CS = (float*)(p.ws + WS_CS1) + v * 4096; float* BI = (float*)(p.ws + WS_BIAS1) + v * 4096;
    if (kq == 0) { *(f32x4*)(CS + n0 + 4 * cq) = mx * (1.0f / 127.0f); *(f32x4*)(BI + n0 + 4 * cq) = bs; }
    const int n = lane >> 2, c = lane & 3;
    float cm;
    { const float c0 = __shfl(mx[0], n >> 2), c1 = __shfl(mx[1], n >> 2), c2 = __shfl(mx[2], n >> 2), c3 = __shfl(mx[3], n >> 2);
      cm = ((n & 3) == 0) ? c0 : ((n & 3) == 1) ? c1 : ((n & 3) == 2) ? c2 : c3; }
    const float inv = (cm > 1e-30f) ? 127.0f / cm : 0.f;
    unsigned char* WT8 = p.ws + WS_WIN3 + (size_t)v * 4096 * 2048;
    for (int kb = 0; kb < 32; ++kb) {
        const int k0 = 64 * kb;
#pragma unroll
        for (int r = 0; r < 4; ++r) { const int kk = kq + 16 * r, k = k0 + kk; const f32x4 w = *(const f32x4*)(p.w_in + (size_t)k * INW + n0 + 4 * cq) * (p.g1[k] * (1.0f + MOD[2048 + k]));
            float* d = scr + kk * 17 + 4 * cq; d[0] = w[0]; d[1] = w[1]; d[2] = w[2]; d[3] = w[3]; }
        asm volatile("s_waitcnt lgkmcnt(0)" ::: "memory");
        const float* sp_ = scr + (16 * c) * 17 + n;
        u32x4 o;
#pragma unroll
        for (int e = 0; e < 4; ++e) o[e] = q8pack((f32x4){sp_[(4 * e + 0) * 17], sp_[(4 * e + 1) * 17], sp_[(4 * e + 2) * 17], sp_[(4 * e + 3) * 17]} * inv);
        *(u32x4*)(WT8 + (size_t)(n0 + n) * 2048 + k0 + 16 * c) = o;
        asm volatile("s_waitcnt lgkmcnt(0)" ::: "memory");
    }
}
template <bool BF16COPY>
__device__ __forceinline__ void norm_row_q8(const float* xrow, const float* g, const float* shift, const float* scale, unsigned char* o8, float* osc, int lane, bf16_t* obf = nullptr, const bf16_t* addrow = nullptr, bf16_t* sumout = nullptr) {
    f32x4 v[8]; float ss = 0.f;
#pragma unroll
    for (int j = 0; j < 8; ++j) { v[j] = *((const f32x4*)xrow + lane + 64 * j);
        if (addrow) { const u32x2 a = *((const u32x2*)addrow + lane + 64 * j); v[j] += (f32x4){bflo(a.x), bfhi(a.x), bflo(a.y), bfhi(a.y)}; }
        if (sumout) { u32x2 o; o.x = pk2(v[j][0], v[j][1]); o.y = pk2(v[j][2], v[j][3]); *((u32x2*)sumout + lane + 64 * j) = o; }
        ss += (v[j][0] * v[j][0] + v[j][1] * v[j][1]) + (v[j][2] * v[j][2] + v[j][3] * v[j][3]); }
    const float rstd = rsqrtf(wave_sum(ss) * (1.0f / 2048.0f) + EPS);
    float am = 0.f;
#pragma unroll
    for (int j = 0; j < 8; ++j) {
        const f32x4 gg = *((const f32x4*)g + lane + 64 * j), sh = *((const f32x4*)shift + lane + 64 * j), sc = *((const f32x4*)scale + lane + 64 * j);
        const f32x4 h = (v[j] * rstd) * gg * (sc + 1.0f) + sh; v[j] = h;
        if (BF16COPY) { u32x2 o; o.x = pk2(h[0], h[1]); o.y = pk2(h[2], h[3]); *((u32x2*)obf + lane + 64 * j) = o; }
        am = fmaxf(am, fmaxf(fmaxf(fabsf(h[0]), fabsf(h[1])), fmaxf(fabsf(h[2]), fabsf(h[3]))));
    }
#pragma unroll
    for (int o = 1; o < 64; o <<= 1) am = fmaxf(am, __shfl_xor(am, o));
    const float inv = (am > 1e-30f) ? 127.0f / am : 0.f;
#pragma unroll
    for (int j = 0; j < 8; ++j) *((unsigned*)o8 + lane + 64 * j) = q8pack(v[j] * inv);
    if (lane == 0) *osc = am * (1.0f / 127.0f);
}
__device__ __forceinline__ void phase_norm1(const Params& p, unsigned char* lds, int bid, int nblk) {
    int tid = threadIdx.x; asm volatile("" : "+v"(tid));
    const int lane = tid & 63, wave = __builtin_amdgcn_readfirstlane(tid >> 6);
    const float* MOD = (const float*)(p.ws + WS_MOD); unsigned char* HN8 = p.ws + WS_HN; float* RS1 = (float*)(p.ws + WS_RS1);
    float* scr = (float*)(lds + wave * 8448);
    const int gw = bid * 8 + wave, NGW = nblk * 8;
    constexpr int I_IN = G1_I8 ? 3 * 256 : 0, I_Q = G3_I8 ? 32 * 64 : 0;
    for (int it = gw; it < I_IN + I_Q; it += NGW) {
        if (it < I_IN) p1_win3_item(p, it / 256, it % 256, scr, lane);
        else p1_qt_item(p.wq, 2048, 2048, (const unsigned*)(p.ws + WS_COLMAX_Q), p.ws + WS_WQ, scr, it - I_IN, lane);
    }
    unsigned* rowctr = (unsigned*)(p.ws + WS_CTL + 49152);
#if G1_I8
    {
#define P1_XPTR(r_) ((r_) >= MLAT ? p.ctx + (size_t)((r_) - MLAT) * D : p.x + (size_t)(r_) * D)
#define P1_NEXT(r_, out_) { if (((r_) & 7) != 7) out_ = (r_) + 1; else { const int c_ = __builtin_amdgcn_readfirstlane(nxt_v); out_ = (c_ < MALL) ? c_ : -1; if (lane == 0) nxt_v = (int)atomicAdd(rowctr, 8u); } }
        int cur_v = 0, nxt_v = 0;
        if (lane == 0) { cur_v = (int)atomicAdd(rowctr, 8u); nxt_v = (int)atomicAdd(rowctr, 8u); }
        int row = __builtin_amdgcn_readfirstlane(cur_v);
        f32x4 va[8], vb[8];
        if (row < MALL) {
            xrow_load(P1_XPTR(row), lane, va);
            for (;;) {
                int r1; P1_NEXT(row, r1)
                if (r1 >= 0) xrow_load(P1_XPTR(r1), lane, vb);
                xhat_pack(va, HN8 + (size_t)row * D, RS1 + row, lane);
                if (r1 < 0) break;
                int r2; P1_NEXT(r1, r2)
                if (r2 >= 0) xrow_load(P1_XPTR(r2), lane, va);
                xhat_pack(vb, HN8 + (size_t)r1 * D, RS1 + r1, lane);
                if (r2 < 0) break;
                row = r2;
            }
        }
#undef P1_XPTR
#undef P1_NEXT
        (void)MOD;
    }
#else
    for (;;) {
      int r0 = 0; if (lane == 0) r0 = (int)atomicAdd(rowctr, 4u); r0 = __builtin_amdgcn_readfirstlane(r0);
      if (r0 >= MALL) break;
      for (int row = r0; row < r0 + 4 && row < MALL; ++row) {
        const bool isctx = row >= MLAT; const int v = isctx ? 2 : (row >> 14);
        const float* xr = isctx ? p.ctx + (size_t)(row - MLAT) * D : p.x + (size_t)row * D;
        norm_row_bf16(xr, p.g1, MOD + v * 12288, MOD + v * 12288 + 2048, (bf16_t*)(p.ws + WS_HN) + (size_t)row * D, lane);
      }
    }
#endif
}
__device__ __forceinline__ void xl_row_q8(const bf16_t* xl, const float* g, const float* shift, const float* scale, unsigned char* o8, float* osc, int lane) {
    f32x4 v[8]; float ss = 0.f;
#pragma unroll
    for (int j = 0; j < 8; ++j) { const u32x2 a = *((const u32x2*)xl + lane + 64 * j); v[j] = (f32x4){bflo(a.x), bfhi(a.x), bflo(a.y), bfhi(a.y)};
        ss += (v[j][0] * v[j][0] + v[j][1] * v[j][1]) + (v[j][2] * v[j][2] + v[j][3] * v[j][3]); }
    const float rstd = rsqrtf(wave_sum(ss) * (1.0f / 2048.0f) + EPS);
    float am = 0.f;
#pragma unroll
    for (int j = 0; j < 8; ++j) {
        const f32x4 gg = *((const f32x4*)g + lane + 64 * j), sh = *((const f32x4*)shift + lane + 64 * j), sc = *((const f32x4*)scale + lane + 64 * j);
        const f32x4 h = (v[j] * rstd) * gg * (sc + 1.0f) + sh; v[j] = h;
        am = fmaxf(am, fmaxf(fmaxf(fabsf(h[0]), fabsf(h[1])), fmaxf(fabsf(h[2]), fabsf(h[3]))));
    }
#pragma unroll
    for (int o = 1; o < 64; o <<= 1) am = fmaxf(am, __shfl_xor(am, o));
    const float inv = (am > 1e-30f) ? 127.0f / am : 0.f;
#pragma unroll
    for (int j = 0; j < 8; ++j) *((unsigned*)o8 + lane + 64 * j) = q8pack(v[j] * inv);
    if (lane == 0) *osc = am * (1.0f / 127.0f);
}
__device__ __forceinline__ void phase_norm2(const Params& p, int bid, int nblk) {
    int tid = threadIdx.x; asm volatile("" : "+v"(tid));
    const int lane = tid & 63, wave = __builtin_amdgcn_readfirstlane(tid >> 6);
    const float* MOD = (const float*)(p.ws + WS_MOD);
    for (int row = bid * 8 + wave; row < MLAT; row += nblk * 8) {
        const int v = row >> 14;
        xl_row_q8((const bf16_t*)(p.ws + WS_YL) + (size_t)row * D, p.g2, MOD + v * 12288 + 3 * 2048, MOD + v * 12288 + 4 * 2048, p.ws + WS_HN8 + (size_t)row * D, (float*)(p.ws + WS_HSC) + row, lane);
    }
}

constexpr int XCB_LD = 136, XCF_LD = 132;
constexpr size_t WS_GABF = 696 * MiB;
constexpr size_t WS_GABB = 824 * MiB;
constexpr size_t WS_CARRY = 596 * MiB;

__device__ __forceinline__ void lru_ab(float ga, float gx, float ba, float bx, float sp, float xv, float& a, float& b) {
    const float rg = __builtin_amdgcn_rcpf(1.0f + __builtin_amdgcn_exp2f(fmaf(ga, -1.4426950408889634f, ba)));
    const float ig = __builtin_amdgcn_rcpf(1.0f + __builtin_amdgcn_exp2f(fmaf(gx, -1.4426950408889634f, bx)));
    a = __builtin_amdgcn_exp2f(rg * sp);
    const float em = fmaf(-a, a, 1.0f);
    b = __builtin_amdgcn_sqrtf(em) * ig * xv;
}
__device__ __forceinline__ void lru_abl(float ga, float gx, float ba, float bx, float sp, float xv, float& a, float& b, float& l) {
    const float rg = __builtin_amdgcn_rcpf(1.0f + __builtin_amdgcn_exp2f(fmaf(ga, -1.4426950408889634f, ba)));
    const float ig = __builtin_amdgcn_rcpf(1.0f + __builtin_amdgcn_exp2f(fmaf(gx, -1.4426950408889634f, bx)));
    l = rg * sp; a = __builtin_amdgcn_exp2f(l);
    const float em = fmaf(-a, a, 1.0f);
    b = __builtin_amdgcn_sqrtf(em) * ig * xv;
}
__device__ __forceinline__ void lru_gates1(const bf16_t* xcb, const float* xcf, int mt, int cc, int q4, int chl, const bf16x8 (&Bwa)[4], const bf16x8 (&Bwx)[4],
                                           float ba, float bx, float sp, float (&a)[4], float (&b)[4]) {
    f32x4 ga = {0.f, 0.f, 0.f, 0.f}, gx = {0.f, 0.f, 0.f, 0.f};
#pragma unroll
    for (int ks = 0; ks < 4; ++ks) {
        const bf16x8 A = *(const bf16x8*)(xcb + (16 * mt + cc) * XCB_LD + 32 * ks + 8 * q4);
        ga = __builtin_amdgcn_mfma_f32_16x16x32_bf16(A, Bwa[ks], ga, 0, 0, 0);
        gx = __builtin_amdgcn_mfma_f32_16x16x32_bf16(A, Bwx[ks], gx, 0, 0, 0);
    }
#pragma unroll
    for (int r = 0; r < 4; ++r) lru_ab(ga[r], gx[r], ba, bx, sp, xcf[(16 * mt + 4 * q4 + r) * XCF_LD + chl], a[r], b[r]);
}

__device__ __forceinline__ void carry_phase(const Params& p, int bid, int nblk) {
    int tid = threadIdx.x; asm volatile("" : "+v"(tid));
    const float* SUMS = (const float*)(p.ws + WS_SUMS); float* CARRY = (float*)(p.ws + WS_CARRY);
    for (int gid = bid * 512 + tid; gid < 4096; gid += nblk * 512) {
        const int b = gid >> 11, d = (gid >> 10) & 1, ch = gid & 1023;
        const float* sb = SUMS + (size_t)b * NSEG * 4096 + d * 2048 + ch;
        float* cb = CARRY + (size_t)b * 128 * 2048 + d * 1024 + ch;
        if (d == 0) {
            float h = sb[1024]; h = sb[4096] * h + sb[4096 + 1024];
#pragma unroll 8
            for (int c = 0; c < 128; ++c) { cb[(size_t)c * 2048] = h; h = sb[(size_t)(c + 2) * 4096] * h + sb[(size_t)(c + 2) * 4096 + 1024]; }
        } else {
            float h = sb[4096 + 1024]; h = sb[0] * h + sb[1024];
#pragma unroll 8
            for (int c = 127; c >= 0; --c) { cb[(size_t)c * 2048] = h; h = sb[(size_t)(c + 2) * 4096] * h + sb[(size_t)(c + 2) * 4096 + 1024]; }
        }
    }
}

__device__ __forceinline__ void wait_count(unsigned* ctr, unsigned target) {
    unsigned sp = 0u;
    while (__hip_atomic_load(ctr, __ATOMIC_RELAXED, __HIP_MEMORY_SCOPE_AGENT) < target) { __builtin_amdgcn_s_sleep(2); if (++sp > (1u << 22)) break; }
    __builtin_amdgcn_fence(__ATOMIC_ACQUIRE, "agent");
    asm volatile("s_waitcnt vmcnt(0)" ::: "memory");
}
template <bool APPLY>
__device__ __forceinline__ void lru_phase(const Params& p, unsigned char* lds, int bid, int nblk) {
    int tid = threadIdx.x; asm volatile("" : "+v"(tid));
    const int lane = tid & 63, w = __builtin_amdgcn_readfirstlane(tid >> 6), cc = lane & 15, q4 = lane >> 4;
    const int pg = tid >> 4, c8 = tid & 15;
    bf16_t* xcb = (bf16_t*)lds;
    float* xcf = (float*)(lds + 34816);
    float* cw = (float*)(lds + 102400);
    const bf16_t* PROJ = (const bf16_t*)(p.ws + WS_PROJ);
    float* SUMS = (float*)(p.ws + WS_SUMS);
    const float* SP = (const float*)(p.ws + WS_SP);
    const float* CARRY = (const float*)(p.ws + WS_CARRY);
    bf16_t* Y = (bf16_t*)(p.ws + WS_HN);
    const bf16_t* LRUW = (const bf16_t*)(p.ws + WS_LRUW);
    constexpr int NS = APPLY ? 128 : NSEG;
    const int nitems = 2 * NS * 8;
    int cur_h = -1;
    const int chl = 16 * w + cc;
    bf16x8 Bw[2][2][4];
    float ba[2], bx[2], sp[2];
#pragma unroll
    for (int d = 0; d < 2; ++d) { ba[d] = 0.f; bx[d] = 0.f; sp[d] = 0.f;
#pragma unroll
        for (int m = 0; m < 2; ++m)
#pragma unroll
            for (int ks = 0; ks < 4; ++ks) Bw[d][m][ks] = (bf16x8){0, 0, 0, 0, 0, 0, 0, 0}; }
#define LRU_DECODE(it_) const int h = (it_) & 7, bs = (it_) >> 3, b = APPLY ? bs / NS : (bs < 256 ? bs >> 7 : (bs - 256) >> 1), sg = APPLY ? bs % NS : (bs < 256 ? 2 + (bs & 127) : (bs - 256) & 1); const int seg = APPLY ? sg + 2 : sg; const bool isctx = seg < 2;        \
        const int L = isctx ? CTXL : SEQ; const int p0 = isctx ? seg * 128 : (seg - 2) * 128; const size_t rowbase = isctx ? (size_t)(MLAT + b * CTXL) : (size_t)b * SEQ;
#define LRU_LOADRAW(dst) { _Pragma("unroll") for (int i = 0; i < 7; ++i) { const int r = p0 + 4 * pg - 2 + i; const bool ok = (r >= 0) && (r < L); \
            dst[i] = ok ? *(const u32x4*)(PROJ + (rowbase + (size_t)(ok ? r : 0)) * INW + h * 128 + 8 * c8) : (u32x4){0u, 0u, 0u, 0u}; } }
    bool ctx_ready = !(G1_I8 && CTX_SPLIT) || APPLY;
#define LRU_CTXWAIT(it_) if (!ctx_ready && ((it_) >> 3) >= 256) { if (tid == 0) wait_count((unsigned*)(p.ws + WS_CTL + CTXDONE_OFS), 8u); __syncthreads(); ctx_ready = true; }
    u32x4 rw[7];
    unsigned* lctr = (unsigned*)(p.ws + WS_CTL + 45120) + (bid & 7);
    volatile int* nxl = (volatile int*)(lds + 105216);
    int it = bid, itn = bid + nblk, itnn = 0;
    if (!APPLY) {
        if (tid == 0) { nxl[0] = (int)atomicAdd(lctr, 1u) * 8 + (bid & 7); nxl[1] = (int)atomicAdd(lctr, 1u) * 8 + (bid & 7); }
        __syncthreads();
        it = nxl[0]; itn = nxl[1];
        __syncthreads();
        if (it < nitems) { LRU_CTXWAIT(it) LRU_DECODE(it) LRU_LOADRAW(rw) }
    }
    for (; it < nitems; it = itn, itn = APPLY ? itn + nblk : itnn) {
        LRU_DECODE(it)
        if (!APPLY) { if (tid == 0) nxl[0] = (int)atomicAdd(lctr, 1u) * 8 + (bid & 7); }
        if (APPLY) { LRU_LOADRAW(rw) }
#define LRU_LOADW2(d_, W0, W1) { const bf16_t* wa_ = LRUW + ((size_t)(((d_) * 2 + 0) * 8 + h) * 128 + chl) * 128 + 8 * q4; const bf16_t* wx_ = LRUW + ((size_t)(((d_) * 2 + 1) * 8 + h) * 128 + chl) * 128 + 8 * q4; \
            _Pragma("unroll") for (int ks = 0; ks < 4; ++ks) { W0[ks] = *(const bf16x8*)(wa_ + 32 * ks); W1[ks] = *(const bf16x8*)(wx_ + 32 * ks); } }
        if (h != cur_h) {
            cur_h = h;
#pragma unroll
            for (int d = 0; d < 2; ++d) {
                if (APPLY) { ba[d] = -1.4426950408889634f * p.lru_ba[d * 1024 + h * 128 + chl]; bx[d] = -1.4426950408889634f * p.lru_bx[d * 1024 + h * 128 + chl]; sp[d] = -8.0f * 1.4426950408889634f * SP[d * 1024 + h * 128 + chl]; continue; }
                const bf16_t* wa_ = LRUW + ((size_t)((d * 2 + 0) * 8 + h) * 128 + chl) * 128 + 8 * q4; const bf16_t* wx_ = LRUW + ((size_t)((d * 2 + 1) * 8 + h) * 128 + chl) * 128 + 8 * q4;
#pragma unroll
                for (int ks = 0; ks < 4; ++ks) { Bw[d][0][ks] = *(const bf16x8*)(wa_ + 32 * ks); Bw[d][1][ks] = *(const bf16x8*)(wx_ + 32 * ks); }
                ba[d] = -1.4426950408889634f * p.lru_ba[d * 1024 + h * 128 + chl]; bx[d] = -1.4426950408889634f * p.lru_bx[d * 1024 + h * 128 + chl]; sp[d] = -8.0f * 1.4426950408889634f * SP[d * 1024 + h * 128 + chl];
            }
            for (int i = tid; i < 640; i += 512) { const int k = i >> 7, ch = i & 127; cw[i] = (k < 4) ? p.conv_w[k * 1024 + h * 128 + ch] : p.conv_b[h * 128 + ch]; }
            __syncthreads();
        }
        {
            f32x4 wk[5][2];
#pragma unroll
            for (int k = 0; k < 5; ++k) { wk[k][0] = *(const f32x4*)(cw + k * 128 + 8 * c8); wk[k][1] = *(const f32x4*)(cw + k * 128 + 8 * c8 + 4); }
#pragma unroll
            for (int j = 0; j < 4; ++j) {
                f32x4 x0 = wk[4][0], x1 = wk[4][1];
#pragma unroll
                for (int k = 0; k < 4; ++k) { const u32x4 r = rw[j + k];
                    x0 += wk[k][0] * (f32x4){bflo(r[0]), bfhi(r[0]), bflo(r[1]), bfhi(r[1])};
                    x1 += wk[k][1] * (f32x4){bflo(r[2]), bfhi(r[2]), bflo(r[3]), bfhi(r[3])}; }
                const int pos = 4 * pg + j;
                *(f32x4*)(xcf + pos * XCF_LD + 8 * c8) = x0; *(f32x4*)(xcf + pos * XCF_LD + 8 * c8 + 4) = x1;
                u32x4 o; o.x = pk2(x0[0], x0[1]); o.y = pk2(x0[2], x0[3]); o.z = pk2(x1[0], x1[1]); o.w = pk2(x1[2], x1[3]);
                *(u32x4*)(xcb + pos * XCB_LD + 8 * c8) = o;
            }
        }
        u32x4 gt[4]; float cf = 0.f, cbw = 0.f;
        if (APPLY) {
            const float* cp = CARRY + ((size_t)(b * 128 + sg) * 2) * 1024 + h * 128 + chl; cf = cp[0]; cbw = cp[1024];
        }
        if (!APPLY) { if (itn < nitems) { LRU_CTXWAIT(itn) LRU_DECODE(itn) LRU_LOADRAW(rw) } }
        __syncthreads();
        if (!APPLY) itnn = nxl[0];
        if (APPLY) {
            float y[8][4];
#pragma unroll
            for (int mt = 0; mt < 8; ++mt)
#pragma unroll
                for (int r = 0; r < 4; ++r) y[mt][r] = 0.f;
            float stf = cf, stb = cbw;
            bf16x8 Wf0[4], Wf1[4];
            LRU_LOADW2(0, Wf0, Wf1)
#pragma unroll
            for (int i = 0; i < 8; ++i) {
                const int mt = i; float a[4], bb[4];
                lru_gates1(xcb, xcf, mt, cc, q4, chl, Wf0, Wf1, ba[0], bx[0], sp[0], a, bb);
                float A4 = a[0], B4 = bb[0];
#pragma unroll
                for (int r = 1; r < 4; ++r) { B4 = a[r] * B4 + bb[r]; A4 *= a[r]; }
                const float A0 = __shfl(A4, cc), A1 = __shfl(A4, cc + 16), A2 = __shfl(A4, cc + 32), A3 = __shfl(A4, cc + 48);
                const float B0 = __shfl(B4, cc), B1 = __shfl(B4, cc + 16), B2 = __shfl(B4, cc + 32), B3 = __shfl(B4, cc + 48);
                const float s0 = stf, s1 = A0 * s0 + B0, s2 = A1 * s1 + B1, s3 = A2 * s2 + B2, s4 = A3 * s3 + B3;
                float hh = (q4 == 0) ? s0 : (q4 == 1) ? s1 : (q4 == 2) ? s2 : s3;
#pragma unroll
                for (int r = 0; r < 4; ++r) { hh = a[r] * hh + bb[r]; y[mt][r] += hh; }
                stf = s4;
                if (i & 1) __builtin_amdgcn_sched_barrier(0);
            }
            bf16x8 Wb0[4], Wb1[4];
            LRU_LOADW2(1, Wb0, Wb1)
#pragma unroll
            for (int i = 0; i < 8; ++i) {
                const int mt = 7 - i; float a[4], bb[4];
                lru_gates1(xcb, xcf, mt, cc, q4, chl, Wb0, Wb1, ba[1], bx[1], sp[1], a, bb);
                float A4 = a[3], B4 = bb[3];
#pragma unroll
                for (int r = 2; r >= 0; --r) { B4 = a[r] * B4 + bb[r]; A4 *= a[r]; }
                const float A0 = __shfl(A4, cc), A1 = __shfl(A4, cc + 16), A2 = __shfl(A4, cc + 32), A3 = __shfl(A4, cc + 48);
                const float B0 = __shfl(B4, cc), B1 = __shfl(B4, cc + 16), B2 = __shfl(B4, cc + 32), B3 = __shfl(B4, cc + 48);
                const float s0 = stb, s1 = A3 * s0 + B3, s2 = A2 * s1 + B2, s3 = A1 * s2 + B1, s4 = A0 * s3 + B0;
                float hh = (q4 == 3) ? s0 : (q4 == 2) ? s1 : (q4 == 1) ? s2 : s3;
#pragma unroll
                for (int r = 3; r >= 0; --r) { hh = a[r] * hh + bb[r]; y[mt][r] += hh; }
                stb = s4;
                if (i & 1) __builtin_amdgcn_sched_barrier(0);
            }
#pragma unroll
            for (int j = 0; j < 4; ++j) gt[j] = *(const u32x4*)(PROJ + (rowbase + p0 + 4 * pg + j) * INW + 1024 + h * 128 + 8 * c8);
            __syncthreads();
#pragma unroll
            for (int mt = 0; mt < 8; ++mt)
#pragma unroll
                for (int r = 0; r < 4; ++r) xcf[(16 * mt + 4 * q4 + r) * XCF_LD + chl] = y[mt][r];
            __syncthreads();
#pragma unroll
            for (int j = 0; j < 4; ++j) {
                const int pos = 4 * pg + j;
                const f32x4 y0 = *(const f32x4*)(xcf + pos * XCF_LD + 8 * c8), y1 = *(const f32x4*)(xcf + pos * XCF_LD + 8 * c8 + 4);
                const u32x4 g = gt[j];
                u32x4 o;
                o.x = pk2(gelu_tanh(bflo(g[0])) * y0[0], gelu_tanh(bfhi(g[0])) * y0[1]); o.y = pk2(gelu_tanh(bflo(g[1])) * y0[2], gelu_tanh(bfhi(g[1])) * y0[3]);
                o.z = pk2(gelu_tanh(bflo(g[2])) * y1[0], gelu_tanh(bfhi(g[2])) * y1[1]); o.w = pk2(gelu_tanh(bflo(g[3])) * y1[2], gelu_tanh(bfhi(g[3])) * y1[3]);
                *(u32x4*)(Y + (rowbase + p0 + pos) * D + h * 128 + 8 * c8) = o;
            }
        } else {
            float TA[2] = {1.f, 1.f}, TB[2] = {0.f, 0.f};
#pragma unroll 2
            for (int mt = 0; mt < 8; ++mt) {
                f32x4 gaf = {0.f, 0.f, 0.f, 0.f}, gxf = gaf, gab = gaf, gxb = gaf;
#pragma unroll
                for (int ks = 0; ks < 4; ++ks) {
                    const bf16x8 A = *(const bf16x8*)(xcb + (16 * mt + cc) * XCB_LD + 32 * ks + 8 * q4);
                    gaf = __builtin_amdgcn_mfma_f32_16x16x32_bf16(A, Bw[0][0][ks], gaf, 0, 0, 0);
                    gxf = __builtin_amdgcn_mfma_f32_16x16x32_bf16(A, Bw[0][1][ks], gxf, 0, 0, 0);
                    gab = __builtin_amdgcn_mfma_f32_16x16x32_bf16(A, Bw[1][0][ks], gab, 0, 0, 0);
                    gxb = __builtin_amdgcn_mfma_f32_16x16x32_bf16(A, Bw[1][1][ks], gxb, 0, 0, 0);
                }
                float af[4], bf[4], ab[4], bbk[4];
                float lf[4], lb[4];
#pragma unroll
                for (int r = 0; r < 4; ++r) { const float xv = xcf[(16 * mt + 4 * q4 + r) * XCF_LD + chl];
                    lru_abl(gaf[r], gxf[r], ba[0], bx[0], sp[0], xv, af[r], bf[r], lf[r]); lru_abl(gab[r], gxb[r], ba[1], bx[1], sp[1], xv, ab[r], bbk[r], lb[r]); }
                if (GATE_STORE && p.gate_store && !isctx) {
                    const size_t gi = ((((size_t)((b * 128 + (seg - 2)) * 8 + h)) * 8 + mt) * 8 + w) * 64 + lane;
                    u32x4 of, ob;
#pragma unroll
                    for (int r = 0; r < 4; ++r) { of[r] = pg8::cvt_pk_bf16(lf[r], bf[r]); ob[r] = pg8::cvt_pk_bf16(lb[r], bbk[r]); }
                    __builtin_nontemporal_store(of, (u32x4*)(p.ws + WS_GABF) + gi); __builtin_nontemporal_store(ob, (u32x4*)(p.ws + WS_GABB) + gi); }
                float FA = af[0], FB = bf[0], RA = ab[3], RB = bbk[3];
#pragma unroll
                for (int r = 1; r < 4; ++r) { FB = af[r] * FB + bf[r]; FA *= af[r]; }
#pragma unroll
                for (int r = 2; r >= 0; --r) { RB = ab[r] * RB + bbk[r]; RA *= ab[r]; }
                {   const float A0 = __shfl(FA, cc), A1 = __shfl(FA, cc + 16), A2 = __shfl(FA, cc + 32), A3 = __shfl(FA, cc + 48);
                    const float B0 = __shfl(FB, cc), B1 = __shfl(FB, cc + 16), B2 = __shfl(FB, cc + 32), B3 = __shfl(FB, cc + 48);
                    const float At = A0 * A1 * A2 * A3, Bt = ((B0 * A1 + B1) * A2 + B2) * A3 + B3;
                    TB[0] = At * TB[0] + Bt; TA[0] = TA[0] * At; }
                {   const float A0 = __shfl(RA, cc), A1 = __shfl(RA, cc + 16), A2 = __shfl(RA, cc + 32), A3 = __shfl(RA, cc + 48);
                    const float B0 = __shfl(RB, cc), B1 = __shfl(RB, cc + 16), B2 = __shfl(RB, cc + 32), B3 = __shfl(RB, cc + 48);
                    const float At = A0 * A1 * A2 * A3, Bt = ((B3 * A2 + B2) * A1 + B1) * A0 + B0;
                    TB[1] = TA[1] * Bt + TB[1]; TA[1] = At * TA[1]; }
            }
            if (q4 == 0) {
#pragma unroll
                for (int d = 0; d < 2; ++d) { float* sb = SUMS + ((size_t)(b * NSEG + seg) * 2 + d) * 2048 + h * 128 + chl; sb[0] = TA[d]; sb[1024] = TB[d]; }
            }
        }
        __syncthreads();
    }
#undef LRU_DECODE
#undef LRU_LOADRAW
#undef LRU_LOADW2
#undef LRU_CTXWAIT
}

__device__ __forceinline__ void lru_apply2(const Params& p, unsigned char* lds, int bid, int nblk) {
    int tid = threadIdx.x; asm volatile("" : "+v"(tid));
    const int lane = tid & 63, w = __builtin_amdgcn_readfirstlane(tid >> 6), cc = lane & 15, q4 = lane >> 4;
    const int pg = tid >> 4, c8 = tid & 15;
    float* xcf = (float*)(lds + 34816);
    const bf16_t* PROJ = (const bf16_t*)(p.ws + WS_PROJ); const float* CARRY = (const float*)(p.ws + WS_CARRY); bf16_t* Y = (bf16_t*)(p.ws + WS_HN);
    const int chl = 16 * w + cc;
    for (int it = bid; it < 2 * 128 * 8; it += nblk) {
        const int h = it & 7, bs = it >> 3, b = bs >> 7, sg = bs & 127, p0 = sg * 128; const size_t rowbase = (size_t)b * SEQ;
        const u32x4* gf = (const u32x4*)(p.ws + WS_GABF) + (((size_t)it * 8) * 8 + w) * 64 + lane;
        const u32x4* gb = (const u32x4*)(p.ws + WS_GABB) + (((size_t)it * 8) * 8 + w) * 64 + lane;
        const float* cp = CARRY + ((size_t)(b * 128 + sg) * 2) * 1024 + h * 128 + chl; float stf = cp[0], stb = cp[1024];
        u32x4 GF[8], GB[8], gt[4];
#pragma unroll
        for (int mt = 0; mt < 8; ++mt) GF[mt] = __builtin_nontemporal_load(gf + mt * 512);
#pragma unroll
        for (int i = 0; i < 8; ++i) GB[7 - i] = __builtin_nontemporal_load(gb + (7 - i) * 512);
#pragma unroll
        for (int j = 0; j < 4; ++j) gt[j] = *(const u32x4*)(PROJ + (rowbase + p0 + 4 * pg + j) * INW + 1024 + h * 128 + 8 * c8);
        float y[8][4];
#pragma unroll
        for (int i = 0; i < 8; ++i) {
            const int mt = i; float a[4], bb[4];
#pragma unroll
            for (int r = 0; r < 4; ++r) { a[r] = __builtin_amdgcn_exp2f(bflo(GF[mt][r])); bb[r] = bfhi(GF[mt][r]); }
            float A4 = a[0], B4 = bb[0];
#pragma unroll
            for (int r = 1; r < 4; ++r) { B4 = a[r] * B4 + bb[r]; A4 *= a[r]; }
            float A0, A1, A2, A3; row_bcast4(A4, A0, A1, A2, A3);
            float B0, B1, B2, B3; row_bcast4(B4, B0, B1, B2, B3);
            const float s0 = stf, s1 = A0 * s0 + B0, s2 = A1 * s1 + B1, s3 = A2 * s2 + B2, s4 = A3 * s3 + B3;
            float hh = (q4 == 0) ? s0 : (q4 == 1) ? s1 : (q4 == 2) ? s2 : s3;
#pragma unroll
            for (int r = 0; r < 4; ++r) { hh = a[r] * hh + bb[r]; y[mt][r] = hh; }
            stf = s4;
        }
#pragma unroll
        for (int i = 0; i < 8; ++i) {
            const int mt = 7 - i; float a[4], bb[4];
#pragma unroll
            for (int r = 0; r < 4; ++r) { a[r] = __builtin_amdgcn_exp2f(bflo(GB[mt][r])); bb[r] = bfhi(GB[mt][r]); }
            float A4 = a[3], B4 = bb[3];
#pragma unroll
            for (int r = 2; r >= 0; --r) { B4 = a[r] * B4 + bb[r]; A4 *= a[r]; }
            float A0, A1, A2, A3; row_bcast4(A4, A0, A1, A2, A3);
            float B0, B1, B2, B3; row_bcast4(B4, B0, B1, B2, B3);
            const float s0 = stb, s1 = A3 * s0 + B3, s2 = A2 * s1 + B2, s3 = A1 * s2 + B1, s4 = A0 * s3 + B0;
            float hh = (q4 == 3) ? s0 : (q4 == 2) ? s1 : (q4 == 1) ? s2 : s3;
#pragma unroll
            for (int r = 3; r >= 0; --r) { hh = a[r] * hh + bb[r]; y[mt][r] += hh; }
            stb = s4;
        }
#pragma unroll
        for (int mt = 0; mt < 8; ++mt)
#pragma unroll
            for (int r = 0; r < 4; ++r) xcf[(16 * mt + 4 * q4 + r) * XCF_LD + chl] = y[mt][r];
        __syncthreads();
#pragma unroll
        for (int j = 0; j < 4; ++j) {
            const int pos = 4 * pg + j;
            const f32x4 y0 = *(const f32x4*)(xcf + pos * XCF_LD + 8 * c8), y1 = *(const f32x4*)(xcf + pos * XCF_LD + 8 * c8 + 4);
            const u32x4 g = gt[j];
            u32x4 o;
            o.x = pk2(gelu_tanh(bflo(g[0])) * y0[0], gelu_tanh(bfhi(g[0])) * y0[1]); o.y = pk2(gelu_tanh(bflo(g[1])) * y0[2], gelu_tanh(bfhi(g[1])) * y0[3]);
            o.z = pk2(gelu_tanh(bflo(g[2])) * y1[0], gelu_tanh(bfhi(g[2])) * y1[1]); o.w = pk2(gelu_tanh(bflo(g[3])) * y1[2], gelu_tanh(bfhi(g[3])) * y1[3]);
            *(u32x4*)(Y + (rowbase + p0 + pos) * D + h * 128 + 8 * c8) = o;
        }
        __syncthreads();
    }
}

__device__ __forceinline__ void sgu_phase(const Params& p, unsigned char* lds, int bid, int nblk) {
    int tid = threadIdx.x; asm volatile("" : "+v"(tid));
    const int lane = tid & 63, w = __builtin_amdgcn_readfirstlane(tid >> 6), cc = lane & 15, q4 = lane >> 4;
    bf16_t* vgT = (bf16_t*)lds;
    float* part = (float*)(lds + 34816);
    bf16_t* Wl = (bf16_t*)(lds + 38912);
    const bf16_t* PROJ = (const bf16_t*)(p.ws + WS_PROJ);
    const bf16_t* WS_ = (const bf16_t*)(p.ws + WS_SGUW);
    bf16_t* Y = (bf16_t*)(p.ws + WS_HN);
    const int pp1 = tid & 127, cg4 = tid >> 7;
    const int c0 = 16 * w + 4 * q4;
    const int g = bid & 7;
    unsigned* ctr = (unsigned*)(p.ws + WS_CTL + 45056) + g;
    volatile int* nxtw = (volatile int*)(lds + 73728);
    if (tid == 0) nxtw[0] = (int)atomicAdd(ctr, 1u);
#pragma unroll
    for (int e = 0; e < 4; ++e) { const int i = tid + 512 * e; const int r = i >> 4, c16 = i & 15; *(u32x4*)(Wl + r * XCB_LD + 8 * c16) = *(const u32x4*)(WS_ + ((size_t)g * 128 + r) * 128 + 8 * c16); }
    __syncthreads();
    int jt = nxtw[0];
    float bsr[8];
#pragma unroll
    for (int nt = 0; nt < 8; ++nt) bsr[nt] = p.sgu_b[g * 128 + 16 * nt + cc];
    u32x4 vr[4];
    if (jt < 256) { const u32x4* src = (const u32x4*)(PROJ + ((size_t)(jt >> 7) * SEQ + (size_t)(jt & 127) * 128 + pp1) * INW + 3072 + g * 128 + 32 * cg4);
#pragma unroll
        for (int e = 0; e < 4; ++e) vr[e] = src[e]; }
    while (jt < 256) {
        const int n = jt & 127, b = jt >> 7;
        const size_t rowbase = (size_t)b * SEQ + (size_t)n * 128;
        if (tid == 0) nxtw[1] = (int)atomicAdd(ctr, 1u);
        u32x2 ur[8];
#pragma unroll
        for (int nt = 0; nt < 8; ++nt) ur[nt] = *(const u32x2*)(PROJ + (rowbase + 16 * nt + cc) * INW + 2048 + g * 128 + c0);
        {
            float gv[32]; float s1 = 0.f, s2 = 0.f;
#pragma unroll
            for (int e = 0; e < 4; ++e) { const u32x4 r = vr[e];
#pragma unroll
                for (int j = 0; j < 4; ++j) { const float lo = gelu_tanh(bflo(r[j])), hi = gelu_tanh(bfhi(r[j])); gv[8 * e + 2 * j] = lo; gv[8 * e + 2 * j + 1] = hi; s1 += lo + hi; s2 += lo * lo + hi * hi; } }
            part[(cg4 * 128 + pp1) * 2] = s1; part[(cg4 * 128 + pp1) * 2 + 1] = s2;
            __syncthreads();
            jt = nxtw[1];
            if (jt < 256) { const u32x4* src = (const u32x4*)(PROJ + ((size_t)(jt >> 7) * SEQ + (size_t)(jt & 127) * 128 + pp1) * INW + 3072 + g * 128 + 32 * cg4);
#pragma unroll
                for (int e = 0; e < 4; ++e) vr[e] = src[e]; }
            float ts = 0.f, ts2 = 0.f;
#pragma unroll
            for (int k = 0; k < 4; ++k) { ts += part[(k * 128 + pp1) * 2]; ts2 += part[(k * 128 + pp1) * 2 + 1]; }
            const float mu = ts * (1.0f / 128.0f); const float var = fmaxf(ts2 * (1.0f / 128.0f) - mu * mu, 0.f); const float rstd = rsqrtf(var + EPS);
#pragma unroll
            for (int j = 0; j < 32; ++j) vgT[(32 * cg4 + j) * XCB_LD + pp1] = (bf16_t)f2bf((gv[j] - mu) * rstd);
        }
        __syncthreads();
        {
            bf16x8 Af[4];
#pragma unroll
            for (int ks = 0; ks < 4; ++ks) Af[ks] = *(const bf16x8*)(vgT + (16 * w + cc) * XCB_LD + 32 * ks + 8 * q4);
#pragma unroll
            for (int nt = 0; nt < 8; ++nt) {
                const int pp = 16 * nt + cc;
                f32x4 acc = {0.f, 0.f, 0.f, 0.f};
#pragma unroll
                for (int ks = 0; ks < 4; ++ks) { const bf16x8 Bf = *(const bf16x8*)(Wl + pp * XCB_LD + 32 * ks + 8 * q4); acc = __builtin_amdgcn_mfma_f32_16x16x32_bf16(Af[ks], Bf, acc, 0, 0, 0); }
                const float bsv = bsr[nt];
                const u32x2 uu = ur[nt];
                const float y0 = gelu_tanh(bflo(uu.x)) * (acc[0] + bsv), y1 = gelu_tanh(bfhi(uu.x)) * (acc[1] + bsv), y2 = gelu_tanh(bflo(uu.y)) * (acc[2] + bsv), y3 = gelu_tanh(bfhi(uu.y)) * (acc[3] + bsv);
                u32x2 o; o.x = pk2(y0, y1); o.y = pk2(y2, y3);
                *(u32x2*)(Y + (rowbase + pp) * D + 1024 + g * 128 + c0) = o;
            }
        }
        __syncthreads();
    }
}

#define INS16(S, x) do { int _x = (x); _Pragma("unroll") for (int _j = 0; _j < 16; ++_j) { const int _hi = max(S[_j], _x); _x = min(S[_j], _x); S[_j] = _hi; } } while (0)
#define MERGE16(A, B) do { _Pragma("unroll") for (int _i = 0; _i < 16; ++_i) A[_i] = max(A[_i], B[15 - _i]); \
    _Pragma("unroll") for (int _st = 8; _st >= 1; _st >>= 1) { _Pragma("unroll") for (int _i = 0; _i < 16; ++_i) if ((_i & _st) == 0) { const int _hi = max(A[_i], A[_i + _st]), _lo = min(A[_i], A[_i + _st]); A[_i] = _hi; A[_i + _st] = _lo; } } } while (0)
#define SORT16(S) { _Pragma("unroll") for (int kk = 2; kk <= 16; kk <<= 1) _Pragma("unroll") for (int jj2 = kk >> 1; jj2 > 0; jj2 >>= 1) _Pragma("unroll") for (int i = 0; i < 16; ++i) { const int l = i ^ jj2; \
        if (l > i) { const int hi = max(S[i], S[l]), lo = min(S[i], S[l]); const bool desc = ((i & kk) == 0); S[i] = desc ? hi : lo; S[l] = desc ? lo : hi; } } }
#define QMERGE(S, CTRL) { int T_[16]; _Pragma("unroll") for (int i_ = 0; i_ < 16; ++i_) T_[i_] = max(S[i_], dpp_i<CTRL>(S[15 - i_])); \
        _Pragma("unroll") for (int st_ = 8; st_ >= 1; st_ >>= 1) { _Pragma("unroll") for (int i_ = 0; i_ < 16; ++i_) if ((i_ & st_) == 0) { const int hi_ = max(T_[i_], T_[i_ + st_]), lo_ = min(T_[i_], T_[i_ + st_]); T_[i_] = hi_; T_[i_ + st_] = lo_; } } \
        _Pragma("unroll") for (int i_ = 0; i_ < 16; ++i_) S[i_] = T_[i_]; }
__device__ __forceinline__ void topk_phase(const Params& p, unsigned char* lds, int bid, int nblk) {
    int tid = threadIdx.x; asm volatile("" : "+v"(tid));
    const int lane = tid & 63, w = __builtin_amdgcn_readfirstlane(tid >> 6), cc = lane & 15, q4 = lane >> 4;
    constexpr int QT_LD = 264;
    bf16_t* qt = (bf16_t*)lds;
    constexpr int ST_LD = 132;
    float* ST = (float*)(lds + 67584);
    constexpr int LL_LD = 33;
    int* LL = (int*)(lds + 135168);
    const bf16_t* Q = (const bf16_t*)(p.ws + WS_PROJ);
    int* TOPI = (int*)(p.ws + WS_TOPI); float* TOPG = (float*)(p.ws + WS_TOPG);
    const int srow = 16 * w + (lane >> 5), scol = 8 * (lane & 31);
    const int t = tid >> 2, kq = tid & 3;
    int code[13];
    {   int cnt = 0;
#pragma unroll
        for (int c = 0; c < 13; ++c) code[c] = -1;
#pragma unroll
        for (int i = 0; i < 16; ++i)
#pragma unroll
            for (int j = 0; j < 16; ++j)
                if ((i + 1) * (j + 1) <= 16) { code[cnt >> 2] = ((cnt & 3) == kq) ? (i * 16 + j) : code[cnt >> 2]; ++cnt; } }
    int cur_h = -1;
    bf16x8 Ak[2][4];
#pragma unroll
    for (int hf = 0; hf < 2; ++hf)
#pragma unroll
        for (int ks = 0; ks < 4; ++ks) Ak[hf][ks] = (bf16x8){0, 0, 0, 0, 0, 0, 0, 0};
    u32x4 qr[8];
    if (bid < 2048) { const int h0 = bid & 7, t0 = (bid >> 3) * 128; const bf16_t* src = Q + (size_t)(t0 + srow) * D + h0 * 256 + scol;
#pragma unroll
        for (int e = 0; e < 8; ++e) qr[e] = *(const u32x4*)(src + (size_t)(2 * e) * D); }
    for (int it = bid; it < 2048; it += nblk) {
        const int h = it & 7, tok0 = (it >> 3) * 128;
        if (h != cur_h) { cur_h = h;
#pragma unroll
            for (int hf = 0; hf < 2; ++hf) { const bf16_t* kb = (const bf16_t*)(p.ws + (hf ? WS_K2 : WS_K1)) + ((size_t)h * 128 + 16 * w + cc) * 128 + 8 * q4;
#pragma unroll
                for (int ks = 0; ks < 4; ++ks) Ak[hf][ks] = *(const bf16x8*)(kb + 32 * ks); } }
#pragma unroll
        for (int e = 0; e < 8; ++e) *(u32x4*)(qt + (srow + 2 * e) * QT_LD + scol) = qr[e];
        if (it + nblk < 2048) { const int h1 = (it + nblk) & 7, t1 = ((it + nblk) >> 3) * 128; const bf16_t* src = Q + (size_t)(t1 + srow) * D + h1 * 256 + scol;
#pragma unroll
            for (int e = 0; e < 8; ++e) qr[e] = *(const u32x4*)(src + (size_t)(2 * e) * D); }
        __syncthreads();
#pragma unroll
        for (int half = 0; half < 2; ++half) {
            if (half == 1) __syncthreads();
#pragma unroll 2
            for (int n = 0; n < 8; ++n) {
                f32x4 acc = {0.f, 0.f, 0.f, 0.f};
#pragma unroll
                for (int ks = 0; ks < 4; ++ks) { const bf16x8 Bf = *(const bf16x8*)(qt + (16 * n + cc) * QT_LD + half * 128 + 32 * ks + 8 * q4); acc = __builtin_amdgcn_mfma_f32_16x16x32_bf16(Ak[half][ks], Bf, acc, 0, 0, 0); }
#pragma unroll
                for (int r = 0; r < 4; ++r) ST[(16 * w + 4 * q4 + r) * ST_LD + 16 * n + cc] = acc[r];
            }
            __syncthreads();
            int S[16];
            {
                int K2[16];
#pragma unroll
                for (int i = 0; i < 16; ++i) { const int k0 = 16 * (i >> 2) + 4 * kq + (i & 3), k1 = k0 + 64;
                    S[i] = (mono(ST[k0 * ST_LD + t]) & ~127) | (127 - k0); K2[i] = (mono(ST[k1 * ST_LD + t]) & ~127) | (127 - k1); }
                SORT16(S) SORT16(K2)
                MERGE16(S, K2);
            }
            QMERGE(S, DPP_XOR1) QMERGE(S, DPP_XOR2)
            if (kq == 0) {
#pragma unroll
                for (int j = 0; j < 16; ++j) LL[t * LL_LD + half * 16 + j] = S[j]; }
        }
        int S[16];
        {
#pragma unroll
            for (int c = 0; c < 13; ++c) { const int cd = max(code[c], 0); const float f1 = unmono(LL[t * LL_LD + (cd >> 4)] & ~127), f2 = unmono(LL[t * LL_LD + 16 + (cd & 15)] & ~127);
                S[c] = (code[c] >= 0) ? ((mono(f1 + f2) & ~255) | (255 - cd)) : (int)0x80000000; }
            S[13] = (int)0x80000000; S[14] = (int)0x80000000; S[15] = (int)0x80000000;
            SORT16(S)
        }
        QMERGE(S, DPP_XOR1) QMERGE(S, DPP_XOR2)
        {
            int my[4];
#pragma unroll
            for (int m = 0; m < 4; ++m) my[m] = (kq == 0) ? S[m] : (kq == 1) ? S[4 + m] : (kq == 2) ? S[8 + m] : S[12 + m];
            const float mx = unmono(S[0] & ~255);
            f32x4 ev; int idx[4]; float part = 0.f;
#pragma unroll
            for (int m = 0; m < 4; ++m) { const int cd = 255 - (my[m] & 255);
                const int e1 = 127 - (LL[t * LL_LD + (cd >> 4)] & 127), e2 = 127 - (LL[t * LL_LD + 16 + (cd & 15)] & 127);
                idx[m] = e1 * 128 + e2; ev[m] = __expf(unmono(my[m] & ~255) - mx); part += ev[m]; }
            part += dpp_f<DPP_XOR1>(part); part += dpp_f<DPP_XOR2>(part);
            const float inv = 1.0f / part;
            *(int4*)(TOPI + (size_t)(tok0 + t) * 128 + h * 16 + 4 * kq) = make_int4(idx[0], idx[1], idx[2], idx[3]);
            *(f32x4*)(TOPG + (size_t)(tok0 + t) * 128 + h * 16 + 4 * kq) = ev * inv;
        }
    }
}

constexpr size_t WS_PART = WS_PROJ;
constexpr size_t WS_DELTA = WS_HN;
__device__ __forceinline__ int pu_dot_ref(u32x4 qv, u32x4 hv) {
    float d = 0.f;
#pragma unroll
    for (int w = 0; w < 4; ++w)
#pragma unroll
        for (int k = 0; k < 4; ++k) d += sb(qv[w], k) * sb(hv[w], k);
    return (int)d;
}
__device__ __forceinline__ void peer_u_phase(const Params& p, int bid, int nblk) {
    int tid = threadIdx.x; asm volatile("" : "+v"(tid));
    const int lane = tid & 63, wave = __builtin_amdgcn_readfirstlane(tid >> 6), g = lane >> 3, jj = lane & 7;
    const int nx = (nblk % 8 == 0) ? 8 : 1, x = bid % nx, j = bid / nx, J = nblk / nx;
    const unsigned char* UB = p.ws + WS_UB;
    const unsigned char* HN8 = p.ws + WS_HN8; const float* HSC = (const float*)(p.ws + WS_HSC);
    const int* TOPI = (const int*)(p.ws + WS_TOPI); bf16_t* PART = (bf16_t*)(p.ws + WS_PART);
    const bool b2 = (jj & 4) != 0, b1 = (jj & 2) != 0, b0 = (jj & 1) != 0;
    const int tstep = J * 8;
#define PU_IDX(I, t_) { const int tt = min((t_), MLAT - 1); I = *(const int2*)(TOPI + (size_t)tt * 128 + 16 * g + 2 * jj); }
#define PU_ROW1(Q, i_, v_) Q[i_] = *(const u32x4*)(UB + (unsigned)(ubase + (v_)));
#define PU_HALF(Q, I, h_) { GROUP_HALF(I, h_, hx_, hy_) \
        PU_ROW1(Q, 8 * (h_) + 0, dpp_i<0x00>(hx_)) PU_ROW1(Q, 8 * (h_) + 1, dpp_i<0x00>(hy_)) PU_ROW1(Q, 8 * (h_) + 2, dpp_i<0x55>(hx_)) PU_ROW1(Q, 8 * (h_) + 3, dpp_i<0x55>(hy_)) \
        PU_ROW1(Q, 8 * (h_) + 4, dpp_i<0xAA>(hx_)) PU_ROW1(Q, 8 * (h_) + 5, dpp_i<0xAA>(hy_)) PU_ROW1(Q, 8 * (h_) + 6, dpp_i<0xFF>(hx_)) PU_ROW1(Q, 8 * (h_) + 7, dpp_i<0xFF>(hy_)) }
#define PU_Q(Q, H, E, I, t_, s_) { const int tt = min((t_), MLAT - 1); \
        PU_HALF(Q, I, 0) PU_HALF(Q, I, 1) \
        H##_d = *(const u32x2*)(HN8 + (size_t)tt * D + 128 * (s_) + 16 * jj + 8 * (g & 1)); H##_s = HSC[tt]; }
#if U_MODE == 1
#define PU_DOT(Qi, H) (__builtin_amdgcn_sdot4((int)Qi[3], (int)H[3], __builtin_amdgcn_sdot4((int)Qi[2], (int)H[2], __builtin_amdgcn_sdot4((int)Qi[1], (int)H[1], dot4_first(Qi[0], H[0]), false), false), false))
#else
#define PU_DOT(Qi, H) pu_dot_ref(Qi, H)
#endif
#define PU_COMPUTE(Q, H, E, t_, s_) { \
        u32x4 H; { const unsigned ox = (unsigned)dpp_i<DPP_ROR8>((int)H##_d.x), oy = (unsigned)dpp_i<DPP_ROR8>((int)H##_d.y); const bool odd = (g & 1) != 0; \
            H[0] = odd ? ox : H##_d.x; H[1] = odd ? oy : H##_d.y; H[2] = odd ? H##_d.x : ox; H[3] = odd ? H##_d.y : oy; } \
        int acc[16]; \
        _Pragma("unroll") for (int i = 0; i < 16; ++i) acc[i] = PU_DOT(Q[i], H); \
        int r1[8], r2[4], r3[2]; \
        _Pragma("unroll") for (int k = 0; k < 8; ++k) { const int mine = b2 ? acc[8 + k] : acc[k], send = b2 ? acc[k] : acc[8 + k]; r1[k] = mine + dpp_i<DPP_HMIRROR>(send); }        \
        _Pragma("unroll") for (int k = 0; k < 4; ++k) { const int mine = b1 ? r1[4 + k] : r1[k], send = b1 ? r1[k] : r1[4 + k]; r2[k] = mine + dpp_i<DPP_XOR2>(send); } \
        _Pragma("unroll") for (int k = 0; k < 2; ++k) { const int mine = b0 ? r2[2 + k] : r2[k], send = b0 ? r2[k] : r2[2 + k]; r3[k] = mine + dpp_i<DPP_XOR1>(send); } \
        if ((t_) < MLAT) { const float hs = H##_s; const unsigned o = pk2((float)r3[0] * hs, (float)r3[1] * hs); __builtin_nontemporal_store(o, (unsigned*)(PART + ((size_t)(s_) * MLAT + (t_)) * 128 + 16 * g + 2 * jj)); } }
    for (int s = x; s < 16; s += nx) {
        int ubase = s * (16384 * 128) + 16 * jj; asm volatile("" : "+v"(ubase));
        int t0 = j * 8 + wave, t1 = t0 + tstep;
        int2 IA, IB; u32x4 QA[16], QB[16]; u32x2 HA_d, HB_d; float HA_s, HB_s; int2 EA, EB;
        PU_IDX(IA, t0) PU_IDX(IB, t1)
        __builtin_amdgcn_sched_barrier(0);
        PU_Q(QA, HA, EA, IA, t0, s)
        __builtin_amdgcn_sched_barrier(0);
        for (; t0 < MLAT; t0 += 2 * tstep, t1 += 2 * tstep) {
            PU_IDX(IA, t0 + 2 * tstep)
            __builtin_amdgcn_sched_barrier(0);
            PU_Q(QB, HB, EB, IB, t1, s)
            __builtin_amdgcn_sched_barrier(0);
            PU_COMPUTE(QA, HA, EA, t0, s)
            __builtin_amdgcn_sched_barrier(0);
            PU_IDX(IB, t1 + 2 * tstep)
            __builtin_amdgcn_sched_barrier(0);
            PU_Q(QA, HA, EA, IA, t0 + 2 * tstep, s)
            __builtin_amdgcn_sched_barrier(0);
            PU_COMPUTE(QB, HB, EB, t1, s)
            __builtin_amdgcn_sched_barrier(0);
        }
    }
#undef PU_IDX
#undef PU_Q
#undef PU_DOT
#undef PU_COMPUTE
}
__device__ __forceinline__ void peer_w_phase(const Params& p, unsigned char* lds, int bid, int nblk) {
    int tid = threadIdx.x; asm volatile("" : "+v"(tid));
    {
        const u32x4* src4 = (const u32x4*)(p.ws + WS_USC); u32x4* dst4 = (u32x4*)lds;
        _Pragma("unroll 4") for (int i = tid; i < 8192; i += 512) dst4[i] = src4[i];
        __syncthreads();
    }
    const f32x2* USCL = (const f32x2*)lds;
    const bf16_t* PART = (const bf16_t*)(p.ws + WS_PART); const float* TOPG = (const float*)(p.ws + WS_TOPG); const int* TOPI = (const int*)(p.ws + WS_TOPI); const float* USC = (const float*)(p.ws + WS_USC);
    signed char* WQ8 = (signed char*)(p.ws + WS_WQ8); float* SW = (float*)(p.ws + WS_SW);
#define PW_LOAD(ti_, pr_, tg_, q_) { const size_t e_ = 4 * (q_); ti_ = *(const int4*)(TOPI + e_); \
        _Pragma("unroll") for (int s = 0; s < 16; ++s) pr_[s] = __builtin_nontemporal_load((const u32x2*)(PART + (size_t)s * MLAT * 128 + e_)); tg_ = *(const f32x4*)(TOPG + e_); }
#define PW_DO(ti_, pr_, tg_, q_) { const size_t e_ = 4 * (q_); \
        const f32x2 sc0 = USCL[ti_.x], sc1 = USCL[ti_.y], sc2 = USCL[ti_.z], sc3 = USCL[ti_.w]; \
        f32x4 d = {0.f, 0.f, 0.f, 0.f}; \
        _Pragma("unroll") for (int s = 0; s < 16; ++s) d += (f32x4){bflo(pr_[s].x), bfhi(pr_[s].x), bflo(pr_[s].y), bfhi(pr_[s].y)}; \
        const f32x4 wv = {tg_[0] * gelu_tanh(d[0] * sc0.x) * sc0.y, tg_[1] * gelu_tanh(d[1] * sc1.x) * sc1.y, tg_[2] * gelu_tanh(d[2] * sc2.x) * sc2.y, tg_[3] * gelu_tanh(d[3] * sc3.x) * sc3.y}; \
        float am = fmaxf(fmaxf(fabsf(wv[0]), fabsf(wv[1])), fmaxf(fabsf(wv[2]), fabsf(wv[3]))); \
        am = fmaxf(am, dpp_f<DPP_XOR1>(am)); am = fmaxf(am, dpp_f<DPP_XOR2>(am)); \
        am = fmaxf(am, dpp_f<DPP_HMIRROR>(am)); am = fmaxf(am, dpp_f<DPP_MIRROR>(am)); { float a2 = am, b2 = am; swap16(a2, b2); am = fmaxf(a2, b2); }        \
        const float inv = (am > 1e-30f) ? 127.0f / am : 0.f; \
        *(unsigned*)(WQ8 + e_) = q8pack(wv * inv); \
        if ((tid & 3) == 0) SW[e_ >> 4] = am * (1.0f / 127.0f); }
    const size_t NQ = (size_t)MLAT * 32, stepq = (size_t)nblk * 512;
    size_t q = (size_t)bid * 512 + tid;
    int4 tia, tib; u32x2 pra[16], prb[16]; f32x4 tga, tgb;
    if (q < NQ) PW_LOAD(tia, pra, tga, q)
    for (; q < NQ; q += 2 * stepq) {
        if (q + stepq < NQ) PW_LOAD(tib, prb, tgb, q + stepq)
        PW_DO(tia, pra, tga, q)
        if (q + 2 * stepq < NQ) PW_LOAD(tia, pra, tga, q + 2 * stepq)
        if (q + stepq < NQ) PW_DO(tib, prb, tgb, q + stepq)
    }
#undef PW_LOAD
#undef PW_DO
}
__device__ __forceinline__ void peer_v_phase(const Params& p, int bid, int nblk) {
    int tid = threadIdx.x; asm volatile("" : "+v"(tid));
    const int lane = tid & 63, wave = __builtin_amdgcn_readfirstlane(tid >> 6), g = lane >> 3, jj = lane & 7;
    const int nx = (nblk % 8 == 0) ? 8 : 1, x = bid % nx, j = bid / nx, J = nblk / nx;
    const unsigned char* VB = p.ws + WS_VB; const unsigned char* WQ8 = p.ws + WS_WQ8; const float* SW = (const float*)(p.ws + WS_SW); const int* TOPI = (const int*)(p.ws + WS_TOPI);
    const float* MOD = (const float*)(p.ws + WS_MOD); bf16_t* DELTA = (bf16_t*)(p.ws + WS_DELTA);
    const bool b5 = (g & 4) != 0, b4 = (g & 2) != 0, b3 = (g & 1) != 0;
    const int tl = 8 * jj + g;
    const int tstep = J * 8;
#define PV_IDX(I, t_) { const int tt = min((t_), MLAT - 1); I = *(const int2*)(TOPI + (size_t)tt * 128 + 16 * g + 2 * jj); }
#define PV_SB __builtin_amdgcn_sched_barrier(0);
#define PV_ROW1(Q, i_, v_) Q[i_] = *(const u32x4*)(VB + (unsigned)(vbase + (v_)));
#define PV_ROWS(Q, I, h_) { GROUP_HALF(I, h_, hx_, hy_) \
        PV_ROW1(Q, 8 * (h_) + 0, dpp_i<0x00>(hx_)) PV_ROW1(Q, 8 * (h_) + 1, dpp_i<0x00>(hy_)) PV_ROW1(Q, 8 * (h_) + 2, dpp_i<0x55>(hx_)) PV_ROW1(Q, 8 * (h_) + 3, dpp_i<0x55>(hy_)) \
        PV_ROW1(Q, 8 * (h_) + 4, dpp_i<0xAA>(hx_)) PV_ROW1(Q, 8 * (h_) + 5, dpp_i<0xAA>(hy_)) PV_ROW1(Q, 8 * (h_) + 6, dpp_i<0xFF>(hx_)) PV_ROW1(Q, 8 * (h_) + 7, dpp_i<0xFF>(hy_)) }
#define PV_AUX(W, SWv, X, t_) { const int tt = min((t_), MLAT - 1); W##_d = *(const unsigned*)(WQ8 + (size_t)tt * 128 + 16 * g + 4 * (jj & 3)); SWv = SW[(size_t)tt * 8 + g]; }
#define PV_ACC(Q, W, acc, a0_) { _Pragma("unroll") for (int a4 = (a0_); a4 < (a0_) + 2; ++a4) _Pragma("unroll") for (int w = 0; w < 4; ++w) { \
            const unsigned x0 = Q[4 * a4][w], x1 = Q[4 * a4 + 1][w], x2 = Q[4 * a4 + 2][w], x3 = Q[4 * a4 + 3][w]; \
            const unsigned l01 = __builtin_amdgcn_perm(x1, x0, 0x05010400u), h01 = __builtin_amdgcn_perm(x1, x0, 0x07030602u), l23 = __builtin_amdgcn_perm(x3, x2, 0x05010400u), h23 = __builtin_amdgcn_perm(x3, x2, 0x07030602u); \
            acc[4 * w + 0] = (a4 == 0) ? dot4_first(__builtin_amdgcn_perm(l23, l01, 0x05040100u), W[a4]) : __builtin_amdgcn_sdot4((int)__builtin_amdgcn_perm(l23, l01, 0x05040100u), (int)W[a4], acc[4 * w + 0], false); \
            acc[4 * w + 1] = (a4 == 0) ? dot4_first(__builtin_amdgcn_perm(l23, l01, 0x07060302u), W[a4]) : __builtin_amdgcn_sdot4((int)__builtin_amdgcn_perm(l23, l01, 0x07060302u), (int)W[a4], acc[4 * w + 1], false); \
            acc[4 * w + 2] = (a4 == 0) ? dot4_first(__builtin_amdgcn_perm(h23, h01, 0x05040100u), W[a4]) : __builtin_amdgcn_sdot4((int)__builtin_amdgcn_perm(h23, h01, 0x05040100u), (int)W[a4], acc[4 * w + 2], false); \
            acc[4 * w + 3] = (a4 == 0) ? dot4_first(__builtin_amdgcn_perm(h23, h01, 0x07060302u), W[a4]) : __builtin_amdgcn_sdot4((int)__builtin_amdgcn_perm(h23, h01, 0x07060302u), (int)W[a4], acc[4 * w + 3], false); } }
#define PV_FIN(acc, SWv, X, t_) { \
        int r1[8], r2[4], r3[2]; \
        _Pragma("unroll") for (int k = 0; k < 8; ++k) { int lo = acc[k], hi = acc[8 + k]; swap32(lo, hi); r1[k] = lo + hi; }        \
        _Pragma("unroll") for (int k = 0; k < 4; ++k) { int lo = r1[k], hi = r1[4 + k]; swap16(lo, hi); r2[k] = lo + hi; }        \
        _Pragma("unroll") for (int c = 0; c < 2; ++c) { const int mine = b3 ? r2[2 + c] : r2[c], send = b3 ? r2[c] : r2[2 + c]; r3[c] = mine + dpp_i<DPP_ROR8>(send); } \
        const f32x2 gt = ((t_) < SEQ) ? gt0 : gt1; \
        const f32x2 r3t = (f32x2){(float)__shfl(r3[0], tl) * SWv, (float)__shfl(r3[1], tl) * SWv};        \
        const f32x2 dl = gt * r3t; \
        if ((t_) < MLAT) __builtin_nontemporal_store(pk2(dl.x, dl.y), (unsigned*)(DELTA + (size_t)(t_) * D + col)); }
#define PV_STEP(Q, W, SWv, X, IX, IY, t_) { \
        PV_IDX(IY, (t_) + 3 * tstep) PV_SB \
        int acc[16]; _Pragma("unroll") for (int d = 0; d < 16; ++d) acc[d] = 0; \
        { u32x4 Wv; Wv[0] = (unsigned)dpp_i<0x00>((int)W##_d); Wv[1] = (unsigned)dpp_i<0x55>((int)W##_d); Wv[2] = 0u; Wv[3] = 0u; PV_ACC(Q, Wv, acc, 0) } PV_SB \
        PV_ROWS(Q, IX, 0) PV_SB \
        { u32x4 Wv; Wv[0] = 0u; Wv[1] = 0u; Wv[2] = (unsigned)dpp_i<0xAA>((int)W##_d); Wv[3] = (unsigned)dpp_i<0xFF>((int)W##_d); PV_ACC(Q, Wv, acc, 2) } \
        PV_FIN(acc, SWv, X, t_) PV_SB \
        PV_AUX(W, SWv, X, (t_) + 2 * tstep) PV_ROWS(Q, IX, 1) PV_SB }
    for (int s = x; s < 16; s += nx) {
        const int col = 128 * s + 2 * lane;
        int vbase = s * (16384 * 128) + 16 * jj; asm volatile("" : "+v"(vbase));
        const f32x2 gt0 = *(const f32x2*)(MOD + 5 * 2048 + col), gt1 = *(const f32x2*)(MOD + 12288 + 5 * 2048 + col);
        int t0 = j * 8 + wave, t1 = t0 + tstep;
        int2 IA, IB; u32x4 QA[16], QB[16]; unsigned WA_d, WB_d; float SA, SB;
        PV_IDX(IA, t0) PV_IDX(IB, t1) PV_SB
        PV_ROWS(QA, IA, 0) PV_AUX(WA, SA, XA, t0) PV_ROWS(QA, IA, 1) PV_SB
        PV_IDX(IA, t0 + 2 * tstep) PV_SB
        PV_ROWS(QB, IB, 0) PV_AUX(WB, SB, XB, t1) PV_ROWS(QB, IB, 1) PV_SB
        for (; t0 < MLAT; t0 += 2 * tstep, t1 += 2 * tstep) {
            PV_STEP(QA, WA, SA, XA, IA, IB, t0)
            PV_STEP(QB, WB, SB, XB, IB, IA, t1)
        }
    }
#undef PV_SB
#undef PV_ROWS
#undef PV_AUX
#undef PV_FIN
#undef PV_STEP
#undef PV_IDX
#undef PV_ACC
#undef PV_COMPUTE
}
__device__ __forceinline__ void final_norm_phase(const Params& p, int bid, int nblk) {
    int tid = threadIdx.x; asm volatile("" : "+v"(tid));
    const int lane = tid & 63, wave = __builtin_amdgcn_readfirstlane(tid >> 6);
    const bf16_t* XL = (const bf16_t*)(p.ws + WS_YL); const bf16_t* DELTA = (const bf16_t*)(p.ws + WS_DELTA);
    f32x4 fgv[8];
#pragma unroll
    for (int jx = 0; jx < 8; ++jx) fgv[jx] = *((const f32x4*)p.fg + lane + 64 * jx);
    for (int row = bid * 8 + wave; row < MLAT; row += nblk * 8) {
        u32x2 xa[8], da[8];
#pragma unroll
        for (int jx = 0; jx < 8; ++jx) { xa[jx] = __builtin_nontemporal_load((const u32x2*)(XL + (size_t)row * D) + lane + 64 * jx); da[jx] = __builtin_nontemporal_load((const u32x2*)(DELTA + (size_t)row * D) + lane + 64 * jx); }
        f32x4 v[8]; float ss = 0.f;
#pragma unroll
        for (int jx = 0; jx < 8; ++jx) { v[jx] = (f32x4){bflo(xa[jx].x) + bflo(da[jx].x), bfhi(xa[jx].x) + bfhi(da[jx].x), bflo(xa[jx].y) + bflo(da[jx].y), bfhi(xa[jx].y) + bfhi(da[jx].y)};
            ss += (v[jx][0] * v[jx][0] + v[jx][1] * v[jx][1]) + (v[jx][2] * v[jx][2] + v[jx][3] * v[jx][3]); }
        const float r2 = rsqrtf(wave_sum(ss) * (1.0f / 2048.0f) + EPS);
        f32x4* xr = (f32x4*)(p.out + (size_t)row * D);
#pragma unroll
        for (int jx = 0; jx < 8; ++jx) __builtin_nontemporal_store(v[jx] * r2 * fgv[jx], xr + lane + 64 * jx);
    }
}

#define XB_TMO      128
#define XB_XCNT(j)  (256  + 64 * (j))
#define XB_XSUB(j)  (1280 + 64 * (j))
#define XB_XGEN(j)  (2304 + 64 * (j))
#define XB_TOP      3328
#define XB_TOPGEN   3392
#define XCD_BAR_WORDS 3456
#define XB_SPIN_CAP (1u << 20)
__device__ __forceinline__ unsigned xb_ld(unsigned* p)              { return __hip_atomic_load(p, __ATOMIC_RELAXED, __HIP_MEMORY_SCOPE_AGENT); }
__device__ __forceinline__ unsigned xb_add(unsigned* p, unsigned v) { return __hip_atomic_fetch_add(p, v, __ATOMIC_RELAXED, __HIP_MEMORY_SCOPE_AGENT); }
__device__ __forceinline__ unsigned xb_xcc_id() { return (unsigned)__builtin_amdgcn_s_getreg((3 << 11) | 20) & 0xFu; }
#define XB_SPIN(cond, bar) do { unsigned _sp = 0; while (cond) { __builtin_amdgcn_s_sleep(1); \
    if ((++_sp & 255u) == 0u) { if (xb_ld(&(bar)[XB_TMO])) break; if (_sp > XB_SPIN_CAP) { atomicAdd(&(bar)[XB_TMO], 1u); break; } } } } while (0)
struct XcdBarrier { unsigned* bar; unsigned x; volatile LAS unsigned* st; };
__device__ __forceinline__ XcdBarrier xcd_barrier_post(unsigned* bar, volatile LAS unsigned* st) {
    XcdBarrier b; b.bar = bar; b.x = xb_xcc_id(); b.st = st;
    if (threadIdx.x == 0) (void)xb_add(&bar[XB_XCNT(b.x)], 1u);
    return b;
}
__device__ __forceinline__ void xcd_barrier_complete(unsigned* bar, unsigned x, unsigned& nloc, unsigned& nx) {
    const unsigned G = gridDim.x * gridDim.y * gridDim.z;
    unsigned sum, cnt, mine, sp = 0u;
    for (;;) {
        sum = 0u; cnt = 0u; mine = 0u;
#pragma unroll
        for (unsigned j = 0; j < 16; ++j) { const unsigned c = xb_ld(&bar[XB_XCNT(j)]); sum += c; cnt += (c > 0u) ? 1u : 0u; mine = (j == x) ? c : mine; }
        if (sum == G) break;
        __builtin_amdgcn_s_sleep(1);
        if ((++sp & 255u) == 0u) { if (xb_ld(&bar[XB_TMO])) break; if (sp > XB_SPIN_CAP) { atomicAdd(&bar[XB_TMO], 1u); break; } }
    }
    nloc = mine > 0u ? mine : 1u; nx = cnt > 0u ? cnt : 1u;
}
__device__ __forceinline__ void xcd_barrier(const XcdBarrier& b) {
    asm volatile("s_waitcnt vmcnt(0)" ::: "memory");
    __syncthreads();
    if (threadIdx.x == 0) {
        unsigned* bar = b.bar;
        __builtin_amdgcn_s_waitcnt(0);
        unsigned nloc = b.st[0], nx = b.st[1];
        if (nloc == 0u) { xcd_barrier_complete(bar, b.x, nloc, nx); b.st[0] = nloc; b.st[1] = nx; }
        const unsigned old = xb_add(&bar[XB_XSUB(b.x)], 1u);
        const unsigned gen = old / nloc;
        if (old + 1u == (gen + 1u) * nloc) {
            __builtin_amdgcn_fence(__ATOMIC_RELEASE, "agent");
            asm volatile("s_waitcnt vmcnt(0)" ::: "memory");
            const unsigned og = xb_add(&bar[XB_TOP], 1u);
            const unsigned tg = og / nx;
            if (og + 1u == (tg + 1u) * nx) xb_add(&bar[XB_TOPGEN], 1u);
            else XB_SPIN(xb_ld(&bar[XB_TOPGEN]) == tg, bar);
            xb_add(&bar[XB_XGEN(b.x)], 1u);
            __builtin_amdgcn_fence(__ATOMIC_ACQUIRE, "agent");
            asm volatile("s_waitcnt vmcnt(0)" ::: "memory");
        } else {
            XB_SPIN(xb_ld(&bar[XB_XGEN(b.x)]) == gen, bar);
            __builtin_amdgcn_fence(__ATOMIC_ACQUIRE, "agent");
            asm volatile("s_waitcnt vmcnt(0)" ::: "memory");
        }
    }
    __syncthreads();
}

__global__ void __launch_bounds__(512, 2) k_main(Params p, int ph_lo, int ph_hi) {
    extern __shared__ __attribute__((aligned(16))) unsigned char lds[];
    const int bid = blockIdx.x, nblk = gridDim.x;
#if FUSED
    cg::grid_group grid = cg::this_grid();
    volatile LAS unsigned* bst = (volatile LAS unsigned*)((LAS unsigned char*)lds + (LDS_BYTES - 64));
    if (threadIdx.x < 2) bst[threadIdx.x] = 0u;
    __syncthreads();
    const XcdBarrier xbar = xcd_barrier_post((unsigned*)(p.ws + WS_CTL), bst);
#define SYNC_AFTER(k) if ((k) + 1 < ph_hi) { if (ph_lo < 0) grid.sync(); else xcd_barrier(xbar); }
#else
#define SYNC_AFTER(k)
#endif
#define IN(k) (ph_lo <= (k) && (k) < ph_hi)
    if (IN(0)) { phase0(p, lds, bid, nblk); SYNC_AFTER(0) }
    if (IN(1)) { phase_norm1(p, lds, bid, nblk); SYNC_AFTER(1) }
#if !G1_I8
    if (IN(2)) { pg8::Gemm g{(const bf16_t*)(p.ws + WS_HN), (const bf16_t*)(p.ws + WS_WIN), MALL, INW, D, 1, 0, 0}; pg8::StaticOrder S; S.init(MALL, INW, nblk, bid);
                 pg8::EpiBf16 E{(bf16_t*)(p.ws + WS_PROJ), INW}; pg8::gemm_phase<pg8::EpiBf16>((LAS unsigned char*)lds, g, S, E); SYNC_AFTER(2) }
#else
    if (IN(2)) { pg8::Gemm g{(const bf16_t*)(p.ws + WS_HN), (const bf16_t*)(p.ws + WS_WIN3), MALL, INW, D / 2, 64, 2, (size_t)4096 * 2048}; pg8::StaticOrder S; S.init(CTX_SPLIT ? MLAT : MALL, INW, nblk, bid);
                 pg8::EpiI8BiasBf16 E{(bf16_t*)(p.ws + WS_PROJ), INW, (const float*)(p.ws + WS_RS1), (const float*)(p.ws + WS_CS1), (const float*)(p.ws + WS_BIAS1)}; pg8::gemm_phase<pg8::EpiI8BiasBf16>((LAS unsigned char*)lds, g, S, E); SYNC_AFTER(2) }
#endif
    if (IN(3)) {
#if G1_I8 && CTX_SPLIT
        if (bid < 8) { pg8::Gemm g{(const bf16_t*)(p.ws + WS_HN), (const bf16_t*)(p.ws + WS_WIN3), MALL, INW, D / 2, 64, 2, (size_t)4096 * 2048}; pg8::StaticOrder S; S.init(MALL, INW, nblk, bid); S.fpm = 128 + (bid >> 2); S.fpn = bid & 3;
            pg8::EpiI8BiasBf16 E{(bf16_t*)(p.ws + WS_PROJ), INW, (const float*)(p.ws + WS_RS1), (const float*)(p.ws + WS_CS1), (const float*)(p.ws + WS_BIAS1)}; pg8::gemm_phase<pg8::EpiI8BiasBf16>((LAS unsigned char*)lds, g, S, E);
            asm volatile("s_waitcnt vmcnt(0)" ::: "memory");
            __syncthreads();
            if (threadIdx.x == 0) { __builtin_amdgcn_fence(__ATOMIC_RELEASE, "agent"); asm volatile("s_waitcnt vmcnt(0)" ::: "memory"); (void)xb_add((unsigned*)(p.ws + WS_CTL + CTXDONE_OFS), 1u); }
            __syncthreads(); }
#endif
        lru_phase<false>(p, lds, bid, nblk); SYNC_AFTER(3) }
#if FUSED && MERGE45
    if (IN(4)) {
        carry_phase(p, bid, nblk);
        const int ncarry = (4096 + 511) / 512 < nblk ? (4096 + 511) / 512 : nblk;
        if (bid < ncarry) { asm volatile("s_waitcnt vmcnt(0)" ::: "memory"); __syncthreads();
            if (threadIdx.x == 0) { __builtin_amdgcn_fence(__ATOMIC_RELEASE, "agent"); asm volatile("s_waitcnt vmcnt(0)" ::: "memory"); (void)xb_add((unsigned*)(p.ws + WS_CTL + CARRYDONE_OFS), 1u); } }
        sgu_phase(p, lds, bid, nblk);
        if (threadIdx.x == 0) wait_count((unsigned*)(p.ws + WS_CTL + CARRYDONE_OFS), (unsigned)ncarry);
        __syncthreads();
        if (GATE_STORE && p.gate_store) lru_apply2(p, lds, bid, nblk); else lru_phase<true>(p, lds, bid, nblk);
        SYNC_AFTER(5) }
#else
    if (IN(4)) { carry_phase(p, bid, nblk); sgu_phase(p, lds, bid, nblk); SYNC_AFTER(4) }
    if (IN(5)) { if (GATE_STORE && p.gate_store) lru_apply2(p, lds, bid, nblk); else lru_phase<true>(p, lds, bid, nblk); SYNC_AFTER(5) }
#endif
    if (IN(6)) { pg8::Gemm g{(const bf16_t*)(p.ws + WS_HN), (const bf16_t*)(p.ws + WS_WOUT), MLAT, D, D, 1, 0, 0}; pg8::StaticOrder S; S.init(MLAT, D, nblk, bid);
                 pg8::EpiXlatBf16 E{(bf16_t*)(p.ws + WS_YL), D, (const float*)(p.ws + WS_MOD) + 2 * 2048, 12288, SEQ, p.x}; pg8::gemm_phase<pg8::EpiXlatBf16>((LAS unsigned char*)lds, g, S, E); SYNC_AFTER(6) }
    if (IN(7)) { phase_norm2(p, bid, nblk); SYNC_AFTER(7) }
#if G3_I8
    if (IN(8)) { pg8::Gemm g{(const bf16_t*)(p.ws + WS_HN8), (const bf16_t*)(p.ws + WS_WQ), MLAT, D, D / 2, 1, 0, 0}; pg8::StaticOrder S; S.init(MLAT, D, nblk, bid);
                 pg8::EpiI8Bf16 E{(bf16_t*)(p.ws + WS_PROJ), D, (const float*)(p.ws + WS_HSC), (const unsigned*)(p.ws + WS_COLMAX_Q)}; pg8::gemm_phase<pg8::EpiI8Bf16>((LAS unsigned char*)lds, g, S, E); SYNC_AFTER(8) }
#else
    if (IN(8)) { pg8::Gemm g{(const bf16_t*)(p.ws + WS_HN), (const bf16_t*)(p.ws + WS_WQ), MLAT, D, D, 1, 0, 0}; pg8::StaticOrder S; S.init(MLAT, D, nblk, bid);
                 pg8::EpiBf16 E{(bf16_t*)(p.ws + WS_PROJ), D}; pg8::gemm_phase<pg8::EpiBf16>((LAS unsigned char*)lds, g, S, E); SYNC_AFTER(8) }
#endif
    if (IN(9)) { topk_phase(p, lds, bid, nblk); SYNC_AFTER(9) }
    if (IN(10)) { peer_u_phase(p, bid, nblk); SYNC_AFTER(10) }
    if (IN(11)) { peer_w_phase(p, lds, bid, nblk); SYNC_AFTER(11) }
    if (IN(12)) { peer_v_phase(p, bid, nblk); SYNC_AFTER(12) }
    if (IN(13)) { final_norm_phase(p, bid, nblk); }
#undef IN
}

extern "C" void kernel_launch(void* const* d_in, const int* in_sizes, int n_in, void* d_out, int out_size, void* d_ws, size_t ws_size, hipStream_t stream) {
    static int grid = 0;
    if (grid == 0) {
        if (n_in != 25 || out_size != MLAT * D || ws_size < WS_END) { fprintf(stderr, "kernel_launch: unexpected shapes (n_in %d out %d ws %zu)\n", n_in, out_size, ws_size); grid = -1; return; }
        int dev = 0, cus = 0, per_cu = 0;
        hipGetDevice(&dev); hipDeviceGetAttribute(&cus, hipDeviceAttributeMultiprocessorCount, dev);
        if (hipFuncSetAttribute((const void*)k_main, hipFuncAttributeMaxDynamicSharedMemorySize, LDS_BYTES) != hipSuccess) { fprintf(stderr, "kernel_launch: hipFuncSetAttribute failed\n"); grid = -1; return; }
        hipOccupancyMaxActiveBlocksPerMultiprocessor(&per_cu, (const void*)k_main, 512, LDS_BYTES);
        if (per_cu < 1) { fprintf(stderr, "kernel_launch: occupancy query says %d blocks per CU\n", per_cu); per_cu = 1; }
        (void)hipGetLastError();
        grid = cus * 1;
    }
    if (grid < 0) return;
    Params p{};
    const float** pp = (const float**)&p;
    for (int i = 0; i < 25; ++i) pp[i] = (const float*)d_in[i];
    p.out = (float*)d_out; p.ws = (unsigned char*)d_ws; p.gate_store = (GATE_STORE && ws_size >= (size_t)952 * MiB) ? 1 : 0;
#if FUSED
    hipMemsetAsync((char*)d_ws + WS_CTL, 0, 131072, stream);
    int lo = 0, hi = NPHASES;
    void* args[] = {&p, &lo, &hi};
    hipError_t e = hipLaunchCooperativeKernel((const void*)k_main, dim3(grid), dim3(512), args, LDS_BYTES, stream);
    if (e != hipSuccess) fprintf(stderr, "cooperative launch failed: %s (grid %d)\n", hipGetErrorString(e), grid);
#else
    for (int ph = 0; ph < NPHASES; ++ph) hipLaunchKernelGGL(k_main, dim3(grid), dim3(512), LDS_BYTES, stream, p, ph, ph + 1);
#endif
}
```
